# Optimizing an MI355X kernel written in HIP

```python
import math, functools
import jax, jax.numpy as jnp
from jax import lax
import numpy as np

D_MODEL = 1024
BATCH = 16
SEQ = 2048
DEPTH = 1

PLE_DIM = 256
M_HEADS = 4
M_WIDTH = D_MODEL
M_HEAD_DIM = M_WIDTH // M_HEADS
QKV_BLOCK = 4
CONV_WIDTH = 4
M_CHUNK = 64
G_GROUPS = 8
G_WIDTH = D_MODEL
G_GROUP_DIM = G_WIDTH // G_GROUPS
G_CHUNK = 128
D_FF = 4 * D_MODEL
IN_COLS = 2 * M_WIDTH + 2 * G_WIDTH + 2 * D_MODEL
EPS = 1e-6

kernel_name = "hybrid_mlstm_gmlp_gated_block"


def rms_norm(x, g):
    x32 = x.astype(jnp.float32)
    y = x32 * lax.rsqrt(jnp.mean(x32 * x32, axis=-1, keepdims=True) + EPS)
    return (y * g.astype(jnp.float32)).astype(x.dtype)


def layer_norm(x, w, b=None):
    x32 = x.astype(jnp.float32)
    mu = jnp.mean(x32, axis=-1, keepdims=True)
    var = jnp.mean(jnp.square(x32 - mu), axis=-1, keepdims=True)
    y = (x32 - mu) * lax.rsqrt(var + EPS) * w.astype(jnp.float32)
    if b is not None:
        y = y + b.astype(jnp.float32)
    return y.astype(x.dtype)


def causal_conv(x, w, b):
    K = w.shape[0]
    S = x.shape[1]
    xp = jnp.pad(x, ((0, 0), (K - 1, 0), (0, 0)))
    out = xp[:, 0:S] * w[0]
    for j in range(1, K):
        out = out + xp[:, j:j + S] * w[j]
    return out + b


def block_diag_proj(x, w):
    B, S, C = x.shape
    nb, bs, _ = w.shape
    return jnp.einsum('bsnd,nde->bsne', x.reshape(B, S, nb, bs), w).reshape(B, S, C)


def mlstm_chunkwise(q, k, v, ig, lf):
    out_dtype = q.dtype
    B, S, H, dk = q.shape
    dv = v.shape[-1]
    L = M_CHUNK
    NC = S // L

    def chunks(t):
        return t.astype(jnp.float32).reshape(B, NC, L, H, -1).transpose(1, 0, 3, 2, 4)

    def gchunks(t):
        return t.astype(jnp.float32).reshape(B, NC, L, H).transpose(1, 0, 3, 2)

    qc, kc, vc = chunks(q), chunks(k) * (dk ** -0.5), chunks(v)
    igc, lfc = gchunks(ig), gchunks(lf)
    mask = jnp.tril(jnp.ones((L, L), dtype=bool))

    def step(carry, inp):
        C, n, m = carry
        qt, kt, vt, it, ft = inp
        b = jnp.cumsum(ft, axis=-1)
        D = b[..., :, None] - b[..., None, :] + it[..., None, :]
        D = jnp.where(mask, D, -jnp.inf)
        a = b + m[..., None]
        m_t = jnp.maximum(a, jnp.max(D, axis=-1))
        Dw = jnp.exp(D - m_t[..., None])
        inter_w = jnp.exp(a - m_t)
        Sqk = jnp.einsum('bhtd,bhsd->bhts', qt, kt) * Dw
        num = inter_w[..., None] * jnp.einsum('bhtd,bhde->bhte', qt, C) \
            + jnp.einsum('bhts,bhse->bhte', Sqk, vt)
        den = inter_w * jnp.einsum('bhtd,bhd->bht', qt, n) + jnp.sum(Sqk, axis=-1)
        h = num / jnp.maximum(jnp.abs(den), jnp.exp(-m_t))[..., None]
        bL = b[..., -1]
        w_s = bL[..., None] - b + it
        m_new = jnp.maximum(bL + m, jnp.max(w_s, axis=-1))
        decay = jnp.exp(bL + m - m_new)
        ws = jnp.exp(w_s - m_new[..., None])
        C_new = decay[..., None, None] * C + jnp.einsum('bhsd,bhse->bhde', kt * ws[..., None], vt)
        n_new = decay[..., None] * n + jnp.einsum('bhs,bhsd->bhd', ws, kt)
        return (C_new, n_new, m_new), h

    init = (jnp.zeros((B, H, dk, dv), jnp.float32),
            jnp.zeros((B, H, dk), jnp.float32),
            jnp.zeros((B, H), jnp.float32))
    _, hc = lax.scan(step, init, (qc, kc, vc, igc, lfc))
    return hc.transpose(1, 0, 3, 2, 4).reshape(B, S, H, dv).astype(out_dtype)


def token_mixer(h, w_in, conv_w, conv_b, wq_bd, wk_bd, wv_bd, w_if, b_if, m_norm_g, m_skip,
                g_ln_w, g_ln_b, w_spatial, b_spatial, w_br_m, w_br_g, w_out):
    B, S, _ = h.shape
    proj = h @ w_in
    m_x, m_z, g_uv, gate_pre = jnp.split(
        proj, [M_WIDTH, 2 * M_WIDTH, 2 * M_WIDTH + 2 * G_WIDTH], axis=-1)

    m_c = jax.nn.silu(causal_conv(m_x, conv_w, conv_b))
    q = block_diag_proj(m_c, wq_bd)
    k = block_diag_proj(m_c, wk_bd)
    v = block_diag_proj(m_x, wv_bd)
    gates = jnp.concatenate([q, k, v], axis=-1) @ w_if + b_if
    ig, f_pre = jnp.split(gates.astype(jnp.float32), 2, axis=-1)
    lf = jax.nn.log_sigmoid(f_pre)
    heads = lambda t: t.reshape(B, S, M_HEADS, M_HEAD_DIM)
    hm = mlstm_chunkwise(heads(q), heads(k), heads(v), ig, lf)
    hm = layer_norm(hm, jnp.ones((M_HEAD_DIM,), h.dtype)).reshape(B, S, M_WIDTH) * m_norm_g
    y_m = (hm + m_skip * m_c) * jax.nn.silu(m_z)

    g_u, g_v = jnp.split(jax.nn.gelu(g_uv), 2, axis=-1)
    g_v = layer_norm(g_v, g_ln_w, g_ln_b)
    vv = g_v.reshape(B, S // G_CHUNK, G_CHUNK, G_GROUPS, G_GROUP_DIM)
    w_causal = jnp.where(jnp.tril(jnp.ones((G_CHUNK, G_CHUNK), dtype=bool)), w_spatial, 0)
    mixed = jnp.einsum('gts,bcsgd->bctgd', w_causal, vv) + b_spatial.T[None, None, :, :, None]
    y_g = g_u * mixed.reshape(B, S, G_WIDTH)

    gate_m, gate_g = jnp.split(jax.nn.sigmoid(gate_pre), 2, axis=-1)
    merged = gate_m * (y_m @ w_br_m) + gate_g * (y_g @ w_br_g)
    return merged @ w_out


def setup_inputs(seed: int = 0) -> dict:
    key = jax.random.key(seed)
    ks = jax.random.split(key, 32)
    f32 = jnp.float32
    nrm = lambda k, shape, scale: jax.random.normal(k, shape, f32) * scale
    gain = lambda k, n: 1.0 + 0.01 * jax.random.normal(k, (DEPTH, n), f32)
    forget_bias = jnp.linspace(3.0, 6.0, M_HEADS, dtype=f32)
    b_if = jnp.concatenate([
        nrm(ks[10], (DEPTH, M_HEADS), 0.1),
        forget_bias[None, :] + nrm(ks[11], (DEPTH, M_HEADS), 0.1)], axis=-1)
    return {
        "x": jax.random.normal(ks[0], (BATCH, SEQ, D_MODEL), f32),
        "p": jax.random.normal(ks[1], (DEPTH, BATCH, SEQ, PLE_DIM), f32),
        "mix_pre_g": gain(ks[2], D_MODEL),
        "w_in": nrm(ks[3], (DEPTH, D_MODEL, IN_COLS), D_MODEL ** -0.5),
        "conv_w": nrm(ks[4], (DEPTH, CONV_WIDTH, M_WIDTH), CONV_WIDTH ** -0.5),
        "conv_b": nrm(ks[5], (DEPTH, M_WIDTH), 0.02),
        "wq_bd": nrm(ks[6], (DEPTH, M_WIDTH // QKV_BLOCK, QKV_BLOCK, QKV_BLOCK), QKV_BLOCK ** -0.5),
        "wk_bd": nrm(ks[7], (DEPTH, M_WIDTH // QKV_BLOCK, QKV_BLOCK, QKV_BLOCK), QKV_BLOCK ** -0.5),
        "wv_bd": nrm(ks[8], (DEPTH, M_WIDTH // QKV_BLOCK, QKV_BLOCK, QKV_BLOCK), QKV_BLOCK ** -0.5),
        "w_if": nrm(ks[9], (DEPTH, 3 * M_WIDTH, 2 * M_HEADS), 0.5 * (3 * M_WIDTH) ** -0.5),
        "b_if": b_if,
        "m_norm_g": gain(ks[12], M_WIDTH),
        "m_skip": gain(ks[13], M_WIDTH),
        "g_ln_w": gain(ks[14], G_WIDTH),
        "g_ln_b": nrm(ks[15], (DEPTH, G_WIDTH), 0.02),
        "w_spatial": nrm(ks[16], (DEPTH, G_GROUPS, G_CHUNK, G_CHUNK), G_CHUNK ** -0.5),
        "b_spatial": 1.0 + nrm(ks[17], (DEPTH, G_GROUPS, G_CHUNK), 0.01),
        "w_br_m": nrm(ks[18], (DEPTH, M_WIDTH, D_MODEL), M_WIDTH ** -0.5),
        "w_br_g": nrm(ks[19], (DEPTH, G_WIDTH, D_MODEL), G_WIDTH ** -0.5),
        "w_out": nrm(ks[20], (DEPTH, D_MODEL, D_MODEL), D_MODEL ** -0.5),
        "mix_post_g": gain(ks[21], D_MODEL),
        "mlp_pre_g": gain(ks[22], D_MODEL),
        "w_up": nrm(ks[23], (DEPTH, D_MODEL, D_FF), D_MODEL ** -0.5),
        "w_down": nrm(ks[24], (DEPTH, D_FF, D_MODEL), D_FF ** -0.5),
        "mlp_post_g": gain(ks[25], D_MODEL),
        "ple_pre_g": gain(ks[26], D_MODEL),
        "w_ple_gate": nrm(ks[27], (DEPTH, D_MODEL, D_MODEL), D_MODEL ** -0.5),
        "w_ple_proj": nrm(ks[28], (DEPTH, PLE_DIM, D_MODEL), PLE_DIM ** -0.5),
        "ple_post_g": gain(ks[29], D_MODEL),
    }


def reference(x, p, mix_pre_g, w_in, conv_w, conv_b, wq_bd, wk_bd, wv_bd, w_if, b_if,
              m_norm_g, m_skip, g_ln_w, g_ln_b, w_spatial, b_spatial, w_br_m, w_br_g, w_out,
              mix_post_g, mlp_pre_g, w_up, w_down, mlp_post_g, ple_pre_g, w_ple_gate,
              w_ple_proj, ple_post_g):
    for i in range(DEPTH):
        h = rms_norm(x, mix_pre_g[i])
        y = token_mixer(h, w_in[i], conv_w[i], conv_b[i], wq_bd[i], wk_bd[i], wv_bd[i],
                        w_if[i], b_if[i], m_norm_g[i], m_skip[i], g_ln_w[i], g_ln_b[i],
                        w_spatial[i], b_spatial[i], w_br_m[i], w_br_g[i], w_out[i])
        x = x + rms_norm(y, mix_post_g[i])
        h = rms_norm(x, mlp_pre_g[i])
        y = jnp.square(jax.nn.relu(h @ w_up[i])) @ w_down[i]
        x = x + rms_norm(y, mlp_post_g[i])
        h = rms_norm(x, ple_pre_g[i])
        y = jax.nn.sigmoid(h @ w_ple_gate[i]) * (p[i] @ w_ple_proj[i])
        x = x + rms_norm(y, ple_post_g[i])
    return x
```

```cpp
#include <hip/hip_runtime.h>
#include <cstdio>
#include <cstdint>
#include <cmath>

#define LAS __attribute__((address_space(3)))
typedef unsigned short bf16_t;
typedef short bf16x8 __attribute__((ext_vector_type(8)));
typedef float f32x4 __attribute__((ext_vector_type(4)));
typedef unsigned u32x4 __attribute__((ext_vector_type(4)));
typedef unsigned u32x2 __attribute__((ext_vector_type(2)));

constexpr int NTOK = 32768, DM = 1024, SEQ = 2048, PROJW = 6144, DFF = 4096, PLE = 256, PLEK = PLE + DM;
constexpr float EPS = 1e-6f;
constexpr int NWAVES = 8, NTHR = 512;
constexpr size_t MiB = 1u << 20;
constexpr size_t WS_CTL = 0;
constexpr size_t WS_WIN = 1 * MiB;
constexpr size_t WS_WBR = 13 * MiB;
constexpr size_t WS_WOUT = 17 * MiB;
constexpr size_t WS_WUP = 19 * MiB;
constexpr size_t WS_WDN = 27 * MiB;
constexpr size_t WS_WPLE = 35 * MiB;
constexpr size_t WS_WCX = 38 * MiB;
constexpr size_t WS_GATES = 39 * MiB;
constexpr size_t WS_XN = 40 * MiB;
constexpr size_t WS_PROJ = 104 * MiB;
constexpr size_t WS_HB = WS_PROJ;
constexpr size_t WS_Y = WS_PROJ + 256 * MiB;
constexpr size_t WS_END = 488 * MiB;

struct Params {
    const float* in[29];
    float* out;
    unsigned char* ws;
};
enum { I_X = 0, I_P, I_MIX_PRE_G, I_W_IN, I_CONV_W, I_CONV_B, I_WQ, I_WK, I_WV, I_W_IF, I_B_IF, I_M_NORM_G, I_M_SKIP, I_G_LN_W, I_G_LN_B, I_W_SP, I_B_SP,
       I_W_BR_M, I_W_BR_G, I_W_OUT, I_MIX_POST_G, I_MLP_PRE_G, I_W_UP, I_W_DOWN, I_MLP_POST_G, I_PLE_PRE_G, I_W_PLE_GATE, I_W_PLE_PROJ, I_PLE_POST_G };

__device__ __forceinline__ unsigned f2bf(float f) { unsigned u = __builtin_bit_cast(unsigned, f); return (u + 0x7fffu + ((u >> 16) & 1u)) >> 16; }
__device__ __forceinline__ unsigned pk2(float lo, float hi) { return f2bf(lo) | (f2bf(hi) << 16); }
__device__ __forceinline__ float bflo(unsigned w) { return __builtin_bit_cast(float, w << 16); }
__device__ __forceinline__ float bfhi(unsigned w) { return __builtin_bit_cast(float, w & 0xffff0000u); }
__device__ __forceinline__ float bf2f(bf16_t h) { return __builtin_bit_cast(float, (unsigned)h << 16); }
__device__ __forceinline__ float sigmoidf_(float x) { return 1.0f / (1.0f + __expf(-x)); }
__device__ __forceinline__ float siluf_(float x) { return x * sigmoidf_(x); }
__device__ __forceinline__ float gelu_tanh(float x) { const float z = 0.7978845608028654f * (x + 0.044715f * x * x * x); return x * sigmoidf_(2.0f * z); }
__device__ __forceinline__ float log_sigmoid(float x) { return fminf(x, 0.f) - log1pf(expf(-fabsf(x))); }
__device__ __forceinline__ float wave_sum(float v) {
#pragma unroll
    for (int o = 1; o < 64; o <<= 1) v += __shfl_xor(v, o);
    return v;
}
#define LDS_WAIT() asm volatile("s_waitcnt lgkmcnt(0)" ::: "memory")

__device__ __forceinline__ void transpose_item(const float* W, int K, int N, bf16_t* WT, int ldw, int koff, LAS float* scr, int item, int lane) {
    const int nblk = N / 32, kb = item / nblk, nb = item % nblk, k0 = 64 * kb, n0 = 32 * nb;
#pragma unroll 8
    for (int i = 0; i < 32; ++i) { const int kk = 2 * i + (lane >> 5); scr[kk * 33 + (lane & 31)] = W[(size_t)(k0 + kk) * N + n0 + (lane & 31)]; }
    LDS_WAIT();
    const int c = lane & 7;
#pragma unroll
    for (int j = 0; j < 4; ++j) { const int n = (lane >> 3) + 8 * j; const LAS float* s = scr + (8 * c) * 33 + n;
        u32x4 o; o.x = pk2(s[0 * 33], s[1 * 33]); o.y = pk2(s[2 * 33], s[3 * 33]); o.z = pk2(s[4 * 33], s[5 * 33]); o.w = pk2(s[6 * 33], s[7 * 33]);
        *(u32x4*)(WT + (size_t)(n0 + n) * ldw + koff + k0 + 8 * c) = o; }
    LDS_WAIT();
}
__device__ __forceinline__ void rms_row_to_bf16(const float* xrow, const float* g, bf16_t* orow, int lane) {
    const f32x4* xr = (const f32x4*)xrow + lane; const f32x4* gr = (const f32x4*)g + lane;
    f32x4 v[4]; float s = 0.f;
#pragma unroll
    for (int j = 0; j < 4; ++j) { v[j] = xr[64 * j]; s += (v[j].x * v[j].x + v[j].y * v[j].y) + (v[j].z * v[j].z + v[j].w * v[j].w); }
    const float r = 1.0f / sqrtf(wave_sum(s) * (1.f / DM) + EPS);
    u32x2* o8 = (u32x2*)orow + lane;
#pragma unroll
    for (int j = 0; j < 4; ++j) { const f32x4 gv = gr[64 * j]; u32x2 o; o.x = pk2(v[j].x * r * gv.x, v[j].y * r * gv.y); o.y = pk2(v[j].z * r * gv.z, v[j].w * r * gv.w); o8[64 * j] = o; }
}
__device__ void p0_prologue(const Params& P, LAS unsigned char* lds) {
    const int tid = threadIdx.x, lane = tid & 63, wave = tid >> 6;
    LAS float* scr = (LAS float*)(lds + wave * 16384);
    const int gw = blockIdx.x * NWAVES + wave, NGW = gridDim.x * NWAVES;
    unsigned char* ws = P.ws;
    constexpr int I_IN = 16 * 192, I_SQ = 16 * 32, I_UP = 16 * 128, I_DN = 64 * 32, I_PP = 4 * 32;
    constexpr int NIT = I_IN + 4 * I_SQ + I_UP + I_DN + I_PP;
    for (int it = gw; it < NIT; it += NGW) {
        int r = it;
        if (r < I_IN) { transpose_item(P.in[I_W_IN], DM, PROJW, (bf16_t*)(ws + WS_WIN), DM, 0, scr, r, lane); continue; } r -= I_IN;
        if (r < I_SQ) { transpose_item(P.in[I_W_BR_M], DM, DM, (bf16_t*)(ws + WS_WBR), 2 * DM, 0, scr, r, lane); continue; } r -= I_SQ;
        if (r < I_SQ) { transpose_item(P.in[I_W_BR_G], DM, DM, (bf16_t*)(ws + WS_WBR), 2 * DM, DM, scr, r, lane); continue; } r -= I_SQ;
        if (r < I_SQ) { transpose_item(P.in[I_W_OUT], DM, DM, (bf16_t*)(ws + WS_WOUT), DM, 0, scr, r, lane); continue; } r -= I_SQ;
        if (r < I_SQ) { transpose_item(P.in[I_W_PLE_GATE], DM, DM, (bf16_t*)(ws + WS_WPLE), PLEK, PLE, scr, r, lane); continue; } r -= I_SQ;
        if (r < I_UP) { transpose_item(P.in[I_W_UP], DM, DFF, (bf16_t*)(ws + WS_WUP), DM, 0, scr, r, lane); continue; } r -= I_UP;
        if (r < I_DN) { transpose_item(P.in[I_W_DOWN], DFF, DM, (bf16_t*)(ws + WS_WDN), DFF, 0, scr, r, lane); continue; } r -= I_DN;
        transpose_item(P.in[I_W_PLE_PROJ], PLE, DM, (bf16_t*)(ws + WS_WPLE), PLEK, 0, scr, r, lane);
    }
    {
        float* wcx = (float*)(ws + WS_WCX);
        const float* wq = P.in[I_WQ]; const float* wk = P.in[I_WK]; const float* wv = P.in[I_WV]; const float* wif = P.in[I_W_IF];
        for (int i = blockIdx.x * NTHR + tid; i < DM * 8; i += gridDim.x * NTHR) {
            const int c = i >> 3, j = i & 7, blk = c >> 2, d = c & 3; float sc = 0.f, sx = 0.f;
#pragma unroll
            for (int e = 0; e < 4; ++e) {
                sc += wq[blk * 16 + d * 4 + e] * wif[(size_t)(blk * 4 + e) * 8 + j] + wk[blk * 16 + d * 4 + e] * wif[(size_t)(DM + blk * 4 + e) * 8 + j];
                sx += wv[blk * 16 + d * 4 + e] * wif[(size_t)(2 * DM + blk * 4 + e) * 8 + j]; }
            wcx[i] = sc; wcx[DM * 8 + i] = sx;
        }
    }
    bf16_t* XN = (bf16_t*)(ws + WS_XN);
    for (int m = gw; m < NTOK; m += NGW) rms_row_to_bf16(P.in[I_X] + (size_t)m * DM, P.in[I_MIX_PRE_G], XN + (size_t)m * DM, lane);
}

struct GemmDesc { const bf16_t* A; const bf16_t* Bt; int lda, ldb, M, N, K, K1; };
template <class Epi>
__global__ void __launch_bounds__(256) gemm_simple(GemmDesc g, Epi E) {
    const int tid = threadIdx.x, w = tid >> 6, lane = tid & 63, fr = lane & 15, fq = lane >> 4;
    const int m0 = blockIdx.y * 64 + (w >> 1) * 32, n0 = blockIdx.x * 64 + (w & 1) * 32;
    f32x4 accA[2][2], accB[2][2];
#pragma unroll
    for (int i = 0; i < 2; ++i)
#pragma unroll
        for (int j = 0; j < 2; ++j) { accA[i][j] = (f32x4){0.f, 0.f, 0.f, 0.f}; accB[i][j] = (f32x4){0.f, 0.f, 0.f, 0.f}; }
    const bf16_t* ap[2]; const bf16_t* bp[2];
#pragma unroll
    for (int i = 0; i < 2; ++i) { ap[i] = g.A + (size_t)(m0 + i * 16 + fr) * g.lda + 8 * fq; bp[i] = g.Bt + (size_t)(n0 + i * 16 + fr) * g.ldb + 8 * fq; }
    for (int k = 0; k < g.K1; k += 32) {
        bf16x8 a[2], b[2];
#pragma unroll
        for (int i = 0; i < 2; ++i) { a[i] = *(const bf16x8*)(ap[i] + k); b[i] = *(const bf16x8*)(bp[i] + k); }
#pragma unroll
        for (int i = 0; i < 2; ++i)
#pragma unroll
            for (int j = 0; j < 2; ++j) accA[i][j] = __builtin_amdgcn_mfma_f32_16x16x32_bf16(b[j], a[i], accA[i][j], 0, 0, 0);
    }
    for (int k = g.K1; k < g.K; k += 32) {
        bf16x8 a[2], b[2];
#pragma unroll
        for (int i = 0; i < 2; ++i) { a[i] = *(const bf16x8*)(ap[i] + k); b[i] = *(const bf16x8*)(bp[i] + k); }
#pragma unroll
        for (int i = 0; i < 2; ++i)
#pragma unroll
            for (int j = 0; j < 2; ++j) accB[i][j] = __builtin_amdgcn_mfma_f32_16x16x32_bf16(b[j], a[i], accB[i][j], 0, 0, 0);
    }
#pragma unroll
    for (int i = 0; i < 2; ++i)
#pragma unroll
        for (int j = 0; j < 2; ++j) E(m0 + i * 16 + fr, n0 + j * 16 + 4 * fq, accA[i][j], accB[i][j]);
}
__device__ __forceinline__ void st_bf16x4(bf16_t* p, f32x4 v) { u32x2 o; o.x = pk2(v.x, v.y); o.y = pk2(v.z, v.w); *(u32x2*)p = o; }
__device__ __forceinline__ f32x4 ld_bf16x4(const bf16_t* p) { const u32x2 w = *(const u32x2*)p; return (f32x4){bflo(w.x), bfhi(w.x), bflo(w.y), bfhi(w.y)}; }
struct EpiProj {
    bf16_t* proj;
    __device__ __forceinline__ void operator()(int row, int col, f32x4 v, f32x4) const {
        const int sec = col >> 10; f32x4 o;
        if (sec == 0) o = v;
        else if (sec == 1) o = (f32x4){siluf_(v.x), siluf_(v.y), siluf_(v.z), siluf_(v.w)};
        else if (sec <= 3) o = (f32x4){gelu_tanh(v.x), gelu_tanh(v.y), gelu_tanh(v.z), gelu_tanh(v.w)};
        else o = (f32x4){sigmoidf_(v.x), sigmoidf_(v.y), sigmoidf_(v.z), sigmoidf_(v.w)};
        st_bf16x4(proj + (size_t)row * PROJW + col, o);
    }
};
struct EpiMerge {
    const bf16_t* proj; bf16_t* merged;
    __device__ __forceinline__ void operator()(int row, int col, f32x4 va, f32x4 vb) const {
        const f32x4 gm = ld_bf16x4(proj + (size_t)row * PROJW + 4 * DM + col), gg = ld_bf16x4(proj + (size_t)row * PROJW + 5 * DM + col);
        st_bf16x4(merged + (size_t)row * DM + col, gm * va + gg * vb);
    }
};
struct EpiF32 {
    float* o; int ldc;
    __device__ __forceinline__ void operator()(int row, int col, f32x4 v, f32x4) const { *(f32x4*)(o + (size_t)row * ldc + col) = v; }
};
struct EpiRelu2 {
    bf16_t* o; int ldc;
    __device__ __forceinline__ void operator()(int row, int col, f32x4 v, f32x4) const {
        f32x4 r; r.x = fmaxf(v.x, 0.f); r.y = fmaxf(v.y, 0.f); r.z = fmaxf(v.z, 0.f); r.w = fmaxf(v.w, 0.f); st_bf16x4(o + (size_t)row * ldc + col, r * r);
    }
};
struct EpiPle {
    float* o;
    __device__ __forceinline__ void operator()(int row, int col, f32x4 va, f32x4 vb) const {
        f32x4 r; r.x = sigmoidf_(vb.x) * va.x; r.y = sigmoidf_(vb.y) * va.y; r.z = sigmoidf_(vb.z) * va.z; r.w = sigmoidf_(vb.w) * va.w;
        *(f32x4*)(o + (size_t)row * DM + col) = r;
    }
};

__device__ __forceinline__ void ld4(const bf16_t* p, float (&x)[4]) { const u32x2 w = *(const u32x2*)p; x[0] = bflo(w.x); x[1] = bfhi(w.x); x[2] = bflo(w.y); x[3] = bfhi(w.y); }
__device__ __forceinline__ void st4(bf16_t* p, const float (&x)[4]) { u32x2 o; o.x = pk2(x[0], x[1]); o.y = pk2(x[2], x[3]); *(u32x2*)p = o; }
__device__ void p2_qkv(const Params& P, LAS unsigned char* lds) {
    const int tid = threadIdx.x, lane = tid & 63, wave = tid >> 6, h = wave & 3, half = wave >> 2;
    unsigned char* ws = P.ws;
    const bf16_t* PROJ = (const bf16_t*)(ws + WS_PROJ);
    bf16_t* Q = (bf16_t*)P.out; bf16_t* K = Q + (size_t)NTOK * DM; bf16_t* V = (bf16_t*)(ws + WS_XN);
    float* GATES = (float*)(ws + WS_GATES);
    LAS float* part = (LAS float*)lds;
    const int ch = h * 256 + lane * 4, blk = ch >> 2;
    float cw[4][4], cb[4], wq[4][4], wk[4][4], wv[4][4], wc[4][8], wx[4][8];
#pragma unroll
    for (int j = 0; j < 4; ++j)
#pragma unroll
        for (int d = 0; d < 4; ++d) cw[j][d] = P.in[I_CONV_W][j * DM + ch + d];
#pragma unroll
    for (int d = 0; d < 4; ++d) { cb[d] = P.in[I_CONV_B][ch + d];
#pragma unroll
        for (int e = 0; e < 4; ++e) { wq[d][e] = P.in[I_WQ][blk * 16 + d * 4 + e]; wk[d][e] = P.in[I_WK][blk * 16 + d * 4 + e]; wv[d][e] = P.in[I_WV][blk * 16 + d * 4 + e]; }
#pragma unroll
        for (int j = 0; j < 8; ++j) { wc[d][j] = ((const float*)(ws + WS_WCX))[(ch + d) * 8 + j]; wx[d][j] = ((const float*)(ws + WS_WCX))[DM * 8 + (ch + d) * 8 + j]; } }
    for (int item = blockIdx.x; item < NTOK / 16; item += gridDim.x) {
        const int tb = item * 16 + half * 8;
        float x0[4], x1[4], x2[4], x3[4];
        if ((tb & (SEQ - 1)) == 0) {
#pragma unroll
            for (int d = 0; d < 4; ++d) { x0[d] = 0.f; x1[d] = 0.f; x2[d] = 0.f; }
        } else { ld4(PROJ + (size_t)(tb - 3) * PROJW + ch, x0); ld4(PROJ + (size_t)(tb - 2) * PROJW + ch, x1); ld4(PROJ + (size_t)(tb - 1) * PROJW + ch, x2); }
#pragma unroll 1
        for (int i = 0; i < 8; ++i) {
            const int t = tb + i;
            ld4(PROJ + (size_t)t * PROJW + ch, x3);
            float mc[4], q[4], k[4], v[4], gp[8];
#pragma unroll
            for (int d = 0; d < 4; ++d) mc[d] = siluf_(cw[0][d] * x0[d] + cw[1][d] * x1[d] + cw[2][d] * x2[d] + cw[3][d] * x3[d] + cb[d]);
#pragma unroll
            for (int e = 0; e < 4; ++e) { q[e] = mc[0] * wq[0][e] + mc[1] * wq[1][e] + mc[2] * wq[2][e] + mc[3] * wq[3][e];
                k[e] = mc[0] * wk[0][e] + mc[1] * wk[1][e] + mc[2] * wk[2][e] + mc[3] * wk[3][e];
                v[e] = x3[0] * wv[0][e] + x3[1] * wv[1][e] + x3[2] * wv[2][e] + x3[3] * wv[3][e]; }
            st4(Q + (size_t)t * DM + ch, q); st4(K + (size_t)t * DM + ch, k); st4(V + (size_t)t * DM + ch, v);
#pragma unroll
            for (int j = 0; j < 8; ++j) { float s = 0.f;
#pragma unroll
                for (int d = 0; d < 4; ++d) s += mc[d] * wc[d][j] + x3[d] * wx[d][j];
                gp[j] = wave_sum(s); }
            if (lane == 0) {
#pragma unroll
                for (int j = 0; j < 8; ++j) part[((half * 8 + i) * 4 + h) * 8 + j] = gp[j]; }
#pragma unroll
            for (int d = 0; d < 4; ++d) { x0[d] = x1[d]; x1[d] = x2[d]; x2[d] = x3[d]; }
        }
        __syncthreads();
        if (tid < 128) { const int tok = tid >> 3, j = tid & 7;
            const float val = part[(tok * 4 + 0) * 8 + j] + part[(tok * 4 + 1) * 8 + j] + part[(tok * 4 + 2) * 8 + j] + part[(tok * 4 + 3) * 8 + j] + P.in[I_B_IF][j];
            GATES[(size_t)(item * 16 + tok) * 8 + j] = (j < 4) ? val : log_sigmoid(val); }
        __syncthreads();
    }
    bf16_t* PW = (bf16_t*)(ws + WS_PROJ);
    const int gw = blockIdx.x * NWAVES + wave, NGW = gridDim.x * NWAVES;
    for (int m = gw; m < NTOK; m += NGW) {
        bf16_t* row = PW + (size_t)m * PROJW + 3 * DM + lane * 16;
        const u32x4 a = *(const u32x4*)row, b = *(const u32x4*)(row + 8);
        float x[16] = {bflo(a.x), bfhi(a.x), bflo(a.y), bfhi(a.y), bflo(a.z), bfhi(a.z), bflo(a.w), bfhi(a.w), bflo(b.x), bfhi(b.x), bflo(b.y), bfhi(b.y), bflo(b.z), bfhi(b.z), bflo(b.w), bfhi(b.w)};
        float s = 0.f;
#pragma unroll
        for (int i = 0; i < 16; ++i) s += x[i];
        const float mu = wave_sum(s) * (1.f / DM); float s2 = 0.f;
#pragma unroll
        for (int i = 0; i < 16; ++i) { x[i] -= mu; s2 += x[i] * x[i]; }
        const float r = 1.0f / sqrtf(wave_sum(s2) * (1.f / DM) + EPS);
        const float* lw = P.in[I_G_LN_W] + lane * 16; const float* lb = P.in[I_G_LN_B] + lane * 16;
#pragma unroll
        for (int i = 0; i < 16; ++i) x[i] = x[i] * r * lw[i] + lb[i];
        u32x4 oa, ob; oa.x = pk2(x[0], x[1]); oa.y = pk2(x[2], x[3]); oa.z = pk2(x[4], x[5]); oa.w = pk2(x[6], x[7]); ob.x = pk2(x[8], x[9]); ob.y = pk2(x[10], x[11]); ob.z = pk2(x[12], x[13]); ob.w = pk2(x[14], x[15]);
        *(u32x4*)row = oa; *(u32x4*)(row + 8) = ob;
    }
}

constexpr int ML_C = 0, ML_N = 65536, ML_Q = ML_N + 1024, ML_K = ML_Q + 32768, ML_V = ML_K + 32768, ML_P = ML_V + 8192, ML_S = ML_P + 16384, ML_BYTES = ML_S + 2048;
__device__ void p3_mlstm_naive(const Params& P, LAS unsigned char* lds) {
    const int tid = threadIdx.x, lane = tid & 63, wave = tid >> 6;
    unsigned char* ws = P.ws;
    const bf16_t* Q = (const bf16_t*)P.out; const bf16_t* K = Q + (size_t)NTOK * DM; bf16_t* V = (bf16_t*)(ws + WS_XN);
    const float* GATES = (const float*)(ws + WS_GATES);
    LAS float* Cs = (LAS float*)(lds + ML_C); LAS float* ns = (LAS float*)(lds + ML_N);
    LAS unsigned* qs = (LAS unsigned*)(lds + ML_Q); LAS unsigned* ks = (LAS unsigned*)(lds + ML_K);
    LAS bf16_t* vs = (LAS bf16_t*)(lds + ML_V);
    LAS float* Ps = (LAS float*)(lds + ML_P);
    LAS float* sc = (LAS float*)(lds + ML_S);
    for (int item = blockIdx.x; item < 256; item += gridDim.x) {
        const int b = item >> 4, h = (item >> 2) & 3, j = item & 3;
        for (int i = tid; i < 256 * 64; i += NTHR) Cs[i] = 0.f;
        if (tid < 256) ns[tid] = 0.f;
        float m = 0.f;
        __syncthreads();
        for (int c = 0; c < 32; ++c) {
            const size_t t0 = (size_t)b * SEQ + c * 64;
#pragma unroll
            for (int i = 0; i < 4; ++i) { const int p = tid + i * NTHR, r = p >> 5, cc = p & 31;
                *(LAS u32x4*)(qs + r * 128 + cc * 4) = *(const u32x4*)(Q + (t0 + r) * DM + h * 256 + cc * 8);
                *(LAS u32x4*)(ks + r * 128 + cc * 4) = *(const u32x4*)(K + (t0 + r) * DM + h * 256 + cc * 8); }
            { const int r = tid >> 3, cc = tid & 7; *(LAS u32x4*)(vs + r * 64 + cc * 8) = *(const u32x4*)(V + (t0 + r) * DM + h * 256 + j * 64 + cc * 8); }
            if (wave == 0) {
                const float ig = GATES[(t0 + lane) * 8 + h], lf = GATES[(t0 + lane) * 8 + 4 + h];
                float bs = lf;
#pragma unroll
                for (int o = 1; o < 64; o <<= 1) { const float t = __shfl_up(bs, o); if (lane >= o) bs += t; }
                const float u = ig - bs; float gm = u;
#pragma unroll
                for (int o = 1; o < 64; o <<= 1) { const float t = __shfl_up(gm, o); if (lane >= o) gm = fmaxf(gm, t); }
                const float g = fmaxf(gm, m), gL = __shfl(g, 63), bL = __shfl(bs, 63);
                sc[lane] = u; sc[64 + lane] = g; sc[128 + lane] = expf(m - g); sc[192 + lane] = expf(-bs - g); sc[256 + lane] = expf(u - gL);
                if (lane == 0) sc[384] = expf(m - gL);
                m = bL + gL;
            }
            __syncthreads();
            { const int t = tid >> 3, sg = tid & 7; float acc[8];
#pragma unroll
                for (int i = 0; i < 8; ++i) acc[i] = 0.f;
                if (sg * 8 <= t) {
                    for (int d2 = 0; d2 < 128; ++d2) { const unsigned qw = qs[t * 128 + d2]; const float ql = bflo(qw), qh = bfhi(qw);
#pragma unroll
                        for (int i = 0; i < 8; ++i) { const unsigned kw = ks[(sg * 8 + i) * 128 + d2]; acc[i] += ql * bflo(kw) + qh * bfhi(kw); } } }
                const float gt = sc[64 + t];
#pragma unroll
                for (int i = 0; i < 8; ++i) { const int s = sg * 8 + i; Ps[t * 64 + s] = (s <= t) ? acc[i] * 0.0625f * expf(sc[s] - gt) : 0.f; } }
            __syncthreads();
            if (tid < 64) { const int t = tid; float qn = 0.f;
                for (int d2 = 0; d2 < 128; ++d2) { const unsigned qw = qs[t * 128 + d2]; qn += bflo(qw) * ns[2 * d2] + bfhi(qw) * ns[2 * d2 + 1]; }
                float ps = 0.f;
                for (int s = 0; s <= t; ++s) ps += Ps[t * 64 + s];
                sc[320 + t] = sc[128 + t] * qn + ps; }
            __syncthreads();
            { const int t = tid >> 3, eg = tid & 7; float acc[8];
#pragma unroll
                for (int i = 0; i < 8; ++i) acc[i] = 0.f;
                for (int d2 = 0; d2 < 128; ++d2) { const unsigned qw = qs[t * 128 + d2]; const float ql = bflo(qw), qh = bfhi(qw);
#pragma unroll
                    for (int i = 0; i < 8; ++i) acc[i] += ql * Cs[(2 * d2) * 64 + eg * 8 + i] + qh * Cs[(2 * d2 + 1) * 64 + eg * 8 + i]; }
                const float iw = sc[128 + t];
#pragma unroll
                for (int i = 0; i < 8; ++i) acc[i] *= iw;
                for (int s = 0; s <= t; ++s) { const float pv = Ps[t * 64 + s];
#pragma unroll
                    for (int i = 0; i < 8; ++i) acc[i] += pv * bf2f(vs[s * 64 + eg * 8 + i]); }
                const float dn = 1.0f / fmaxf(fabsf(sc[320 + t]), sc[192 + t]);
                u32x4 o; o.x = pk2(acc[0] * dn, acc[1] * dn); o.y = pk2(acc[2] * dn, acc[3] * dn); o.z = pk2(acc[4] * dn, acc[5] * dn); o.w = pk2(acc[6] * dn, acc[7] * dn);
                *(u32x4*)(V + (t0 + t) * DM + h * 256 + j * 64 + eg * 8) = o;
            }
            __syncthreads();
            { const int d = tid >> 1, eh = tid & 1; const float decay = sc[384]; float acc[32];
#pragma unroll
                for (int i = 0; i < 32; ++i) acc[i] = decay * Cs[d * 64 + eh * 32 + i];
                float nacc = decay * ns[d];
                for (int s = 0; s < 64; ++s) { const unsigned kw = ks[s * 128 + (d >> 1)]; const float kv = ((d & 1) ? bfhi(kw) : bflo(kw)) * 0.0625f * sc[256 + s];
                    nacc += kv;
#pragma unroll
                    for (int i = 0; i < 32; ++i) acc[i] += kv * bf2f(vs[s * 64 + eh * 32 + i]); }
#pragma unroll
                for (int i = 0; i < 32; ++i) Cs[d * 64 + eh * 32 + i] = acc[i];
                if (eh == 0) ns[d] = nacc; }
            __syncthreads();
        }
    }
}

__device__ void p3_gmlp_naive(const Params& P, LAS unsigned char* lds) {
    const int tid = threadIdx.x;
    bf16_t* PROJ = (bf16_t*)(P.ws + WS_PROJ);
    LAS bf16_t* vv = (LAS bf16_t*)lds;
    const float* WSP = P.in[I_W_SP]; const float* BSP = P.in[I_B_SP];
    for (int item = blockIdx.x; item < 2048; item += gridDim.x) {
        const int g = item & 7, c = (item >> 3) & 15, b = item >> 7; const size_t t0 = (size_t)b * SEQ + c * 128;
#pragma unroll
        for (int i = 0; i < 4; ++i) { const int p = tid + i * NTHR, r = p >> 4, cc = p & 15; *(LAS u32x4*)(vv + r * 128 + cc * 8) = *(const u32x4*)(PROJ + (t0 + r) * PROJW + 3 * DM + g * 128 + cc * 8); }
        __syncthreads();
        const int t = tid >> 2, dg = tid & 3; float acc[32];
#pragma unroll
        for (int i = 0; i < 32; ++i) acc[i] = 0.f;
        const float* wrow = WSP + ((size_t)g * 128 + t) * 128;
        for (int s = 0; s <= t; ++s) { const float w = wrow[s];
#pragma unroll
            for (int i = 0; i < 32; ++i) acc[i] += w * bf2f(vv[s * 128 + dg * 32 + i]); }
        const float bs = BSP[g * 128 + t];
        bf16_t* gu = PROJ + (t0 + t) * PROJW + 2 * DM + g * 128 + dg * 32;
#pragma unroll
        for (int i = 0; i < 4; ++i) { const u32x4 w = *(const u32x4*)(gu + i * 8); u32x4 o;
            o.x = pk2(bflo(w.x) * (acc[i * 8 + 0] + bs), bfhi(w.x) * (acc[i * 8 + 1] + bs)); o.y = pk2(bflo(w.y) * (acc[i * 8 + 2] + bs), bfhi(w.y) * (acc[i * 8 + 3] + bs));
            o.z = pk2(bflo(w.z) * (acc[i * 8 + 4] + bs), bfhi(w.z) * (acc[i * 8 + 5] + bs)); o.w = pk2(bflo(w.w) * (acc[i * 8 + 6] + bs), bfhi(w.w) * (acc[i * 8 + 7] + bs));
            *(u32x4*)(gu + i * 8) = o; }
        __syncthreads();
    }
}

__device__ void p4_ym(const Params& P, LAS unsigned char*) {
    const int tid = threadIdx.x, lane = tid & 63, wave = tid >> 6, h = wave & 3, half = wave >> 2;
    bf16_t* PROJ = (bf16_t*)(P.ws + WS_PROJ); const bf16_t* HM = (const bf16_t*)(P.ws + WS_XN);
    const int ch = h * 256 + lane * 4;
    float cw[4][4], cb[4], ng[4], sk[4];
#pragma unroll
    for (int j = 0; j < 4; ++j)
#pragma unroll
        for (int d = 0; d < 4; ++d) cw[j][d] = P.in[I_CONV_W][j * DM + ch + d];
#pragma unroll
    for (int d = 0; d < 4; ++d) { cb[d] = P.in[I_CONV_B][ch + d]; ng[d] = P.in[I_M_NORM_G][ch + d]; sk[d] = P.in[I_M_SKIP][ch + d]; }
    for (int item = blockIdx.x; item < NTOK / 16; item += gridDim.x) {
        const int tb = item * 16 + half * 8;
        float x0[4], x1[4], x2[4], x3[4];
        if ((tb & (SEQ - 1)) == 0) {
#pragma unroll
            for (int d = 0; d < 4; ++d) { x0[d] = 0.f; x1[d] = 0.f; x2[d] = 0.f; }
        } else { ld4(PROJ + (size_t)(tb - 3) * PROJW + ch, x0); ld4(PROJ + (size_t)(tb - 2) * PROJW + ch, x1); ld4(PROJ + (size_t)(tb - 1) * PROJW + ch, x2); }
#pragma unroll 1
        for (int i = 0; i < 8; ++i) {
            const int t = tb + i;
            ld4(PROJ + (size_t)t * PROJW + ch, x3);
            float hm[4], sz[4], y[4];
            ld4(HM + (size_t)t * DM + ch, hm); ld4(PROJ + (size_t)t * PROJW + DM + ch, sz);
            const float mu = wave_sum(hm[0] + hm[1] + hm[2] + hm[3]) * (1.f / 256.f);
            float s2 = 0.f;
#pragma unroll
            for (int d = 0; d < 4; ++d) { hm[d] -= mu; s2 += hm[d] * hm[d]; }
            const float r = 1.0f / sqrtf(wave_sum(s2) * (1.f / 256.f) + EPS);
#pragma unroll
            for (int d = 0; d < 4; ++d) { const float mc = siluf_(cw[0][d] * x0[d] + cw[1][d] * x1[d] + cw[2][d] * x2[d] + cw[3][d] * x3[d] + cb[d]);
                y[d] = (hm[d] * r * ng[d] + sk[d] * mc) * sz[d]; }
            st4(PROJ + (size_t)t * PROJW + DM + ch, y);
#pragma unroll
            for (int d = 0; d < 4; ++d) { x0[d] = x1[d]; x1[d] = x2[d]; x2[d] = x3[d]; }
        }
    }
}

__device__ void norm_pass(const float* xi, const float* y, const float* g1, float* xo, const float* g2, bf16_t* hn, int ldh, int hoff, const float* pin) {
    const int tid = threadIdx.x, lane = tid & 63, wave = tid >> 6;
    const int gw = blockIdx.x * NWAVES + wave, NGW = gridDim.x * NWAVES;
    for (int m = gw; m < NTOK; m += NGW) {
        const f32x4* yr = (const f32x4*)(y + (size_t)m * DM) + lane; const f32x4* xr = (const f32x4*)(xi + (size_t)m * DM) + lane; f32x4* orow = (f32x4*)(xo + (size_t)m * DM) + lane;
        f32x4 v[4]; float s = 0.f;
#pragma unroll
        for (int j = 0; j < 4; ++j) { v[j] = yr[64 * j]; s += (v[j].x * v[j].x + v[j].y * v[j].y) + (v[j].z * v[j].z + v[j].w * v[j].w); }
        const float r = 1.0f / sqrtf(wave_sum(s) * (1.f / DM) + EPS); float s2 = 0.f;
#pragma unroll
        for (int j = 0; j < 4; ++j) { const f32x4 gv = ((const f32x4*)g1 + lane)[64 * j]; v[j] = xr[64 * j] + v[j] * r * gv; orow[64 * j] = v[j];
            s2 += (v[j].x * v[j].x + v[j].y * v[j].y) + (v[j].z * v[j].z + v[j].w * v[j].w); }
        if (hn) {
            const float r2 = 1.0f / sqrtf(wave_sum(s2) * (1.f / DM) + EPS);
            u32x2* o8 = (u32x2*)(hn + (size_t)m * ldh + hoff) + lane;
#pragma unroll
            for (int j = 0; j < 4; ++j) { const f32x4 gv = ((const f32x4*)g2 + lane)[64 * j]; u32x2 o; o.x = pk2(v[j].x * r2 * gv.x, v[j].y * r2 * gv.y); o.y = pk2(v[j].z * r2 * gv.z, v[j].w * r2 * gv.w); o8[64 * j] = o; }
            if (pin) { const f32x4 pv = ((const f32x4*)(pin + (size_t)m * PLE))[lane]; u32x2 o; o.x = pk2(pv.x, pv.y); o.y = pk2(pv.z, pv.w); ((u32x2*)(hn + (size_t)m * ldh))[lane] = o; }
        }
    }
}

template <int PH> __global__ void __launch_bounds__(NTHR, 2) phase_kernel(Params P) {
    extern __shared__ __attribute__((aligned(16))) unsigned char lds_raw[];
    LAS unsigned char* lds = (LAS unsigned char*)lds_raw;
    unsigned char* ws = P.ws;
    if (PH == 0) p0_prologue(P, lds);
    if (PH == 2) p2_qkv(P, lds);
    if (PH == 3) { p3_mlstm_naive(P, lds); __syncthreads(); p3_gmlp_naive(P, lds); }
    if (PH == 4) p4_ym(P, lds);
    if (PH == 7) norm_pass(P.in[I_X], (const float*)(ws + WS_Y), P.in[I_MIX_POST_G], P.out, P.in[I_MLP_PRE_G], (bf16_t*)(ws + WS_XN), DM, 0, nullptr);
    if (PH == 10) norm_pass(P.out, (const float*)(ws + WS_Y), P.in[I_MLP_POST_G], P.out, P.in[I_PLE_PRE_G], (bf16_t*)(ws + WS_HB), PLEK, PLE, P.in[I_P]);
    if (PH == 12) norm_pass(P.out, (const float*)(ws + WS_Y), P.in[I_PLE_POST_G], P.out, nullptr, nullptr, 0, 0, nullptr);
}

constexpr int LDS_BYTES = 160 * 1024 - 1024;
static_assert(ML_BYTES <= LDS_BYTES, "mlstm lds");

template <int PH> static void launch_phase(const Params& P, int grid, hipStream_t stream) {
    static bool attr = false;
    if (!attr) { (void)hipFuncSetAttribute((const void*)phase_kernel<PH>, hipFuncAttributeMaxDynamicSharedMemorySize, LDS_BYTES); attr = true; }
    hipLaunchKernelGGL(phase_kernel<PH>, dim3(grid), dim3(NTHR), LDS_BYTES, stream, P);
}
template <class Epi> static void launch_gemm(const GemmDesc& g, const Epi& E, hipStream_t stream) {
    hipLaunchKernelGGL(gemm_simple<Epi>, dim3(g.N / 64, g.M / 64), dim3(256), 0, stream, g, E);
}

extern "C" void kernel_launch(void* const* d_in, const int* in_sizes, int n_in, void* d_out, int out_size, void* d_ws, size_t ws_size, hipStream_t stream) {
    if (n_in != 29 || out_size != NTOK * DM || ws_size < WS_END) { fprintf(stderr, "kernel_launch: unexpected shapes (n_in %d out %d ws %zu)\n", n_in, out_size, ws_size); return; }
    Params P{};
    for (int i = 0; i < 29; ++i) P.in[i] = (const float*)d_in[i];
    P.out = (float*)d_out; P.ws = (unsigned char*)d_ws;
    unsigned char* ws = P.ws;
    const int grid = 256;
    bf16_t* PROJ = (bf16_t*)(ws + WS_PROJ); bf16_t* XN = (bf16_t*)(ws + WS_XN);
    launch_phase<0>(P, grid, stream);
    { GemmDesc g{XN, (const bf16_t*)(ws + WS_WIN), DM, DM, NTOK, PROJW, DM, DM}; launch_gemm(g, EpiProj{PROJ}, stream); }
    launch_phase<2>(P, grid, stream);
    launch_phase<3>(P, grid, stream);
    launch_phase<4>(P, grid, stream);
    { GemmDesc g{PROJ + DM, (const bf16_t*)(ws + WS_WBR), PROJW, 2 * DM, NTOK, DM, 2 * DM, DM}; launch_gemm(g, EpiMerge{PROJ, XN}, stream); }
    { GemmDesc g{XN, (const bf16_t*)(ws + WS_WOUT), DM, DM, NTOK, DM, DM, DM}; launch_gemm(g, EpiF32{(float*)(ws + WS_Y), DM}, stream); }
    launch_phase<7>(P, grid, stream);
    { GemmDesc g{XN, (const bf16_t*)(ws + WS_WUP), DM, DM, NTOK, DFF, DM, DM}; launch_gemm(g, EpiRelu2{(bf16_t*)(ws + WS_HB), DFF}, stream); }
    { GemmDesc g{(const bf16_t*)(ws + WS_HB), (const bf16_t*)(ws + WS_WDN), DFF, DFF, NTOK, DM, DFF, DFF}; launch_gemm(g, EpiF32{(float*)(ws + WS_Y), DM}, stream); }
    launch_phase<10>(P, grid, stream);
    { GemmDesc g{(const bf16_t*)(ws + WS_HB), (const bf16_t*)(ws + WS_WPLE), PLEK, PLEK, NTOK, DM, PLEK, PLE}; launch_gemm(g, EpiPle{(float*)(ws + WS_Y)}, stream); }
    launch_phase<12>(P, grid, stream);
}
```

```cpp
#include <hip/hip_runtime.h>
#include <hip/hip_cooperative_groups.h>
#include <cstdio>
#include <cstdint>
#include <cmath>

#define LAS __attribute__((address_space(3)))
typedef unsigned short bf16_t;
typedef short bf16x8 __attribute__((ext_vector_type(8)));
typedef float f32x4 __attribute__((ext_vector_type(4)));
typedef unsigned u32x4 __attribute__((ext_vector_type(4)));
typedef unsigned u32x2 __attribute__((ext_vector_type(2)));

constexpr int NTOK = 32768, DM = 1024, SEQ = 2048, PROJW = 6144, DFF = 4096, PLE = 256, PLEK = PLE + DM;
constexpr float EPS = 1e-6f;
constexpr int NWAVES = 8, NTHR = 512;
constexpr size_t MiB = 1u << 20;
constexpr size_t WS_CTL = 0;
constexpr size_t WS_WIN = 1 * MiB;
constexpr size_t WS_WBR = 13 * MiB;
constexpr size_t WS_WOUT = 17 * MiB;
constexpr size_t WS_WUP = 19 * MiB;
constexpr size_t WS_WDN = 27 * MiB;
constexpr size_t WS_WPLE = 35 * MiB;
constexpr size_t WS_WCX = 38 * MiB;
constexpr size_t WS_GATES = 39 * MiB;
constexpr size_t WS_XN = 40 * MiB;
constexpr size_t WS_PROJ = 104 * MiB;
constexpr size_t WS_HB = WS_PROJ;
constexpr size_t WS_Y = WS_PROJ + 256 * MiB;
constexpr size_t WS_END = 488 * MiB;

struct Params {
    const float* in[29];
    float* out;
    unsigned char* ws;
};
enum { I_X = 0, I_P, I_MIX_PRE_G, I_W_IN, I_CONV_W, I_CONV_B, I_WQ, I_WK, I_WV, I_W_IF, I_B_IF, I_M_NORM_G, I_M_SKIP, I_G_LN_W, I_G_LN_B, I_W_SP, I_B_SP,
       I_W_BR_M, I_W_BR_G, I_W_OUT, I_MIX_POST_G, I_MLP_PRE_G, I_W_UP, I_W_DOWN, I_MLP_POST_G, I_PLE_PRE_G, I_W_PLE_GATE, I_W_PLE_PROJ, I_PLE_POST_G };

__device__ __forceinline__ unsigned f2bf(float f) { unsigned u = __builtin_bit_cast(unsigned, f); return (u + 0x7fffu + ((u >> 16) & 1u)) >> 16; }
__device__ __forceinline__ unsigned pk2(float lo, float hi) { return f2bf(lo) | (f2bf(hi) << 16); }
__device__ __forceinline__ float bflo(unsigned w) { return __builtin_bit_cast(float, w << 16); }
__device__ __forceinline__ float bfhi(unsigned w) { return __builtin_bit_cast(float, w & 0xffff0000u); }
__device__ __forceinline__ float bf2f(bf16_t h) { return __builtin_bit_cast(float, (unsigned)h << 16); }
__device__ __forceinline__ float sigmoidf_(float x) { return 1.0f / (1.0f + __expf(-x)); }
__device__ __forceinline__ float siluf_(float x) { return x * sigmoidf_(x); }
__device__ __forceinline__ float gelu_tanh(float x) { const float z = 0.7978845608028654f * (x + 0.044715f * x * x * x); return x * sigmoidf_(2.0f * z); }
__device__ __forceinline__ float log_sigmoid(float x) { return fminf(x, 0.f) - log1pf(expf(-fabsf(x))); }
__device__ __forceinline__ float wave_sum(float v) {
#pragma unroll
    for (int o = 1; o < 64; o <<= 1) v += __shfl_xor(v, o);
    return v;
}
#define LDS_WAIT() asm volatile("s_waitcnt lgkmcnt(0)" ::: "memory")

template <bool GATE_REMAP = false>
__device__ __forceinline__ void transpose_item(const float* W, int K, int N, bf16_t* WT, int ldw, int koff, LAS float* scr, int item, int lane) {
    const int nblk = N / 32, kb = item / nblk, nb = item % nblk, k0 = 64 * kb, n0 = 32 * nb;
    int r0 = n0; if (GATE_REMAP && n0 >= 4 * DM) { const int g = n0 - 4 * DM, j = g & (DM - 1); r0 = 4 * DM + (j >> 7) * 256 + (g >= DM ? 128 : 0) + (j & 127); }
#pragma unroll 8
    for (int i = 0; i < 32; ++i) { const int kk = 2 * i + (lane >> 5); scr[kk * 33 + (lane & 31)] = W[(size_t)(k0 + kk) * N + n0 + (lane & 31)]; }
    LDS_WAIT();
    const int c = lane & 7;
#pragma unroll
    for (int j = 0; j < 4; ++j) { const int n = (lane >> 3) + 8 * j; const LAS float* s = scr + (8 * c) * 33 + n;
        u32x4 o; o.x = pk2(s[0 * 33], s[1 * 33]); o.y = pk2(s[2 * 33], s[3 * 33]); o.z = pk2(s[4 * 33], s[5 * 33]); o.w = pk2(s[6 * 33], s[7 * 33]);
        *(u32x4*)(WT + (size_t)(r0 + n) * ldw + koff + k0 + 8 * c) = o; }
    LDS_WAIT();
}
__device__ __forceinline__ void rms_row_to_bf16(const float* xrow, const float* g, bf16_t* orow, int lane) {
    const f32x4* xr = (const f32x4*)xrow + lane; const f32x4* gr = (const f32x4*)g + lane;
    f32x4 v[4]; float s = 0.f;
#pragma unroll
    for (int j = 0; j < 4; ++j) { v[j] = xr[64 * j]; s += (v[j].x * v[j].x + v[j].y * v[j].y) + (v[j].z * v[j].z + v[j].w * v[j].w); }
    const float r = 1.0f / sqrtf(wave_sum(s) * (1.f / DM) + EPS);
    u32x2* o8 = (u32x2*)orow + lane;
#pragma unroll
    for (int j = 0; j < 4; ++j) { const f32x4 gv = gr[64 * j]; u32x2 o; o.x = pk2(v[j].x * r * gv.x, v[j].y * r * gv.y); o.y = pk2(v[j].z * r * gv.z, v[j].w * r * gv.w); o8[64 * j] = o; }
}
__device__ void p0_prologue(const Params& P, LAS unsigned char* lds) {
    const int tid = threadIdx.x, lane = tid & 63, wave = tid >> 6;
    LAS float* scr = (LAS float*)(lds + wave * 16384);
    const int gw = blockIdx.x * NWAVES + wave, NGW = gridDim.x * NWAVES;
    unsigned char* ws = P.ws;
    constexpr int I_IN = 16 * 192, I_SQ = 16 * 32, I_UP = 16 * 128, I_DN = 64 * 32, I_PP = 4 * 32;
    constexpr int NIT = I_IN + 4 * I_SQ + I_UP + I_DN + I_PP;
    for (int it = gw; it < NIT; it += NGW) {
        int r = it;
        if (r < I_IN) { transpose_item<true>(P.in[I_W_IN], DM, PROJW, (bf16_t*)(ws + WS_WIN), DM, 0, scr, r, lane); continue; } r -= I_IN;
        if (r < I_SQ) { transpose_item(P.in[I_W_BR_M], DM, DM, (bf16_t*)(ws + WS_WBR), 2 * DM, 0, scr, r, lane); continue; } r -= I_SQ;
        if (r < I_SQ) { transpose_item(P.in[I_W_BR_G], DM, DM, (bf16_t*)(ws + WS_WBR), 2 * DM, DM, scr, r, lane); continue; } r -= I_SQ;
        if (r < I_SQ) { transpose_item(P.in[I_W_OUT], DM, DM, (bf16_t*)(ws + WS_WOUT), DM, 0, scr, r, lane); continue; } r -= I_SQ;
        if (r < I_SQ) { transpose_item(P.in[I_W_PLE_GATE], DM, DM, (bf16_t*)(ws + WS_WPLE), PLEK, PLE, scr, r, lane); continue; } r -= I_SQ;
        if (r < I_UP) { transpose_item(P.in[I_W_UP], DM, DFF, (bf16_t*)(ws + WS_WUP), DM, 0, scr, r, lane); continue; } r -= I_UP;
        if (r < I_DN) { transpose_item(P.in[I_W_DOWN], DFF, DM, (bf16_t*)(ws + WS_WDN), DFF, 0, scr, r, lane); continue; } r -= I_DN;
        transpose_item(P.in[I_W_PLE_PROJ], PLE, DM, (bf16_t*)(ws + WS_WPLE), PLEK, 0, scr, r, lane);
    }
    {
        float* wcx = (float*)(ws + WS_WCX);
        const float* wq = P.in[I_WQ]; const float* wk = P.in[I_WK]; const float* wv = P.in[I_WV]; const float* wif = P.in[I_W_IF];
        for (int i = blockIdx.x * NTHR + tid; i < DM * 8; i += gridDim.x * NTHR) {
            const int c = i >> 3, j = i & 7, blk = c >> 2, d = c & 3; float sc = 0.f, sx = 0.f;
#pragma unroll
            for (int e = 0; e < 4; ++e) {
                sc += wq[blk * 16 + d * 4 + e] * wif[(size_t)(blk * 4 + e) * 8 + j] + wk[blk * 16 + d * 4 + e] * wif[(size_t)(DM + blk * 4 + e) * 8 + j];
                sx += wv[blk * 16 + d * 4 + e] * wif[(size_t)(2 * DM + blk * 4 + e) * 8 + j]; }
            wcx[i] = sc; wcx[DM * 8 + i] = sx;
        }
    }
    bf16_t* XN = (bf16_t*)(ws + WS_XN);
    for (int m = gw; m < NTOK; m += NGW) rms_row_to_bf16(P.in[I_X] + (size_t)m * DM, P.in[I_MIX_PRE_G], XN + (size_t)m * DM, lane);
}

namespace pg8 {
constexpr int BM = 256, BK = 64, HALF = 128, HTB = HALF * BK * 2, STAGE_BYTES = 8 * HTB, NXCD = 8, WGM = 8;
__host__ __device__ __forceinline__ int lds_byte(int r, int c) { const int st = (r >> 4) * 2 + (c >> 5), rr = r & 15, cc = c & 31, ob = rr * 64 + cc * 2; return st * 1024 + (ob ^ (((ob >> 9) & 1) << 5)); }
__host__ __device__ __forceinline__ void stage_rc(int b, int& R, int& C) { const int st = b / 1024, sb = b % 1024, swz = sb ^ (((sb >> 9) & 1) << 5); R = (st >> 1) * 16 + swz / 64; C = (st & 1) * 32 + (swz % 64) / 2; }
__host__ __device__ __forceinline__ int perm32(int rho) { const int n = rho >> 4, i = rho & 15; return 8 * (i >> 2) + 4 * n + (i & 3); }
struct Unit { int pm, pn; };
struct Gemm { const bf16_t* A; const bf16_t* Bt; int lda, ldb, M, N, K; };
struct StaticOrder {
    int nM, nN, nwg, G, c;
    __host__ __device__ void init(int M, int N, int G_, int c_) { nM = M / BM; nN = N / BM; nwg = nM * nN; G = G_; c = c_; }
    __host__ __device__ bool next(int i, Unit& u) const {
        const long L = (long)i * G + c; if (L >= nwg) return false;
        int wgid = (int)L; { const int q = nwg / NXCD, r = nwg % NXCD, xcd = wgid % NXCD, off = wgid / NXCD; wgid = (xcd < r ? xcd * (q + 1) : r * (q + 1) + (xcd - r) * q) + off; }
        const int nig = WGM * nN, gid = wgid / nig, fm = gid * WGM, gsz = (nM - fm) < WGM ? (nM - fm) : WGM;
        u.pm = fm + ((wgid % nig) % gsz); u.pn = (wgid % nig) / gsz; return true;
    }
};
template <class F> struct Epi8 {
    static constexpr bool PERM = true; F f;
    __device__ __forceinline__ void operator()(f32x4 (&acc)[2][2][4][2], const Unit& u_, int wr, int wc, int fr, int fq) const {
        Unit u = u_; asm volatile("" : "+s"(u.pm), "+s"(u.pn));
#pragma unroll
        for (int ai = 0; ai < 2; ++ai)
#pragma unroll
            for (int m = 0; m < 4; ++m)
                { f.store16(u.pm * BM + ai * HALF + wr * 64 + m * 16 + fr, u.pn, wc * 32 + 8 * fq, acc[ai][0][m][0], acc[ai][0][m][1], acc[ai][1][m][0], acc[ai][1][m][1]); asm volatile("" ::: "memory"); }
    }
    __device__ __forceinline__ void mid(f32x4 (&acc)[2][2][4][2], const Unit& u_, int wr, int wc, int fr, int fq) const {
        Unit u = u_; asm volatile("" : "+s"(u.pm), "+s"(u.pn));
#pragma unroll
        for (int ai = 0; ai < 2; ++ai)
#pragma unroll
            for (int m = 0; m < 4; ++m)
#pragma unroll
                for (int bj = 0; bj < 2; ++bj) { f.mid8(u.pm * BM + ai * HALF + wr * 64 + m * 16 + fr, u.pn * BM + bj * HALF + wc * 32 + 8 * fq, acc[ai][bj][m][0], acc[ai][bj][m][1]); asm volatile("" ::: "memory"); }
    }
};
template <class F> struct Epi4 {
    static constexpr bool PERM = false; F f;
    __device__ __forceinline__ void operator()(f32x4 (&acc)[2][2][4][2], const Unit& u_, int wr, int wc, int fr, int fq) const {
        Unit u = u_; asm volatile("" : "+s"(u.pm), "+s"(u.pn));
#pragma unroll
        for (int ai = 0; ai < 2; ++ai)
#pragma unroll
            for (int m = 0; m < 4; ++m)
#pragma unroll
                for (int bj = 0; bj < 2; ++bj)
#pragma unroll
                    for (int n = 0; n < 2; ++n) { f.store4(u.pm * BM + ai * HALF + wr * 64 + m * 16 + fr, u.pn * BM + bj * HALF + wc * 32 + 16 * n + 4 * fq, acc[ai][bj][m][n], ((ai * 4 + m) * 2 + bj) * 2 + n); if (n) asm volatile("" ::: "memory"); }
    }
    __device__ __forceinline__ void mid(f32x4 (&acc)[2][2][4][2], const Unit& u_, int wr, int wc, int fr, int fq) const {
        Unit u = u_; asm volatile("" : "+s"(u.pm), "+s"(u.pn));
#pragma unroll
        for (int ai = 0; ai < 2; ++ai)
#pragma unroll
            for (int m = 0; m < 4; ++m)
#pragma unroll
                for (int bj = 0; bj < 2; ++bj)
#pragma unroll
                    for (int n = 0; n < 2; ++n) { f.mid4(u.pm * BM + ai * HALF + wr * 64 + m * 16 + fr, u.pn * BM + bj * HALF + wc * 32 + 16 * n + 4 * fq, acc[ai][bj][m][n], ((ai * 4 + m) * 2 + bj) * 2 + n); if (n) asm volatile("" ::: "memory"); }
    }
};
template <class Epi, int HOOK_T, bool ALIGN_EPI>
__device__ __forceinline__ void gemm_phase(LAS unsigned char* lds, const Gemm g, const StaticOrder& S, const Epi& E) {
    const int tid = threadIdx.x, wid = __builtin_amdgcn_readfirstlane(tid >> 6), lane = tid & 63, wr = wid >> 2, wc = wid & 3, fr = lane & 15, fq = lane >> 4;
    const int K = g.K, nt = K / BK;
    unsigned voffA[2], voffB[2];
#pragma unroll
    for (int i = 0; i < 2; ++i) { int R, C; stage_rc(tid * 16 + i * 8192, R, C); const int Rb = Epi::PERM ? ((R & ~31) + perm32(R & 31)) : R;
        voffA[i] = (unsigned)(R * g.lda + C) * 2u; voffB[i] = (unsigned)(Rb * g.ldb + C) * 2u; }
    const size_t kstep = (size_t)(BK * 2);
    const size_t hstepA = (size_t)HALF * g.lda * 2, hstepB = (size_t)HALF * g.ldb * 2;
    const size_t tstepA = 2 * hstepA, tstepB = 2 * hstepB;
    const unsigned ldsw = (unsigned)wid * 1024u;
    const int aoff = lds_byte(wr * 64 + fr, fq * 8), boff = lds_byte(wc * 32 + fr, fq * 8);
#define PG8_SA(b, h) (((b) * 2 + (h)) * HTB)
#define PG8_SB(b, h) ((4 + (b) * 2 + (h)) * HTB)
#define PG8_STAGE(bufoff, gbase, voff) do { _Pragma("unroll") for (int _i = 0; _i < 2; ++_i) \
        __builtin_amdgcn_global_load_lds((const unsigned*)((const char*)(gbase) + (voff)[_i]), (LAS unsigned*)(lds + (bufoff) + ldsw + _i * 8192), 16, 0, 0); } while (0)
#define PG8_LDA(dst, b, h) do { _Pragma("unroll") for (int m = 0; m < 4; ++m) _Pragma("unroll") for (int k = 0; k < 2; ++k) dst[m][k] = *(const LAS bf16x8*)(lds + PG8_SA(b, h) + aoff + m * 2048 + k * 1024); } while (0)
#define PG8_LDB(dst, b, h) do { _Pragma("unroll") for (int n = 0; n < 2; ++n) _Pragma("unroll") for (int k = 0; k < 2; ++k) dst[n][k] = *(const LAS bf16x8*)(lds + PG8_SB(b, h) + boff + n * 2048 + k * 1024); } while (0)
#define PG8_MMA(ai, bj, At, Bt) do { __builtin_amdgcn_s_setprio(1); _Pragma("unroll") for (int m = 0; m < 4; ++m) _Pragma("unroll") for (int n = 0; n < 2; ++n) _Pragma("unroll") for (int k = 0; k < 2; ++k) \
        acc[ai][bj][m][n] = __builtin_amdgcn_mfma_f32_16x16x32_bf16(Bt[n][k], At[m][k], acc[ai][bj][m][n], 0, 0, 0); __builtin_amdgcn_s_setprio(0); } while (0)
#define PG8_WAIT_V(n) asm volatile("s_waitcnt vmcnt(" #n ")" ::: "memory")
#define PG8_WAIT_L(n) asm volatile("s_waitcnt lgkmcnt(" #n ")" ::: "memory")
#define PG8_BAR __builtin_amdgcn_s_barrier()
#define PG8_SCHED __builtin_amdgcn_sched_barrier(0)
    Unit cur, nxt; int ui = 0;
    if (!S.next(0, cur)) return;
    f32x4 acc[2][2][4][2];
#pragma unroll
    for (int a = 0; a < 2; ++a)
#pragma unroll
        for (int b = 0; b < 2; ++b)
#pragma unroll
            for (int m = 0; m < 4; ++m)
#pragma unroll
                for (int n = 0; n < 2; ++n) acc[a][b][m][n] = (f32x4){0.f, 0.f, 0.f, 0.f};
    bf16x8 At[4][2], B0[2][2], B1[2][2];
    const char* cA = (const char*)g.A + (size_t)cur.pm * tstepA; const char* cB = (const char*)g.Bt + (size_t)cur.pn * tstepB;
    PG8_STAGE(PG8_SB(0, 0), cB, voffB); PG8_STAGE(PG8_SB(0, 1), cB + hstepB, voffB); PG8_STAGE(PG8_SA(0, 0), cA, voffA); PG8_STAGE(PG8_SA(0, 1), cA + hstepA, voffA);
    if (wr == 1) PG8_BAR;
    PG8_WAIT_V(2); PG8_BAR;
    PG8_STAGE(PG8_SB(1, 0), cB + kstep, voffB); PG8_STAGE(PG8_SA(1, 0), cA + kstep, voffA); PG8_STAGE(PG8_SB(1, 1), cB + hstepB + kstep, voffB);
    PG8_WAIT_V(6); PG8_BAR;
    for (;;) {
        const bool has_next = S.next(ui + 1, nxt);
        const char* nA = has_next ? (const char*)g.A + (size_t)nxt.pm * tstepA : cA; const char* nB = has_next ? (const char*)g.Bt + (size_t)nxt.pn * tstepB : cB;
#define PG8_KBODY() do { \
            const bool last = (t == nt - 2); \
            const char* a1 = cA + (size_t)(t + 1) * kstep; \
            const char* a2 = last ? nA : cA + (size_t)(t + 2) * kstep; const char* b2 = last ? nB : cB + (size_t)(t + 2) * kstep; \
            const char* a3 = a2 + kstep; const char* b3 = b2 + kstep; \
            PG8_LDB(B0, 0, 0); PG8_LDB(B1, 0, 1); PG8_SCHED; PG8_LDA(At, 0, 0); PG8_STAGE(PG8_SA(1, 1), a1 + hstepA, voffA); \
            PG8_WAIT_V(8); PG8_WAIT_L(0); PG8_BAR; PG8_MMA(0, 0, At, B0); PG8_MMA(0, 1, At, B1); PG8_BAR; PG8_SCHED; \
            PG8_LDA(At, 0, 1); PG8_STAGE(PG8_SB(0, 0), b2, voffB); PG8_STAGE(PG8_SB(0, 1), b2 + hstepB, voffB); PG8_STAGE(PG8_SA(0, 0), a2, voffA); \
            PG8_WAIT_V(8); PG8_WAIT_L(0); PG8_BAR; PG8_MMA(1, 0, At, B0); PG8_MMA(1, 1, At, B1); PG8_BAR; PG8_SCHED; \
            PG8_LDB(B0, 1, 0); PG8_LDB(B1, 1, 1); PG8_SCHED; PG8_LDA(At, 1, 0); PG8_STAGE(PG8_SA(0, 1), a2 + hstepA, voffA); \
            PG8_WAIT_V(8); PG8_WAIT_L(0); PG8_BAR; PG8_MMA(0, 0, At, B0); PG8_MMA(0, 1, At, B1); PG8_BAR; PG8_SCHED; \
            PG8_LDA(At, 1, 1); PG8_STAGE(PG8_SB(1, 0), b3, voffB); PG8_STAGE(PG8_SB(1, 1), b3 + hstepB, voffB); PG8_STAGE(PG8_SA(1, 0), a3, voffA); \
            PG8_WAIT_V(8); PG8_WAIT_L(0); PG8_BAR; PG8_MMA(1, 0, At, B0); PG8_MMA(1, 1, At, B1); PG8_BAR; PG8_SCHED; \
        } while (0)
        int t = 0;
        if constexpr (HOOK_T > 0) {
            for (; t < HOOK_T; t += 2) PG8_KBODY();
            PG8_SCHED; E.mid(acc, cur, wr, wc, fr, fq); PG8_SCHED;
        }
        for (; t < nt; t += 2) PG8_KBODY();
#undef PG8_KBODY
        if constexpr (ALIGN_EPI) { if (wr == 0) PG8_BAR; }
        E(acc, cur, wr, wc, fr, fq);
        if (!has_next) break;
#pragma unroll
        for (int a = 0; a < 2; ++a)
#pragma unroll
            for (int b = 0; b < 2; ++b)
#pragma unroll
                for (int m = 0; m < 4; ++m)
#pragma unroll
                    for (int n = 0; n < 2; ++n) acc[a][b][m][n] = (f32x4){0.f, 0.f, 0.f, 0.f};
        cur = nxt; cA = nA; cB = nB; ++ui;
        if constexpr (ALIGN_EPI) { if (wr == 1) PG8_BAR; }
    }
    PG8_WAIT_V(0);
    if constexpr (!ALIGN_EPI) { if (wr == 0) PG8_BAR; }
    PG8_BAR;
#undef PG8_SA
#undef PG8_SB
#undef PG8_STAGE
#undef PG8_LDA
#undef PG8_LDB
#undef PG8_MMA
#undef PG8_WAIT_V
#undef PG8_WAIT_L
#undef PG8_BAR
#undef PG8_SCHED
}
}
__device__ __forceinline__ void st_bf16x8(bf16_t* p, f32x4 a, f32x4 b) { u32x4 o; o.x = pk2(a.x, a.y); o.y = pk2(a.z, a.w); o.z = pk2(b.x, b.y); o.w = pk2(b.z, b.w); *(u32x4*)p = o; }
__device__ __forceinline__ void ld_bf16x8(const bf16_t* p, f32x4& a, f32x4& b) { const u32x4 w = *(const u32x4*)p; a = (f32x4){bflo(w.x), bfhi(w.x), bflo(w.y), bfhi(w.y)}; b = (f32x4){bflo(w.z), bfhi(w.z), bflo(w.w), bfhi(w.w)}; }
template <class FN> __device__ __forceinline__ f32x4 map4(f32x4 v, FN fn) { return (f32x4){fn(v.x), fn(v.y), fn(v.z), fn(v.w)}; }
struct ProjF {
    bf16_t* proj;
    __device__ __forceinline__ void store16(int row, int pn, int cl, f32x4 a0, f32x4 a1, f32x4 b0, f32x4 b1) const {
        bf16_t* rp = proj + (size_t)row * PROJW;
        if (pn < 16) {
            const int sec = pn >> 2;
            if (sec == 1) { a0 = map4(a0, siluf_); a1 = map4(a1, siluf_); b0 = map4(b0, siluf_); b1 = map4(b1, siluf_); }
            else if (sec >= 2) { a0 = map4(a0, gelu_tanh); a1 = map4(a1, gelu_tanh); b0 = map4(b0, gelu_tanh); b1 = map4(b1, gelu_tanh); }
            st_bf16x8(rp + pn * 256 + cl, a0, a1); st_bf16x8(rp + pn * 256 + 128 + cl, b0, b1);
        } else {
            const int j = (pn - 16) * 128 + cl;
            a0 = map4(a0, sigmoidf_); a1 = map4(a1, sigmoidf_); b0 = map4(b0, sigmoidf_); b1 = map4(b1, sigmoidf_);
            st_bf16x8(rp + 4 * DM + j, a0 / b0, a1 / b1); st_bf16x8(rp + 5 * DM + j, b0, b1);
        }
    }
    __device__ __forceinline__ void mid8(int, int, f32x4&, f32x4&) const {}
};
struct MergeF {
    const bf16_t* proj; bf16_t* merged;
    __device__ __forceinline__ void mid8(int row, int col, f32x4& a, f32x4& b) const {
        f32x4 r0, r1; ld_bf16x8(proj + (size_t)row * PROJW + 4 * DM + col, r0, r1); a = a * r0; b = b * r1;
    }
    __device__ __forceinline__ void store16(int row, int pn, int cl, f32x4 a0, f32x4 a1, f32x4 b0, f32x4 b1) const {
        const int col = pn * 256 + cl; f32x4 g0, g1;
        ld_bf16x8(proj + (size_t)row * PROJW + 5 * DM + col, g0, g1); st_bf16x8(merged + (size_t)row * DM + col, a0 * g0, a1 * g1);
        ld_bf16x8(proj + (size_t)row * PROJW + 5 * DM + col + 128, g0, g1); st_bf16x8(merged + (size_t)row * DM + col + 128, b0 * g0, b1 * g1);
    }
};
struct F32F {
    float* o; int ldc;
    __device__ __forceinline__ void store4(int row, int col, f32x4 v, int) const { *(f32x4*)(o + (size_t)row * ldc + col) = v; }
    __device__ __forceinline__ void mid4(int, int, f32x4&, int) const {}
};
struct Relu2F {
    bf16_t* o; int ldc;
    __device__ __forceinline__ void store16(int row, int pn, int cl, f32x4 a0, f32x4 a1, f32x4 b0, f32x4 b1) const {
        auto r2 = [](float x) { const float r = fmaxf(x, 0.f); return r * r; };
        bf16_t* p = o + (size_t)row * ldc + pn * 256 + cl;
        st_bf16x8(p, map4(a0, r2), map4(a1, r2)); st_bf16x8(p + 128, map4(b0, r2), map4(b1, r2));
    }
    __device__ __forceinline__ void mid8(int, int, f32x4&, f32x4&) const {}
};
struct PleF {
    float* o; f32x4* stash;
    __device__ __forceinline__ void mid4(int, int, f32x4& v, int idx) const { unsigned t = threadIdx.x; asm volatile("" : "+v"(t)); stash[((size_t)blockIdx.x * 32 + idx) * NTHR + t] = v; v = (f32x4){0.f, 0.f, 0.f, 0.f}; }
    __device__ __forceinline__ void store4(int row, int col, f32x4 v, int idx) const {
        unsigned t = threadIdx.x; asm volatile("" : "+v"(t)); const f32x4 p = stash[((size_t)blockIdx.x * 32 + idx) * NTHR + t];
        *(f32x4*)(o + (size_t)row * DM + col) = map4(v, sigmoidf_) * p;
    }
};

__device__ __forceinline__ void ld4(const bf16_t* p, float (&x)[4]) { const u32x2 w = *(const u32x2*)p; x[0] = bflo(w.x); x[1] = bfhi(w.x); x[2] = bflo(w.y); x[3] = bfhi(w.y); }
__device__ __forceinline__ void st4(bf16_t* p, const float (&x)[4]) { u32x2 o; o.x = pk2(x[0], x[1]); o.y = pk2(x[2], x[3]); *(u32x2*)p = o; }
__device__ void p2_qkv(const Params& P, LAS unsigned char* lds) {
    const int tid = threadIdx.x, lane = tid & 63, wave = tid >> 6, h = wave & 3, half = wave >> 2;
    unsigned char* ws = P.ws;
    const bf16_t* PROJ = (const bf16_t*)(ws + WS_PROJ);
    bf16_t* Q = (bf16_t*)P.out; bf16_t* K = Q + (size_t)NTOK * DM; bf16_t* V = (bf16_t*)(ws + WS_XN);
    float* GATES = (float*)(ws + WS_GATES);
    LAS float* part = (LAS float*)lds;
    const int ch = h * 256 + lane * 4, blk = ch >> 2;
    float cw[4][4], cb[4], wq[4][4], wk[4][4], wv[4][4], wc[4][8], wx[4][8];
#pragma unroll
    for (int j = 0; j < 4; ++j)
#pragma unroll
        for (int d = 0; d < 4; ++d) cw[j][d] = P.in[I_CONV_W][j * DM + ch + d];
#pragma unroll
    for (int d = 0; d < 4; ++d) { cb[d] = P.in[I_CONV_B][ch + d];
#pragma unroll
        for (int e = 0; e < 4; ++e) { wq[d][e] = P.in[I_WQ][blk * 16 + d * 4 + e]; wk[d][e] = P.in[I_WK][blk * 16 + d * 4 + e]; wv[d][e] = P.in[I_WV][blk * 16 + d * 4 + e]; }
#pragma unroll
        for (int j = 0; j < 8; ++j) { wc[d][j] = ((const float*)(ws + WS_WCX))[(ch + d) * 8 + j]; wx[d][j] = ((const float*)(ws + WS_WCX))[DM * 8 + (ch + d) * 8 + j]; } }
    for (int item = blockIdx.x; item < NTOK / 16; item += gridDim.x) {
        const int tb = item * 16 + half * 8;
        float x0[4], x1[4], x2[4], x3[4];
        if ((tb & (SEQ - 1)) == 0) {
#pragma unroll
            for (int d = 0; d < 4; ++d) { x0[d] = 0.f; x1[d] = 0.f; x2[d] = 0.f; }
        } else { ld4(PROJ + (size_t)(tb - 3) * PROJW + ch, x0); ld4(PROJ + (size_t)(tb - 2) * PROJW + ch, x1); ld4(PROJ + (size_t)(tb - 1) * PROJW + ch, x2); }
#pragma unroll 1
        for (int i = 0; i < 8; ++i) {
            const int t = tb + i;
            ld4(PROJ + (size_t)t * PROJW + ch, x3);
            float mc[4], q[4], k[4], v[4], gp[8];
#pragma unroll
            for (int d = 0; d < 4; ++d) mc[d] = siluf_(cw[0][d] * x0[d] + cw[1][d] * x1[d] + cw[2][d] * x2[d] + cw[3][d] * x3[d] + cb[d]);
#pragma unroll
            for (int e = 0; e < 4; ++e) { q[e] = mc[0] * wq[0][e] + mc[1] * wq[1][e] + mc[2] * wq[2][e] + mc[3] * wq[3][e];
                k[e] = mc[0] * wk[0][e] + mc[1] * wk[1][e] + mc[2] * wk[2][e] + mc[3] * wk[3][e];
                v[e] = x3[0] * wv[0][e] + x3[1] * wv[1][e] + x3[2] * wv[2][e] + x3[3] * wv[3][e]; }
            st4(Q + (size_t)t * DM + ch, q); st4(K + (size_t)t * DM + ch, k); st4(V + (size_t)t * DM + ch, v);
#pragma unroll
            for (int j = 0; j < 8; ++j) { float s = 0.f;
#pragma unroll
                for (int d = 0; d < 4; ++d) s += mc[d] * wc[d][j] + x3[d] * wx[d][j];
                gp[j] = wave_sum(s); }
            if (lane == 0) {
#pragma unroll
                for (int j = 0; j < 8; ++j) part[((half * 8 + i) * 4 + h) * 8 + j] = gp[j]; }
#pragma unroll
            for (int d = 0; d < 4; ++d) { x0[d] = x1[d]; x1[d] = x2[d]; x2[d] = x3[d]; }
        }
        __syncthreads();
        if (tid < 128) { const int tok = tid >> 3, j = tid & 7;
            const float val = part[(tok * 4 + 0) * 8 + j] + part[(tok * 4 + 1) * 8 + j] + part[(tok * 4 + 2) * 8 + j] + part[(tok * 4 + 3) * 8 + j] + P.in[I_B_IF][j];
            GATES[(size_t)(item * 16 + tok) * 8 + j] = (j < 4) ? val : log_sigmoid(val); }
        __syncthreads();
    }
    bf16_t* PW = (bf16_t*)(ws + WS_PROJ);
    const int gw = blockIdx.x * NWAVES + wave, NGW = gridDim.x * NWAVES;
    for (int m = gw; m < NTOK; m += NGW) {
        bf16_t* row = PW + (size_t)m * PROJW + 3 * DM + lane * 16;
        const u32x4 a = *(const u32x4*)row, b = *(const u32x4*)(row + 8);
        float x[16] = {bflo(a.x), bfhi(a.x), bflo(a.y), bfhi(a.y), bflo(a.z), bfhi(a.z), bflo(a.w), bfhi(a.w), bflo(b.x), bfhi(b.x), bflo(b.y), bfhi(b.y), bflo(b.z), bfhi(b.z), bflo(b.w), bfhi(b.w)};
        float s = 0.f;
#pragma unroll
        for (int i = 0; i < 16; ++i) s += x[i];
        const float mu = wave_sum(s) * (1.f / DM); float s2 = 0.f;
#pragma unroll
        for (int i = 0; i < 16; ++i) { x[i] -= mu; s2 += x[i] * x[i]; }
        const float r = 1.0f / sqrtf(wave_sum(s2) * (1.f / DM) + EPS);
        const float* lw = P.in[I_G_LN_W] + lane * 16; const float* lb = P.in[I_G_LN_B] + lane * 16;
#pragma unroll
        for (int i = 0; i < 16; ++i) x[i] = x[i] * r * lw[i] + lb[i];
        u32x4 oa, ob; oa.x = pk2(x[0], x[1]); oa.y = pk2(x[2], x[3]); oa.z = pk2(x[4], x[5]); oa.w = pk2(x[6], x[7]); ob.x = pk2(x[8], x[9]); ob.y = pk2(x[10], x[11]); ob.z = pk2(x[12], x[13]); ob.w = pk2(x[14], x[15]);
        *(u32x4*)row = oa; *(u32x4*)(row + 8) = ob;
    }
}

constexpr int ML_C = 0, ML_N = 65536, ML_Q = ML_N + 1024, ML_K = ML_Q + 32768, ML_V = ML_K + 32768, ML_P = ML_V + 8192, ML_S = ML_P + 16384, ML_BYTES = ML_S + 2048;
__device__ void p3_mlstm_naive(const Params& P, LAS unsigned char* lds) {
    const int tid = threadIdx.x, lane = tid & 63, wave = tid >> 6;
    unsigned char* ws = P.ws;
    const bf16_t* Q = (const bf16_t*)P.out; const bf16_t* K = Q + (size_t)NTOK * DM; bf16_t* V = (bf16_t*)(ws + WS_XN);
    const float* GATES = (const float*)(ws + WS_GATES);
    LAS float* Cs = (LAS float*)(lds + ML_C); LAS float* ns = (LAS float*)(lds + ML_N);
    LAS unsigned* qs = (LAS unsigned*)(lds + ML_Q); LAS unsigned* ks = (LAS unsigned*)(lds + ML_K);
    LAS bf16_t* vs = (LAS bf16_t*)(lds + ML_V);
    LAS float* Ps = (LAS float*)(lds + ML_P);
    LAS float* sc = (LAS float*)(lds + ML_S);
    for (int item = blockIdx.x; item < 256; item += gridDim.x) {
        const int b = item >> 4, h = (item >> 2) & 3, j = item & 3;
        for (int i = tid; i < 256 * 64; i += NTHR) Cs[i] = 0.f;
        if (tid < 256) ns[tid] = 0.f;
        float m = 0.f;
        __syncthreads();
        for (int c = 0; c < 32; ++c) {
            const size_t t0 = (size_t)b * SEQ + c * 64;
#pragma unroll
            for (int i = 0; i < 4; ++i) { const int p = tid + i * NTHR, r = p >> 5, cc = p & 31;
                *(LAS u32x4*)(qs + r * 128 + cc * 4) = *(const u32x4*)(Q + (t0 + r) * DM + h * 256 + cc * 8);
                *(LAS u32x4*)(ks + r * 128 + cc * 4) = *(const u32x4*)(K + (t0 + r) * DM + h * 256 + cc * 8); }
            { const int r = tid >> 3, cc = tid & 7; *(LAS u32x4*)(vs + r * 64 + cc * 8) = *(const u32x4*)(V + (t0 + r) * DM + h * 256 + j * 64 + cc * 8); }
            if (wave == 0) {
                const float ig = GATES[(t0 + lane) * 8 + h], lf = GATES[(t0 + lane) * 8 + 4 + h];
                float bs = lf;
#pragma unroll
                for (int o = 1; o < 64; o <<= 1) { const float t = __shfl_up(bs, o); if (lane >= o) bs += t; }
                const float u = ig - bs; float gm = u;
#pragma unroll
                for (int o = 1; o < 64; o <<= 1) { const float t = __shfl_up(gm, o); if (lane >= o) gm = fmaxf(gm, t); }
                const float g = fmaxf(gm, m), gL = __shfl(g, 63), bL = __shfl(bs, 63);
                sc[lane] = u; sc[64 + lane] = g; sc[128 + lane] = expf(m - g); sc[192 + lane] = expf(-bs - g); sc[256 + lane] = expf(u - gL);
                if (lane == 0) sc[384] = expf(m - gL);
                m = bL + gL;
            }
            __syncthreads();
            { const int t = tid >> 3, sg = tid & 7; float acc[8];
#pragma unroll
                for (int i = 0; i < 8; ++i) acc[i] = 0.f;
                if (sg * 8 <= t) {
                    for (int d2 = 0; d2 < 128; ++d2) { const unsigned qw = qs[t * 128 + d2]; const float ql = bflo(qw), qh = bfhi(qw);
#pragma unroll
                        for (int i = 0; i < 8; ++i) { const unsigned kw = ks[(sg * 8 + i) * 128 + d2]; acc[i] += ql * bflo(kw) + qh * bfhi(kw); } } }
                const float gt = sc[64 + t];
#pragma unroll
                for (int i = 0; i < 8; ++i) { const int s = sg * 8 + i; Ps[t * 64 + s] = (s <= t) ? acc[i] * 0.0625f * expf(sc[s] - gt) : 0.f; } }
            __syncthreads();
            if (tid < 64) { const int t = tid; float qn = 0.f;
                for (int d2 = 0; d2 < 128; ++d2) { const unsigned qw = qs[t * 128 + d2]; qn += bflo(qw) * ns[2 * d2] + bfhi(qw) * ns[2 * d2 + 1]; }
                float ps = 0.f;
                for (int s = 0; s <= t; ++s) ps += Ps[t * 64 + s];
                sc[320 + t] = sc[128 + t] * qn + ps; }
            __syncthreads();
            { const int t = tid >> 3, eg = tid & 7; float acc[8];
#pragma unroll
                for (int i = 0; i < 8; ++i) acc[i] = 0.f;
                for (int d2 = 0; d2 < 128; ++d2) { const unsigned qw = qs[t * 128 + d2]; const float ql = bflo(qw), qh = bfhi(qw);
#pragma unroll
                    for (int i = 0; i < 8; ++i) acc[i] += ql * Cs[(2 * d2) * 64 + eg * 8 + i] + qh * Cs[(2 * d2 + 1) * 64 + eg * 8 + i]; }
                const float iw = sc[128 + t];
#pragma unroll
                for (int i = 0; i < 8; ++i) acc[i] *= iw;
                for (int s = 0; s <= t; ++s) { const float pv = Ps[t * 64 + s];
#pragma unroll
                    for (int i = 0; i < 8; ++i) acc[i] += pv * bf2f(vs[s * 64 + eg * 8 + i]); }
                const float dn = 1.0f / fmaxf(fabsf(sc[320 + t]), sc[192 + t]);
                u32x4 o; o.x = pk2(acc[0] * dn, acc[1] * dn); o.y = pk2(acc[2] * dn, acc[3] * dn); o.z = pk2(acc[4] * dn, acc[5] * dn); o.w = pk2(acc[6] * dn, acc[7] * dn);
                *(u32x4*)(V + (t0 + t) * DM + h * 256 + j * 64 + eg * 8) = o;
            }
            __syncthreads();
            { const int d = tid >> 1, eh = tid & 1; const float decay = sc[384]; float acc[32];
#pragma unroll
                for (int i = 0; i < 32; ++i) acc[i] = decay * Cs[d * 64 + eh * 32 + i];
                float nacc = decay * ns[d];
                for (int s = 0; s < 64; ++s) { const unsigned kw = ks[s * 128 + (d >> 1)]; const float kv = ((d & 1) ? bfhi(kw) : bflo(kw)) * 0.0625f * sc[256 + s];
                    nacc += kv;
#pragma unroll
                    for (int i = 0; i < 32; ++i) acc[i] += kv * bf2f(vs[s * 64 + eh * 32 + i]); }
#pragma unroll
                for (int i = 0; i < 32; ++i) Cs[d * 64 + eh * 32 + i] = acc[i];
                if (eh == 0) ns[d] = nacc; }
            __syncthreads();
        }
    }
}

__device__ void p3_gmlp_naive(const Params& P, LAS unsigned char* lds) {
    const int tid = threadIdx.x;
    bf16_t* PROJ = (bf16_t*)(P.ws + WS_PROJ);
    LAS bf16_t* vv = (LAS bf16_t*)lds;
    const float* WSP = P.in[I_W_SP]; const float* BSP = P.in[I_B_SP];
    for (int item = blockIdx.x; item < 2048; item += gridDim.x) {
        const int g = item & 7, c = (item >> 3) & 15, b = item >> 7; const size_t t0 = (size_t)b * SEQ + c * 128;
#pragma unroll
        for (int i = 0; i < 4; ++i) { const int p = tid + i * NTHR, r = p >> 4, cc = p & 15; *(LAS u32x4*)(vv + r * 128 + cc * 8) = *(const u32x4*)(PROJ + (t0 + r) * PROJW + 3 * DM + g * 128 + cc * 8); }
        __syncthreads();
        const int t = tid >> 2, dg = tid & 3; float acc[32];
#pragma unroll
        for (int i = 0; i < 32; ++i) acc[i] = 0.f;
        const float* wrow = WSP + ((size_t)g * 128 + t) * 128;
        for (int s = 0; s <= t; ++s) { const float w = wrow[s];
#pragma unroll
            for (int i = 0; i < 32; ++i) acc[i] += w * bf2f(vv[s * 128 + dg * 32 + i]); }
        const float bs = BSP[g * 128 + t];
        bf16_t* gu = PROJ + (t0 + t) * PROJW + 2 * DM + g * 128 + dg * 32;
#pragma unroll
        for (int i = 0; i < 4; ++i) { const u32x4 w = *(const u32x4*)(gu + i * 8); u32x4 o;
            o.x = pk2(bflo(w.x) * (acc[i * 8 + 0] + bs), bfhi(w.x) * (acc[i * 8 + 1] + bs)); o.y = pk2(bflo(w.y) * (acc[i * 8 + 2] + bs), bfhi(w.y) * (acc[i * 8 + 3] + bs));
            o.z = pk2(bflo(w.z) * (acc[i * 8 + 4] + bs), bfhi(w.z) * (acc[i * 8 + 5] + bs)); o.w = pk2(bflo(w.w) * (acc[i * 8 + 6] + bs), bfhi(w.w) * (acc[i * 8 + 7] + bs));
            *(u32x4*)(gu + i * 8) = o; }
        __syncthreads();
    }
}

__device__ void p4_ym(const Params& P, LAS unsigned char*) {
    const int tid = threadIdx.x, lane = tid & 63, wave = tid >> 6, h = wave & 3, half = wave >> 2;
    bf16_t* PROJ = (bf16_t*)(P.ws + WS_PROJ); const bf16_t* HM = (const bf16_t*)(P.ws + WS_XN);
    const int ch = h * 256 + lane * 4;
    float cw[4][4], cb[4], ng[4], sk[4];
#pragma unroll
    for (int j = 0; j < 4; ++j)
#pragma unroll
        for (int d = 0; d < 4; ++d) cw[j][d] = P.in[I_CONV_W][j * DM + ch + d];
#pragma unroll
    for (int d = 0; d < 4; ++d) { cb[d] = P.in[I_CONV_B][ch + d]; ng[d] = P.in[I_M_NORM_G][ch + d]; sk[d] = P.in[I_M_SKIP][ch + d]; }
    for (int item = blockIdx.x; item < NTOK / 16; item += gridDim.x) {
        const int tb = item * 16 + half * 8;
        float x0[4], x1[4], x2[4], x3[4];
        if ((tb & (SEQ - 1)) == 0) {
#pragma unroll
            for (int d = 0; d < 4; ++d) { x0[d] = 0.f; x1[d] = 0.f; x2[d] = 0.f; }
        } else { ld4(PROJ + (size_t)(tb - 3) * PROJW + ch, x0); ld4(PROJ + (size_t)(tb - 2) * PROJW + ch, x1); ld4(PROJ + (size_t)(tb - 1) * PROJW + ch, x2); }
#pragma unroll 1
        for (int i = 0; i < 8; ++i) {
            const int t = tb + i;
            ld4(PROJ + (size_t)t * PROJW + ch, x3);
            float hm[4], sz[4], y[4];
            ld4(HM + (size_t)t * DM + ch, hm); ld4(PROJ + (size_t)t * PROJW + DM + ch, sz);
            const float mu = wave_sum(hm[0] + hm[1] + hm[2] + hm[3]) * (1.f / 256.f);
            float s2 = 0.f;
#pragma unroll
            for (int d = 0; d < 4; ++d) { hm[d] -= mu; s2 += hm[d] * hm[d]; }
            const float r = 1.0f / sqrtf(wave_sum(s2) * (1.f / 256.f) + EPS);
#pragma unroll
            for (int d = 0; d < 4; ++d) { const float mc = siluf_(cw[0][d] * x0[d] + cw[1][d] * x1[d] + cw[2][d] * x2[d] + cw[3][d] * x3[d] + cb[d]);
                y[d] = (hm[d] * r * ng[d] + sk[d] * mc) * sz[d]; }
            st4(PROJ + (size_t)t * PROJW + DM + ch, y);
#pragma unroll
            for (int d = 0; d < 4; ++d) { x0[d] = x1[d]; x1[d] = x2[d]; x2[d] = x3[d]; }
        }
    }
}

__device__ void norm_pass(const float* xi, const float* y, const float* g1, float* xo, const float* g2, bf16_t* hn, int ldh, int hoff, const float* pin) {
    const int tid = threadIdx.x, lane = tid & 63, wave = tid >> 6;
    const int gw = blockIdx.x * NWAVES + wave, NGW = gridDim.x * NWAVES;
    for (int m = gw; m < NTOK; m += NGW) {
        const f32x4* yr = (const f32x4*)(y + (size_t)m * DM) + lane; const f32x4* xr = (const f32x4*)(xi + (size_t)m * DM) + lane; f32x4* orow = (f32x4*)(xo + (size_t)m * DM) + lane;
        f32x4 v[4]; float s = 0.f;
#pragma unroll
        for (int j = 0; j < 4; ++j) { v[j] = yr[64 * j]; s += (v[j].x * v[j].x + v[j].y * v[j].y) + (v[j].z * v[j].z + v[j].w * v[j].w); }
        const float r = 1.0f / sqrtf(wave_sum(s) * (1.f / DM) + EPS); float s2 = 0.f;
#pragma unroll
        for (int j = 0; j < 4; ++j) { const f32x4 gv = ((const f32x4*)g1 + lane)[64 * j]; v[j] = xr[64 * j] + v[j] * r * gv; orow[64 * j] = v[j];
            s2 += (v[j].x * v[j].x + v[j].y * v[j].y) + (v[j].z * v[j].z + v[j].w * v[j].w); }
        if (hn) {
            const float r2 = 1.0f / sqrtf(wave_sum(s2) * (1.f / DM) + EPS);
            u32x2* o8 = (u32x2*)(hn + (size_t)m * ldh + hoff) + lane;
#pragma unroll
            for (int j = 0; j < 4; ++j) { const f32x4 gv = ((const f32x4*)g2 + lane)[64 * j]; u32x2 o; o.x = pk2(v[j].x * r2 * gv.x, v[j].y * r2 * gv.y); o.y = pk2(v[j].z * r2 * gv.z, v[j].w * r2 * gv.w); o8[64 * j] = o; }
            if (pin) { const f32x4 pv = ((const f32x4*)(pin + (size_t)m * PLE))[lane]; u32x2 o; o.x = pk2(pv.x, pv.y); o.y = pk2(pv.z, pv.w); ((u32x2*)(hn + (size_t)m * ldh))[lane] = o; }
        }
    }
}

#ifndef MEGA
#define MEGA 1
#endif
namespace cg = cooperative_groups;
constexpr int NPHASE = 13;
constexpr int LDS_BYTES = 160 * 1024 - 1024;
static_assert(ML_BYTES <= LDS_BYTES && pg8::STAGE_BYTES <= LDS_BYTES, "lds");

template <int LO, int HI> __global__ void __launch_bounds__(NTHR, 2) fwd_kernel(Params P) {
    extern __shared__ __attribute__((aligned(16))) unsigned char lds_raw[];
    LAS unsigned char* lds = (LAS unsigned char*)lds_raw;
    unsigned char* ws = P.ws;
    bf16_t* PROJ = (bf16_t*)(ws + WS_PROJ); bf16_t* XN = (bf16_t*)(ws + WS_XN); bf16_t* HB = (bf16_t*)(ws + WS_HB); float* Y = (float*)(ws + WS_Y);
    const int G = gridDim.x, bid = blockIdx.x;
#define IN(k) (LO <= (k) && (k) < HI)
#define SEAM(k) do { if (IN(k) && IN((k) + 1)) cg::this_grid().sync(); } while (0)
    if (IN(0)) p0_prologue(P, lds);
    SEAM(0);
    if (IN(1)) { pg8::Gemm g{XN, (const bf16_t*)(ws + WS_WIN), DM, DM, NTOK, PROJW, DM}; pg8::StaticOrder S; S.init(NTOK, PROJW, G, bid);
        pg8::Epi8<ProjF> E{ProjF{PROJ}}; pg8::gemm_phase<pg8::Epi8<ProjF>, -1, true>(lds, g, S, E); }
    SEAM(1);
    if (IN(2)) p2_qkv(P, lds);
    SEAM(2);
    if (IN(3)) { p3_mlstm_naive(P, lds); __syncthreads(); p3_gmlp_naive(P, lds); }
    SEAM(3);
    if (IN(4)) p4_ym(P, lds);
    SEAM(4);
    if (IN(5)) { pg8::Gemm g{PROJ + DM, (const bf16_t*)(ws + WS_WBR), PROJW, 2 * DM, NTOK, DM, 2 * DM}; pg8::StaticOrder S; S.init(NTOK, DM, G, bid);
        pg8::Epi8<MergeF> E{MergeF{PROJ, XN}}; pg8::gemm_phase<pg8::Epi8<MergeF>, 16, true>(lds, g, S, E); }
    SEAM(5);
    if (IN(6)) { pg8::Gemm g{XN, (const bf16_t*)(ws + WS_WOUT), DM, DM, NTOK, DM, DM}; pg8::StaticOrder S; S.init(NTOK, DM, G, bid);
        pg8::Epi4<F32F> E{F32F{Y, DM}}; pg8::gemm_phase<pg8::Epi4<F32F>, -1, true>(lds, g, S, E); }
    SEAM(6);
    if (IN(7)) norm_pass(P.in[I_X], Y, P.in[I_MIX_POST_G], P.out, P.in[I_MLP_PRE_G], XN, DM, 0, nullptr);
    SEAM(7);
    if (IN(8)) { pg8::Gemm g{XN, (const bf16_t*)(ws + WS_WUP), DM, DM, NTOK, DFF, DM}; pg8::StaticOrder S; S.init(NTOK, DFF, G, bid);
        pg8::Epi8<Relu2F> E{Relu2F{HB, DFF}}; pg8::gemm_phase<pg8::Epi8<Relu2F>, -1, true>(lds, g, S, E); }
    SEAM(8);
    if (IN(9)) { pg8::Gemm g{HB, (const bf16_t*)(ws + WS_WDN), DFF, DFF, NTOK, DM, DFF}; pg8::StaticOrder S; S.init(NTOK, DM, G, bid);
        pg8::Epi4<F32F> E{F32F{Y, DM}}; pg8::gemm_phase<pg8::Epi4<F32F>, -1, true>(lds, g, S, E); }
    SEAM(9);
    if (IN(10)) norm_pass(P.out, Y, P.in[I_MLP_POST_G], P.out, P.in[I_PLE_PRE_G], HB, PLEK, PLE, P.in[I_P]);
    SEAM(10);
    if (IN(11)) { pg8::Gemm g{HB, (const bf16_t*)(ws + WS_WPLE), PLEK, PLEK, NTOK, DM, PLEK}; pg8::StaticOrder S; S.init(NTOK, DM, G, bid);
        pg8::Epi4<PleF> E{PleF{Y, (f32x4*)(ws + WS_XN)}}; pg8::gemm_phase<pg8::Epi4<PleF>, 4, true>(lds, g, S, E); }
    SEAM(11);
    if (IN(12)) norm_pass(P.out, Y, P.in[I_PLE_POST_G], P.out, nullptr, nullptr, 0, 0, nullptr);
#undef IN
#undef SEAM
}

template <int LO, int HI> static void launch_range(const Params& P, int grid, hipStream_t stream, bool coop) {
    static bool attr = false;
    if (!attr) { (void)hipFuncSetAttribute((const void*)fwd_kernel<LO, HI>, hipFuncAttributeMaxDynamicSharedMemorySize, LDS_BYTES); attr = true; }
    if (coop) {
        Params p = P; void* args[] = {&p};
        const hipError_t e = hipLaunchCooperativeKernel((const void*)fwd_kernel<LO, HI>, dim3(grid), dim3(NTHR), args, LDS_BYTES, stream);
        if (e != hipSuccess) fprintf(stderr, "cooperative launch failed: %s (grid %d)\n", hipGetErrorString(e), grid);
    } else hipLaunchKernelGGL((fwd_kernel<LO, HI>), dim3(grid), dim3(NTHR), LDS_BYTES, stream, P);
}
template <int I> static void launch_each(const Params& P, int grid, hipStream_t stream) {
    if constexpr (I < NPHASE) { launch_range<I, I + 1>(P, grid, stream, false); launch_each<I + 1>(P, grid, stream); }
}

extern "C" void kernel_launch(void* const* d_in, const int* in_sizes, int n_in, void* d_out, int out_size, void* d_ws, size_t ws_size, hipStream_t stream) {
    if (n_in != 29 || out_size != NTOK * DM || ws_size < WS_END) { fprintf(stderr, "kernel_launch: unexpected shapes (n_in %d out %d ws %zu)\n", n_in, out_size, ws_size); return; }
    Params P{};
    for (int i = 0; i < 29; ++i) P.in[i] = (const float*)d_in[i];
    P.out = (float*)d_out; P.ws = (unsigned char*)d_ws;
#if MEGA
    static int grid = 0;
    if (!grid) {
        int dev = 0, cus = 0, per_cu = 0;
        (void)hipGetDevice(&dev); (void)hipDeviceGetAttribute(&cus, hipDeviceAttributeMultiprocessorCount, dev);
        (void)hipFuncSetAttribute((const void*)fwd_kernel<0, NPHASE>, hipFuncAttributeMaxDynamicSharedMemorySize, LDS_BYTES);
        (void)hipOccupancyMaxActiveBlocksPerMultiprocessor(&per_cu, (const void*)fwd_kernel<0, NPHASE>, NTHR, LDS_BYTES);
        if (per_cu < 1) per_cu = 1;
        grid = cus;
        if (grid > cus * per_cu) grid = cus * per_cu;
    }
    launch_range<0, NPHASE>(P, grid, stream, true);
#else
    launch_each<0>(P, 256, stream);
#endif
}
```

```cpp
#include <hip/hip_runtime.h>
#include <hip/hip_cooperative_groups.h>
#include <cstdio>
#include <cstdint>
#include <cmath>

#define LAS __attribute__((address_space(3)))
typedef unsigned short bf16_t;
typedef short bf16x8 __attribute__((ext_vector_type(8)));
typedef float f32x4 __attribute__((ext_vector_type(4)));
typedef unsigned u32x4 __attribute__((ext_vector_type(4)));
typedef unsigned u32x2 __attribute__((ext_vector_type(2)));

constexpr int NTOK = 32768, DM = 1024, SEQ = 2048, PROJW = 6144, DFF = 4096, PLE = 256, PLEK = PLE + DM;
constexpr float EPS = 1e-6f;
constexpr int NWAVES = 8, NTHR = 512;
constexpr size_t MiB = 1u << 20;
constexpr size_t WS_CTL = 0;
constexpr size_t WS_WIN = 1 * MiB;
constexpr size_t WS_WBR = 13 * MiB;
constexpr size_t WS_WOUT = 17 * MiB;
constexpr size_t WS_WUP = 19 * MiB;
constexpr size_t WS_WDN = 27 * MiB;
constexpr size_t WS_WPLE = 35 * MiB;
constexpr size_t WS_WCX = 38 * MiB;
constexpr size_t WS_GATES = 39 * MiB;
constexpr size_t WS_XN = 40 * MiB;
constexpr size_t WS_PROJ = 104 * MiB;
constexpr size_t WS_HB = WS_PROJ;
constexpr size_t WS_Y = WS_PROJ + 256 * MiB;
constexpr size_t WS_END = 488 * MiB;

struct Params {
    const float* in[29];
    float* out;
    unsigned char* ws;
};
enum { I_X = 0, I_P, I_MIX_PRE_G, I_W_IN, I_CONV_W, I_CONV_B, I_WQ, I_WK, I_WV, I_W_IF, I_B_IF, I_M_NORM_G, I_M_SKIP, I_G_LN_W, I_G_LN_B, I_W_SP, I_B_SP,
       I_W_BR_M, I_W_BR_G, I_W_OUT, I_MIX_POST_G, I_MLP_PRE_G, I_W_UP, I_W_DOWN, I_MLP_POST_G, I_PLE_PRE_G, I_W_PLE_GATE, I_W_PLE_PROJ, I_PLE_POST_G };

__device__ __forceinline__ unsigned f2bf(float f) { unsigned u = __builtin_bit_cast(unsigned, f); return (u + 0x7fffu + ((u >> 16) & 1u)) >> 16; }
__device__ __forceinline__ unsigned pk2(float lo, float hi) { return f2bf(lo) | (f2bf(hi) << 16); }
__device__ __forceinline__ float bflo(unsigned w) { return __builtin_bit_cast(float, w << 16); }
__device__ __forceinline__ float bfhi(unsigned w) { return __builtin_bit_cast(float, w & 0xffff0000u); }
__device__ __forceinline__ float bf2f(bf16_t h) { return __builtin_bit_cast(float, (unsigned)h << 16); }
__device__ __forceinline__ float sigmoidf_(float x) { return 1.0f / (1.0f + __expf(-x)); }
__device__ __forceinline__ float siluf_(float x) { return x * sigmoidf_(x); }
__device__ __forceinline__ float gelu_tanh(float x) { const float z = 0.7978845608028654f * (x + 0.044715f * x * x * x); return x * sigmoidf_(2.0f * z); }
__device__ __forceinline__ float log_sigmoid(float x) { return fminf(x, 0.f) - log1pf(expf(-fabsf(x))); }
__device__ __forceinline__ float wave_sum(float v) {
#pragma unroll
    for (int o = 1; o < 64; o <<= 1) v += __shfl_xor(v, o);
    return v;
}
#define LDS_WAIT() asm volatile("s_waitcnt lgkmcnt(0)" ::: "memory")

template <bool GATE_REMAP = false>
__device__ __forceinline__ void transpose_item(const float* W, int K, int N, bf16_t* WT, int ldw, int koff, LAS float* scr, int item, int lane) {
    const int nblk = N / 32, kb = item / nblk, nb = item % nblk, k0 = 64 * kb, n0 = 32 * nb;
    int r0 = n0; if (GATE_REMAP && n0 >= 4 * DM) { const int g = n0 - 4 * DM, j = g & (DM - 1); r0 = 4 * DM + (j >> 7) * 256 + (g >= DM ? 128 : 0) + (j & 127); }
#pragma unroll 8
    for (int i = 0; i < 32; ++i) { const int kk = 2 * i + (lane >> 5); scr[kk * 33 + (lane & 31)] = W[(size_t)(k0 + kk) * N + n0 + (lane & 31)]; }
    LDS_WAIT();
    const int c = lane & 7;
#pragma unroll
    for (int j = 0; j < 4; ++j) { const int n = (lane >> 3) + 8 * j; const LAS float* s = scr + (8 * c) * 33 + n;
        u32x4 o; o.x = pk2(s[0 * 33], s[1 * 33]); o.y = pk2(s[2 * 33], s[3 * 33]); o.z = pk2(s[4 * 33], s[5 * 33]); o.w = pk2(s[6 * 33], s[7 * 33]);
        *(u32x4*)(WT + (size_t)(r0 + n) * ldw + koff + k0 + 8 * c) = o; }
    LDS_WAIT();
}
__device__ __forceinline__ void rms_row_to_bf16(const float* xrow, const float* g, bf16_t* orow, int lane) {
    const f32x4* xr = (const f32x4*)xrow + lane; const f32x4* gr = (const f32x4*)g + lane;
    f32x4 v[4]; float s = 0.f;
#pragma unroll
    for (int j = 0; j < 4; ++j) { v[j] = xr[64 * j]; s += (v[j].x * v[j].x + v[j].y * v[j].y) + (v[j].z * v[j].z + v[j].w * v[j].w); }
    const float r = 1.0f / sqrtf(wave_sum(s) * (1.f / DM) + EPS);
    u32x2* o8 = (u32x2*)orow + lane;
#pragma unroll
    for (int j = 0; j < 4; ++j) { const f32x4 gv = gr[64 * j]; u32x2 o; o.x = pk2(v[j].x * r * gv.x, v[j].y * r * gv.y); o.y = pk2(v[j].z * r * gv.z, v[j].w * r * gv.w); o8[64 * j] = o; }
}
__device__ void p0_prologue(const Params& P, LAS unsigned char* lds) {
    const int tid = threadIdx.x, lane = tid & 63, wave = tid >> 6;
    LAS float* scr = (LAS float*)(lds + wave * 16384);
    const int gw = blockIdx.x * NWAVES + wave, NGW = gridDim.x * NWAVES;
    unsigned char* ws = P.ws;
    constexpr int I_IN = 16 * 192, I_SQ = 16 * 32, I_UP = 16 * 128, I_DN = 64 * 32, I_PP = 4 * 32;
    constexpr int NIT = I_IN + 4 * I_SQ + I_UP + I_DN + I_PP;
    for (int it = gw; it < NIT; it += NGW) {
        int r = it;
        if (r < I_IN) { transpose_item<true>(P.in[I_W_IN], DM, PROJW, (bf16_t*)(ws + WS_WIN), DM, 0, scr, r, lane); continue; } r -= I_IN;
        if (r < I_SQ) { transpose_item(P.in[I_W_BR_M], DM, DM, (bf16_t*)(ws + WS_WBR), 2 * DM, 0, scr, r, lane); continue; } r -= I_SQ;
        if (r < I_SQ) { transpose_item(P.in[I_W_BR_G], DM, DM, (bf16_t*)(ws + WS_WBR), 2 * DM, DM, scr, r, lane); continue; } r -= I_SQ;
        if (r < I_SQ) { transpose_item(P.in[I_W_OUT], DM, DM, (bf16_t*)(ws + WS_WOUT), DM, 0, scr, r, lane); continue; } r -= I_SQ;
        if (r < I_SQ) { transpose_item(P.in[I_W_PLE_GATE], DM, DM, (bf16_t*)(ws + WS_WPLE), PLEK, PLE, scr, r, lane); continue; } r -= I_SQ;
        if (r < I_UP) { transpose_item(P.in[I_W_UP], DM, DFF, (bf16_t*)(ws + WS_WUP), DM, 0, scr, r, lane); continue; } r -= I_UP;
        if (r < I_DN) { transpose_item(P.in[I_W_DOWN], DFF, DM, (bf16_t*)(ws + WS_WDN), DFF, 0, scr, r, lane); continue; } r -= I_DN;
        transpose_item(P.in[I_W_PLE_PROJ], PLE, DM, (bf16_t*)(ws + WS_WPLE), PLEK, 0, scr, r, lane);
    }
    {
        float* wcx = (float*)(ws + WS_WCX);
        const float* wq = P.in[I_WQ]; const float* wk = P.in[I_WK]; const float* wv = P.in[I_WV]; const float* wif = P.in[I_W_IF];
        for (int i = blockIdx.x * NTHR + tid; i < DM * 8; i += gridDim.x * NTHR) {
            const int c = i >> 3, j = i & 7, blk = c >> 2, d = c & 3; float sc = 0.f, sx = 0.f;
#pragma unroll
            for (int e = 0; e < 4; ++e) {
                sc += wq[blk * 16 + d * 4 + e] * wif[(size_t)(blk * 4 + e) * 8 + j] + wk[blk * 16 + d * 4 + e] * wif[(size_t)(DM + blk * 4 + e) * 8 + j];
                sx += wv[blk * 16 + d * 4 + e] * wif[(size_t)(2 * DM + blk * 4 + e) * 8 + j]; }
            wcx[i] = sc; wcx[DM * 8 + i] = sx;
        }
    }
    bf16_t* XN = (bf16_t*)(ws + WS_XN);
    for (int m = gw; m < NTOK; m += NGW) rms_row_to_bf16(P.in[I_X] + (size_t)m * DM, P.in[I_MIX_PRE_G], XN + (size_t)m * DM, lane);
}

namespace pg8 {
constexpr int BM = 256, BK = 64, HALF = 128, HTB = HALF * BK * 2, STAGE_BYTES = 8 * HTB, NXCD = 8, WGM = 8;
__host__ __device__ __forceinline__ int lds_byte(int r, int c) { const int st = (r >> 4) * 2 + (c >> 5), rr = r & 15, cc = c & 31, ob = rr * 64 + cc * 2; return st * 1024 + (ob ^ (((ob >> 9) & 1) << 5)); }
__host__ __device__ __forceinline__ void stage_rc(int b, int& R, int& C) { const int st = b / 1024, sb = b % 1024, swz = sb ^ (((sb >> 9) & 1) << 5); R = (st >> 1) * 16 + swz / 64; C = (st & 1) * 32 + (swz % 64) / 2; }
__host__ __device__ __forceinline__ int perm32(int rho) { const int n = rho >> 4, i = rho & 15; return 8 * (i >> 2) + 4 * n + (i & 3); }
struct Unit { int pm, pn; };
struct Gemm { const bf16_t* A; const bf16_t* Bt; int lda, ldb, M, N, K; };
struct StaticOrder {
    int nM, nN, nwg, G, c;
    __host__ __device__ void init(int M, int N, int G_, int c_) { nM = M / BM; nN = N / BM; nwg = nM * nN; G = G_; c = c_; }
    __host__ __device__ bool next(int i, Unit& u) const {
        const long L = (long)i * G + c; if (L >= nwg) return false;
        int wgid = (int)L; { const int q = nwg / NXCD, r = nwg % NXCD, xcd = wgid % NXCD, off = wgid / NXCD; wgid = (xcd < r ? xcd * (q + 1) : r * (q + 1) + (xcd - r) * q) + off; }
        const int nig = WGM * nN, gid = wgid / nig, fm = gid * WGM, gsz = (nM - fm) < WGM ? (nM - fm) : WGM;
        u.pm = fm + ((wgid % nig) % gsz); u.pn = (wgid % nig) / gsz; return true;
    }
};
template <class F> struct Epi8 {
    static constexpr bool PERM = true; F f;
    __device__ __forceinline__ void operator()(f32x4 (&acc)[2][2][4][2], const Unit& u_, int wr, int wc, int fr, int fq) const {
        Unit u = u_; asm volatile("" : "+s"(u.pm), "+s"(u.pn));
#pragma unroll
        for (int ai = 0; ai < 2; ++ai)
#pragma unroll
            for (int m = 0; m < 4; ++m)
                { f.store16(u.pm * BM + ai * HALF + wr * 64 + m * 16 + fr, u.pn, wc * 32 + 8 * fq, acc[ai][0][m][0], acc[ai][0][m][1], acc[ai][1][m][0], acc[ai][1][m][1]); asm volatile("" ::: "memory"); }
    }
    __device__ __forceinline__ void mid(f32x4 (&acc)[2][2][4][2], const Unit& u_, int wr, int wc, int fr, int fq) const {
        Unit u = u_; asm volatile("" : "+s"(u.pm), "+s"(u.pn));
#pragma unroll
        for (int ai = 0; ai < 2; ++ai)
#pragma unroll
            for (int m = 0; m < 4; ++m)
#pragma unroll
                for (int bj = 0; bj < 2; ++bj) { f.mid8(u.pm * BM + ai * HALF + wr * 64 + m * 16 + fr, u.pn * BM + bj * HALF + wc * 32 + 8 * fq, acc[ai][bj][m][0], acc[ai][bj][m][1]); asm volatile("" ::: "memory"); }
    }
};
template <class F> struct Epi4 {
    static constexpr bool PERM = false; F f;
    __device__ __forceinline__ void operator()(f32x4 (&acc)[2][2][4][2], const Unit& u_, int wr, int wc, int fr, int fq) const {
        Unit u = u_; asm volatile("" : "+s"(u.pm), "+s"(u.pn));
#pragma unroll
        for (int ai = 0; ai < 2; ++ai)
#pragma unroll
            for (int m = 0; m < 4; ++m)
#pragma unroll
                for (int bj = 0; bj < 2; ++bj)
#pragma unroll
                    for (int n = 0; n < 2; ++n) { f.store4(u.pm * BM + ai * HALF + wr * 64 + m * 16 + fr, u.pn * BM + bj * HALF + wc * 32 + 16 * n + 4 * fq, acc[ai][bj][m][n], ((ai * 4 + m) * 2 + bj) * 2 + n); if (n) asm volatile("" ::: "memory"); }
    }
    __device__ __forceinline__ void mid(f32x4 (&acc)[2][2][4][2], const Unit& u_, int wr, int wc, int fr, int fq) const {
        Unit u = u_; asm volatile("" : "+s"(u.pm), "+s"(u.pn));
#pragma unroll
        for (int ai = 0; ai < 2; ++ai)
#pragma unroll
            for (int m = 0; m < 4; ++m)
#pragma unroll
                for (int bj = 0; bj < 2; ++bj)
#pragma unroll
                    for (int n = 0; n < 2; ++n) { f.mid4(u.pm * BM + ai * HALF + wr * 64 + m * 16 + fr, u.pn * BM + bj * HALF + wc * 32 + 16 * n + 4 * fq, acc[ai][bj][m][n], ((ai * 4 + m) * 2 + bj) * 2 + n); if (n) asm volatile("" ::: "memory"); }
    }
};
template <class Epi, int HOOK_T, bool ALIGN_EPI>
__device__ __forceinline__ void gemm_phase(LAS unsigned char* lds, const Gemm g, const StaticOrder& S, const Epi& E) {
    const int tid = threadIdx.x, wid = __builtin_amdgcn_readfirstlane(tid >> 6), lane = tid & 63, wr = wid >> 2, wc = wid & 3, fr = lane & 15, fq = lane >> 4;
    const int K = g.K, nt = K / BK;
    unsigned voffA[2], voffB[2];
#pragma unroll
    for (int i = 0; i < 2; ++i) { int R, C; stage_rc(tid * 16 + i * 8192, R, C); const int Rb = Epi::PERM ? ((R & ~31) + perm32(R & 31)) : R;
        voffA[i] = (unsigned)(R * g.lda + C) * 2u; voffB[i] = (unsigned)(Rb * g.ldb + C) * 2u; }
    const size_t kstep = (size_t)(BK * 2);
    const size_t hstepA = (size_t)HALF * g.lda * 2, hstepB = (size_t)HALF * g.ldb * 2;
    const size_t tstepA = 2 * hstepA, tstepB = 2 * hstepB;
    const unsigned ldsw = (unsigned)wid * 1024u;
    const int aoff = lds_byte(wr * 64 + fr, fq * 8), boff = lds_byte(wc * 32 + fr, fq * 8);
#define PG8_SA(b, h) (((b) * 2 + (h)) * HTB)
#define PG8_SB(b, h) ((4 + (b) * 2 + (h)) * HTB)
#define PG8_STAGE(bufoff, gbase, voff) do { _Pragma("unroll") for (int _i = 0; _i < 2; ++_i) \
        __builtin_amdgcn_global_load_lds((const unsigned*)((const char*)(gbase) + (voff)[_i]), (LAS unsigned*)(lds + (bufoff) + ldsw + _i * 8192), 16, 0, 0); } while (0)
#define PG8_LDA(dst, b, h) do { _Pragma("unroll") for (int m = 0; m < 4; ++m) _Pragma("unroll") for (int k = 0; k < 2; ++k) dst[m][k] = *(const LAS bf16x8*)(lds + PG8_SA(b, h) + aoff + m * 2048 + k * 1024); } while (0)
#define PG8_LDB(dst, b, h) do { _Pragma("unroll") for (int n = 0; n < 2; ++n) _Pragma("unroll") for (int k = 0; k < 2; ++k) dst[n][k] = *(const LAS bf16x8*)(lds + PG8_SB(b, h) + boff + n * 2048 + k * 1024); } while (0)
#define PG8_MMA(ai, bj, At, Bt) do { __builtin_amdgcn_s_setprio(1); _Pragma("unroll") for (int m = 0; m < 4; ++m) _Pragma("unroll") for (int n = 0; n < 2; ++n) _Pragma("unroll") for (int k = 0; k < 2; ++k) \
        acc[ai][bj][m][n] = __builtin_amdgcn_mfma_f32_16x16x32_bf16(Bt[n][k], At[m][k], acc[ai][bj][m][n], 0, 0, 0); __builtin_amdgcn_s_setprio(0); } while (0)
#define PG8_WAIT_V(n) asm volatile("s_waitcnt vmcnt(" #n ")" ::: "memory")
#define PG8_WAIT_L(n) asm volatile("s_waitcnt lgkmcnt(" #n ")" ::: "memory")
#define PG8_BAR __builtin_amdgcn_s_barrier()
#define PG8_SCHED __builtin_amdgcn_sched_barrier(0)
    Unit cur, nxt; int ui = 0;
    if (!S.next(0, cur)) return;
    f32x4 acc[2][2][4][2];
#pragma unroll
    for (int a = 0; a < 2; ++a)
#pragma unroll
        for (int b = 0; b < 2; ++b)
#pragma unroll
            for (int m = 0; m < 4; ++m)
#pragma unroll
                for (int n = 0; n < 2; ++n) acc[a][b][m][n] = (f32x4){0.f, 0.f, 0.f, 0.f};
    bf16x8 At[4][2], B0[2][2], B1[2][2];
    const char* cA = (const char*)g.A + (size_t)cur.pm * tstepA; const char* cB = (const char*)g.Bt + (size_t)cur.pn * tstepB;
    PG8_STAGE(PG8_SB(0, 0), cB, voffB); PG8_STAGE(PG8_SB(0, 1), cB + hstepB, voffB); PG8_STAGE(PG8_SA(0, 0), cA, voffA); PG8_STAGE(PG8_SA(0, 1), cA + hstepA, voffA);
    if (wr == 1) PG8_BAR;
    PG8_WAIT_V(2); PG8_BAR;
    PG8_STAGE(PG8_SB(1, 0), cB + kstep, voffB); PG8_STAGE(PG8_SA(1, 0), cA + kstep, voffA); PG8_STAGE(PG8_SB(1, 1), cB + hstepB + kstep, voffB);
    PG8_WAIT_V(6); PG8_BAR;
    for (;;) {
        const bool has_next = S.next(ui + 1, nxt);
        const char* nA = has_next ? (const char*)g.A + (size_t)nxt.pm * tstepA : cA; const char* nB = has_next ? (const char*)g.Bt + (size_t)nxt.pn * tstepB : cB;
#define PG8_KBODY() do { \
            const bool last = (t == nt - 2); \
            const char* a1 = cA + (size_t)(t + 1) * kstep; \
            const char* a2 = last ? nA : cA + (size_t)(t + 2) * kstep; const char* b2 = last ? nB : cB + (size_t)(t + 2) * kstep; \
            const char* a3 = a2 + kstep; const char* b3 = b2 + kstep; \
            PG8_LDB(B0, 0, 0); PG8_LDB(B1, 0, 1); PG8_SCHED; PG8_LDA(At, 0, 0); PG8_STAGE(PG8_SA(1, 1), a1 + hstepA, voffA); \
            PG8_WAIT_V(8); PG8_WAIT_L(0); PG8_BAR; PG8_MMA(0, 0, At, B0); PG8_MMA(0, 1, At, B1); PG8_BAR; PG8_SCHED; \
            PG8_LDA(At, 0, 1); PG8_STAGE(PG8_SB(0, 0), b2, voffB); PG8_STAGE(PG8_SB(0, 1), b2 + hstepB, voffB); PG8_STAGE(PG8_SA(0, 0), a2, voffA); \
            PG8_WAIT_V(8); PG8_WAIT_L(0); PG8_BAR; PG8_MMA(1, 0, At, B0); PG8_MMA(1, 1, At, B1); PG8_BAR; PG8_SCHED; \
            PG8_LDB(B0, 1, 0); PG8_LDB(B1, 1, 1); PG8_SCHED; PG8_LDA(At, 1, 0); PG8_STAGE(PG8_SA(0, 1), a2 + hstepA, voffA); \
            PG8_WAIT_V(8); PG8_WAIT_L(0); PG8_BAR; PG8_MMA(0, 0, At, B0); PG8_MMA(0, 1, At, B1); PG8_BAR; PG8_SCHED; \
            PG8_LDA(At, 1, 1); PG8_STAGE(PG8_SB(1, 0), b3, voffB); PG8_STAGE(PG8_SB(1, 1), b3 + hstepB, voffB); PG8_STAGE(PG8_SA(1, 0), a3, voffA); \
            PG8_WAIT_V(8); PG8_WAIT_L(0); PG8_BAR; PG8_MMA(1, 0, At, B0); PG8_MMA(1, 1, At, B1); PG8_BAR; PG8_SCHED; \
        } while (0)
        int t = 0;
        if constexpr (HOOK_T > 0) {
            for (; t < HOOK_T; t += 2) PG8_KBODY();
            PG8_SCHED; E.mid(acc, cur, wr, wc, fr, fq); PG8_SCHED;
        }
        for (; t < nt; t += 2) PG8_KBODY();
#undef PG8_KBODY
        if constexpr (ALIGN_EPI) { if (wr == 0) PG8_BAR; }
        E(acc, cur, wr, wc, fr, fq);
        if (!has_next) break;
#pragma unroll
        for (int a = 0; a < 2; ++a)
#pragma unroll
            for (int b = 0; b < 2; ++b)
#pragma unroll
                for (int m = 0; m < 4; ++m)
#pragma unroll
                    for (int n = 0; n < 2; ++n) acc[a][b][m][n] = (f32x4){0.f, 0.f, 0.f, 0.f};
        cur = nxt; cA = nA; cB = nB; ++ui;
        if constexpr (ALIGN_EPI) { if (wr == 1) PG8_BAR; }
    }
    PG8_WAIT_V(0);
    if constexpr (!ALIGN_EPI) { if (wr == 0) PG8_BAR; }
    PG8_BAR;
#undef PG8_SA
#undef PG8_SB
#undef PG8_STAGE
#undef PG8_LDA
#undef PG8_LDB
#undef PG8_MMA
#undef PG8_WAIT_V
#undef PG8_WAIT_L
#undef PG8_BAR
#undef PG8_SCHED
}
}
__device__ __forceinline__ void st_bf16x8(bf16_t* p, f32x4 a, f32x4 b) { u32x4 o; o.x = pk2(a.x, a.y); o.y = pk2(a.z, a.w); o.z = pk2(b.x, b.y); o.w = pk2(b.z, b.w); *(u32x4*)p = o; }
__device__ __forceinline__ void ld_bf16x8(const bf16_t* p, f32x4& a, f32x4& b) { const u32x4 w = *(const u32x4*)p; a = (f32x4){bflo(w.x), bfhi(w.x), bflo(w.y), bfhi(w.y)}; b = (f32x4){bflo(w.z), bfhi(w.z), bflo(w.w), bfhi(w.w)}; }
template <class FN> __device__ __forceinline__ f32x4 map4(f32x4 v, FN fn) { return (f32x4){fn(v.x), fn(v.y), fn(v.z), fn(v.w)}; }
struct ProjF {
    bf16_t* proj;
    __device__ __forceinline__ void store16(int row, int pn, int cl, f32x4 a0, f32x4 a1, f32x4 b0, f32x4 b1) const {
        bf16_t* rp = proj + (size_t)row * PROJW;
        if (pn < 16) {
            const int sec = pn >> 2;
            if (sec == 1) { a0 = map4(a0, siluf_); a1 = map4(a1, siluf_); b0 = map4(b0, siluf_); b1 = map4(b1, siluf_); }
            else if (sec >= 2) { a0 = map4(a0, gelu_tanh); a1 = map4(a1, gelu_tanh); b0 = map4(b0, gelu_tanh); b1 = map4(b1, gelu_tanh); }
            st_bf16x8(rp + pn * 256 + cl, a0, a1); st_bf16x8(rp + pn * 256 + 128 + cl, b0, b1);
        } else {
            const int j = (pn - 16) * 128 + cl;
            a0 = map4(a0, sigmoidf_); a1 = map4(a1, sigmoidf_); b0 = map4(b0, sigmoidf_); b1 = map4(b1, sigmoidf_);
            st_bf16x8(rp + 4 * DM + j, a0 / b0, a1 / b1); st_bf16x8(rp + 5 * DM + j, b0, b1);
        }
    }
    __device__ __forceinline__ void mid8(int, int, f32x4&, f32x4&) const {}
};
struct MergeF {
    const bf16_t* proj; bf16_t* merged;
    __device__ __forceinline__ void mid8(int row, int col, f32x4& a, f32x4& b) const {
        f32x4 r0, r1; ld_bf16x8(proj + (size_t)row * PROJW + 4 * DM + col, r0, r1); a = a * r0; b = b * r1;
    }
    __device__ __forceinline__ void store16(int row, int pn, int cl, f32x4 a0, f32x4 a1, f32x4 b0, f32x4 b1) const {
        const int col = pn * 256 + cl; f32x4 g0, g1;
        ld_bf16x8(proj + (size_t)row * PROJW + 5 * DM + col, g0, g1); st_bf16x8(merged + (size_t)row * DM + col, a0 * g0, a1 * g1);
        ld_bf16x8(proj + (size_t)row * PROJW + 5 * DM + col + 128, g0, g1); st_bf16x8(merged + (size_t)row * DM + col + 128, b0 * g0, b1 * g1);
    }
};
struct F32F {
    float* o; int ldc;
    __device__ __forceinline__ void store4(int row, int col, f32x4 v, int) const { *(f32x4*)(o + (size_t)row * ldc + col) = v; }
    __device__ __forceinline__ void mid4(int, int, f32x4&, int) const {}
};
struct Relu2F {
    bf16_t* o; int ldc;
    __device__ __forceinline__ void store16(int row, int pn, int cl, f32x4 a0, f32x4 a1, f32x4 b0, f32x4 b1) const {
        auto r2 = [](float x) { const float r = fmaxf(x, 0.f); return r * r; };
        bf16_t* p = o + (size_t)row * ldc + pn * 256 + cl;
        st_bf16x8(p, map4(a0, r2), map4(a1, r2)); st_bf16x8(p + 128, map4(b0, r2), map4(b1, r2));
    }
    __device__ __forceinline__ void mid8(int, int, f32x4&, f32x4&) const {}
};
struct PleF {
    float* o; f32x4* stash;
    __device__ __forceinline__ void mid4(int, int, f32x4& v, int idx) const { unsigned t = threadIdx.x; asm volatile("" : "+v"(t)); stash[((size_t)blockIdx.x * 32 + idx) * NTHR + t] = v; v = (f32x4){0.f, 0.f, 0.f, 0.f}; }
    __device__ __forceinline__ void store4(int row, int col, f32x4 v, int idx) const {
        unsigned t = threadIdx.x; asm volatile("" : "+v"(t)); const f32x4 p = stash[((size_t)blockIdx.x * 32 + idx) * NTHR + t];
        *(f32x4*)(o + (size_t)row * DM + col) = map4(v, sigmoidf_) * p;
    }
};

__device__ __forceinline__ void ld4(const bf16_t* p, float (&x)[4]) { const u32x2 w = *(const u32x2*)p; x[0] = bflo(w.x); x[1] = bfhi(w.x); x[2] = bflo(w.y); x[3] = bfhi(w.y); }
__device__ __forceinline__ void st4(bf16_t* p, const float (&x)[4]) { u32x2 o; o.x = pk2(x[0], x[1]); o.y = pk2(x[2], x[3]); *(u32x2*)p = o; }
__device__ void p2_qkv(const Params& P, LAS unsigned char* lds) {
    const int tid = threadIdx.x, lane = tid & 63, wave = tid >> 6, h = wave & 3, half = wave >> 2;
    unsigned char* ws = P.ws;
    const bf16_t* PROJ = (const bf16_t*)(ws + WS_PROJ);
    bf16_t* Q = (bf16_t*)P.out; bf16_t* K = Q + (size_t)NTOK * DM; bf16_t* V = (bf16_t*)(ws + WS_XN);
    float* GATES = (float*)(ws + WS_GATES);
    LAS float* part = (LAS float*)lds;
    const int ch = h * 256 + lane * 4, blk = ch >> 2;
    float cw[4][4], cb[4], wq[4][4], wk[4][4], wv[4][4], wc[4][8], wx[4][8];
#pragma unroll
    for (int j = 0; j < 4; ++j)
#pragma unroll
        for (int d = 0; d < 4; ++d) cw[j][d] = P.in[I_CONV_W][j * DM + ch + d];
#pragma unroll
    for (int d = 0; d < 4; ++d) { cb[d] = P.in[I_CONV_B][ch + d];
#pragma unroll
        for (int e = 0; e < 4; ++e) { wq[d][e] = P.in[I_WQ][blk * 16 + d * 4 + e]; wk[d][e] = P.in[I_WK][blk * 16 + d * 4 + e]; wv[d][e] = P.in[I_WV][blk * 16 + d * 4 + e]; }
#pragma unroll
        for (int j = 0; j < 8; ++j) { wc[d][j] = ((const float*)(ws + WS_WCX))[(ch + d) * 8 + j]; wx[d][j] = ((const float*)(ws + WS_WCX))[DM * 8 + (ch + d) * 8 + j]; } }
    for (int item = blockIdx.x; item < NTOK / 16; item += gridDim.x) {
        const int tb = item * 16 + half * 8;
        float x0[4], x1[4], x2[4], x3[4];
        if ((tb & (SEQ - 1)) == 0) {
#pragma unroll
            for (int d = 0; d < 4; ++d) { x0[d] = 0.f; x1[d] = 0.f; x2[d] = 0.f; }
        } else { ld4(PROJ + (size_t)(tb - 3) * PROJW + ch, x0); ld4(PROJ + (size_t)(tb - 2) * PROJW + ch, x1); ld4(PROJ + (size_t)(tb - 1) * PROJW + ch, x2); }
#pragma unroll 1
        for (int i = 0; i < 8; ++i) {
            const int t = tb + i;
            ld4(PROJ + (size_t)t * PROJW + ch, x3);
            float mc[4], q[4], k[4], v[4], gp[8];
#pragma unroll
            for (int d = 0; d < 4; ++d) mc[d] = siluf_(cw[0][d] * x0[d] + cw[1][d] * x1[d] + cw[2][d] * x2[d] + cw[3][d] * x3[d] + cb[d]);
#pragma unroll
            for (int e = 0; e < 4; ++e) { q[e] = mc[0] * wq[0][e] + mc[1] * wq[1][e] + mc[2] * wq[2][e] + mc[3] * wq[3][e];
                k[e] = mc[0] * wk[0][e] + mc[1] * wk[1][e] + mc[2] * wk[2][e] + mc[3] * wk[3][e];
                v[e] = x3[0] * wv[0][e] + x3[1] * wv[1][e] + x3[2] * wv[2][e] + x3[3] * wv[3][e]; }
            st4(Q + (size_t)t * DM + ch, q); st4(K + (size_t)t * DM + ch, k); st4(V + (size_t)t * DM + ch, v);
#pragma unroll
            for (int j = 0; j < 8; ++j) { float s = 0.f;
#pragma unroll
                for (int d = 0; d < 4; ++d) s += mc[d] * wc[d][j] + x3[d] * wx[d][j];
                gp[j] = wave_sum(s); }
            if (lane == 0) {
#pragma unroll
                for (int j = 0; j < 8; ++j) part[((half * 8 + i) * 4 + h) * 8 + j] = gp[j]; }
#pragma unroll
            for (int d = 0; d < 4; ++d) { x0[d] = x1[d]; x1[d] = x2[d]; x2[d] = x3[d]; }
        }
        __syncthreads();
        if (tid < 128) { const int tok = tid >> 3, j = tid & 7;
            const float val = part[(tok * 4 + 0) * 8 + j] + part[(tok * 4 + 1) * 8 + j] + part[(tok * 4 + 2) * 8 + j] + part[(tok * 4 + 3) * 8 + j] + P.in[I_B_IF][j];
            GATES[(size_t)(item * 16 + tok) * 8 + j] = (j < 4) ? val : log_sigmoid(val); }
        __syncthreads();
    }
    bf16_t* PW = (bf16_t*)(ws + WS_PROJ);
    const int gw = blockIdx.x * NWAVES + wave, NGW = gridDim.x * NWAVES;
    for (int m = gw; m < NTOK; m += NGW) {
        bf16_t* row = PW + (size_t)m * PROJW + 3 * DM + lane * 16;
        const u32x4 a = *(const u32x4*)row, b = *(const u32x4*)(row + 8);
        float x[16] = {bflo(a.x), bfhi(a.x), bflo(a.y), bfhi(a.y), bflo(a.z), bfhi(a.z), bflo(a.w), bfhi(a.w), bflo(b.x), bfhi(b.x), bflo(b.y), bfhi(b.y), bflo(b.z), bfhi(b.z), bflo(b.w), bfhi(b.w)};
        float s = 0.f;
#pragma unroll
        for (int i = 0; i < 16; ++i) s += x[i];
        const float mu = wave_sum(s) * (1.f / DM); float s2 = 0.f;
#pragma unroll
        for (int i = 0; i < 16; ++i) { x[i] -= mu; s2 += x[i] * x[i]; }
        const float r = 1.0f / sqrtf(wave_sum(s2) * (1.f / DM) + EPS);
        const float* lw = P.in[I_G_LN_W] + lane * 16; const float* lb = P.in[I_G_LN_B] + lane * 16;
#pragma unroll
        for (int i = 0; i < 16; ++i) x[i] = x[i] * r * lw[i] + lb[i];
        u32x4 oa, ob; oa.x = pk2(x[0], x[1]); oa.y = pk2(x[2], x[3]); oa.z = pk2(x[4], x[5]); oa.w = pk2(x[6], x[7]); ob.x = pk2(x[8], x[9]); ob.y = pk2(x[10], x[11]); ob.z = pk2(x[12], x[13]); ob.w = pk2(x[14], x[15]);
        *(u32x4*)row = oa; *(u32x4*)(row + 8) = ob;
    }
}

constexpr int ML_C = 0, ML_N = 65536, ML_Q = ML_N + 1024, ML_K = ML_Q + 32768, ML_V = ML_K + 32768, ML_P = ML_V + 8192, ML_S = ML_P + 16384, ML_BYTES = ML_S + 2048;
__device__ void p3_mlstm_naive(const Params& P, LAS unsigned char* lds) {
    const int tid = threadIdx.x, lane = tid & 63, wave = tid >> 6;
    unsigned char* ws = P.ws;
    const bf16_t* Q = (const bf16_t*)P.out; const bf16_t* K = Q + (size_t)NTOK * DM; bf16_t* V = (bf16_t*)(ws + WS_XN);
    const float* GATES = (const float*)(ws + WS_GATES);
    LAS float* Cs = (LAS float*)(lds + ML_C); LAS float* ns = (LAS float*)(lds + ML_N);
    LAS unsigned* qs = (LAS unsigned*)(lds + ML_Q); LAS unsigned* ks = (LAS unsigned*)(lds + ML_K);
    LAS bf16_t* vs = (LAS bf16_t*)(lds + ML_V);
    LAS float* Ps = (LAS float*)(lds + ML_P);
    LAS float* sc = (LAS float*)(lds + ML_S);
    for (int item = blockIdx.x; item < 256; item += gridDim.x) {
        const int b = item >> 4, h = (item >> 2) & 3, j = item & 3;
        for (int i = tid; i < 256 * 64; i += NTHR) Cs[i] = 0.f;
        if (tid < 256) ns[tid] = 0.f;
        float m = 0.f;
        __syncthreads();
        for (int c = 0; c < 32; ++c) {
            const size_t t0 = (size_t)b * SEQ + c * 64;
#pragma unroll
            for (int i = 0; i < 4; ++i) { const int p = tid + i * NTHR, r = p >> 5, cc = p & 31;
                *(LAS u32x4*)(qs + r * 128 + cc * 4) = *(const u32x4*)(Q + (t0 + r) * DM + h * 256 + cc * 8);
                *(LAS u32x4*)(ks + r * 128 + cc * 4) = *(const u32x4*)(K + (t0 + r) * DM + h * 256 + cc * 8); }
            { const int r = tid >> 3, cc = tid & 7; *(LAS u32x4*)(vs + r * 64 + cc * 8) = *(const u32x4*)(V + (t0 + r) * DM + h * 256 + j * 64 + cc * 8); }
            if (wave == 0) {
                const float ig = GATES[(t0 + lane) * 8 + h], lf = GATES[(t0 + lane) * 8 + 4 + h];
                float bs = lf;
#pragma unroll
                for (int o = 1; o < 64; o <<= 1) { const float t = __shfl_up(bs, o); if (lane >= o) bs += t; }
                const float u = ig - bs; float gm = u;
#pragma unroll
                for (int o = 1; o < 64; o <<= 1) { const float t = __shfl_up(gm, o); if (lane >= o) gm = fmaxf(gm, t); }
                const float g = fmaxf(gm, m), gL = __shfl(g, 63), bL = __shfl(bs, 63);
                sc[lane] = u; sc[64 + lane] = g; sc[128 + lane] = expf(m - g); sc[192 + lane] = expf(-bs - g); sc[256 + lane] = expf(u - gL);
                if (lane == 0) sc[384] = expf(m - gL);
                m = bL + gL;
            }
            __syncthreads();
            { const int t = tid >> 3, sg = tid & 7; float acc[8];
#pragma unroll
                for (int i = 0; i < 8; ++i) acc[i] = 0.f;
                if (sg * 8 <= t) {
                    for (int d2 = 0; d2 < 128; ++d2) { const unsigned qw = qs[t * 128 + d2]; const float ql = bflo(qw), qh = bfhi(qw);
#pragma unroll
                        for (int i = 0; i < 8; ++i) { const unsigned kw = ks[(sg * 8 + i) * 128 + d2]; acc[i] += ql * bflo(kw) + qh * bfhi(kw); } } }
                const float gt = sc[64 + t];
#pragma unroll
                for (int i = 0; i < 8; ++i) { const int s = sg * 8 + i; Ps[t * 64 + s] = (s <= t) ? acc[i] * 0.0625f * expf(sc[s] - gt) : 0.f; } }
            __syncthreads();
            if (tid < 64) { const int t = tid; float qn = 0.f;
                for (int d2 = 0; d2 < 128; ++d2) { const unsigned qw = qs[t * 128 + d2]; qn += bflo(qw) * ns[2 * d2] + bfhi(qw) * ns[2 * d2 + 1]; }
                float ps = 0.f;
                for (int s = 0; s <= t; ++s) ps += Ps[t * 64 + s];
                sc[320 + t] = sc[128 + t] * qn + ps; }
            __syncthreads();
            { const int t = tid >> 3, eg = tid & 7; float acc[8];
#pragma unroll
                for (int i = 0; i < 8; ++i) acc[i] = 0.f;
                for (int d2 = 0; d2 < 128; ++d2) { const unsigned qw = qs[t * 128 + d2]; const float ql = bflo(qw), qh = bfhi(qw);
#pragma unroll
                    for (int i = 0; i < 8; ++i) acc[i] += ql * Cs[(2 * d2) * 64 + eg * 8 + i] + qh * Cs[(2 * d2 + 1) * 64 + eg * 8 + i]; }
                const float iw = sc[128 + t];
#pragma unroll
                for (int i = 0; i < 8; ++i) acc[i] *= iw;
                for (int s = 0; s <= t; ++s) { const float pv = Ps[t * 64 + s];
#pragma unroll
                    for (int i = 0; i < 8; ++i) acc[i] += pv * bf2f(vs[s * 64 + eg * 8 + i]); }
                const float dn = 1.0f / fmaxf(fabsf(sc[320 + t]), sc[192 + t]);
                u32x4 o; o.x = pk2(acc[0] * dn, acc[1] * dn); o.y = pk2(acc[2] * dn, acc[3] * dn); o.z = pk2(acc[4] * dn, acc[5] * dn); o.w = pk2(acc[6] * dn, acc[7] * dn);
                *(u32x4*)(V + (t0 + t) * DM + h * 256 + j * 64 + eg * 8) = o;
            }
            __syncthreads();
            { const int d = tid >> 1, eh = tid & 1; const float decay = sc[384]; float acc[32];
#pragma unroll
                for (int i = 0; i < 32; ++i) acc[i] = decay * Cs[d * 64 + eh * 32 + i];
                float nacc = decay * ns[d];
                for (int s = 0; s < 64; ++s) { const unsigned kw = ks[s * 128 + (d >> 1)]; const float kv = ((d & 1) ? bfhi(kw) : bflo(kw)) * 0.0625f * sc[256 + s];
                    nacc += kv;
#pragma unroll
                    for (int i = 0; i < 32; ++i) acc[i] += kv * bf2f(vs[s * 64 + eh * 32 + i]); }
#pragma unroll
                for (int i = 0; i < 32; ++i) Cs[d * 64 + eh * 32 + i] = acc[i];
                if (eh == 0) ns[d] = nacc; }
            __syncthreads();
        }
    }
}

__device__ void p3_gmlp_naive(const Params& P, LAS unsigned char* lds) {
    const int tid = threadIdx.x;
    bf16_t* PROJ = (bf16_t*)(P.ws + WS_PROJ);
    LAS bf16_t* vv = (LAS bf16_t*)lds;
    const float* WSP = P.in[I_W_SP]; const float* BSP = P.in[I_B_SP];
    for (int item = blockIdx.x; item < 2048; item += gridDim.x) {
        const int g = item & 7, c = (item >> 3) & 15, b = item >> 7; const size_t t0 = (size_t)b * SEQ + c * 128;
#pragma unroll
        for (int i = 0; i < 4; ++i) { const int p = tid + i * NTHR, r = p >> 4, cc = p & 15; *(LAS u32x4*)(vv + r * 128 + cc * 8) = *(const u32x4*)(PROJ + (t0 + r) * PROJW + 3 * DM + g * 128 + cc * 8); }
        __syncthreads();
        const int t = tid >> 2, dg = tid & 3; float acc[32];
#pragma unroll
        for (int i = 0; i < 32; ++i) acc[i] = 0.f;
        const float* wrow = WSP + ((size_t)g * 128 + t) * 128;
        for (int s = 0; s <= t; ++s) { const float w = wrow[s];
#pragma unroll
            for (int i = 0; i < 32; ++i) acc[i] += w * bf2f(vv[s * 128 + dg * 32 + i]); }
        const float bs = BSP[g * 128 + t];
        bf16_t* gu = PROJ + (t0 + t) * PROJW + 2 * DM + g * 128 + dg * 32;
#pragma unroll
        for (int i = 0; i < 4; ++i) { const u32x4 w = *(const u32x4*)(gu + i * 8); u32x4 o;
            o.x = pk2(bflo(w.x) * (acc[i * 8 + 0] + bs), bfhi(w.x) * (acc[i * 8 + 1] + bs)); o.y = pk2(bflo(w.y) * (acc[i * 8 + 2] + bs), bfhi(w.y) * (acc[i * 8 + 3] + bs));
            o.z = pk2(bflo(w.z) * (acc[i * 8 + 4] + bs), bfhi(w.z) * (acc[i * 8 + 5] + bs)); o.w = pk2(bflo(w.w) * (acc[i * 8 + 6] + bs), bfhi(w.w) * (acc[i * 8 + 7] + bs));
            *(u32x4*)(gu + i * 8) = o; }
        __syncthreads();
    }
}

namespace mlm {
constexpr int QP = 264, VP = 88, PP = 72;
constexpr int QS_OFF = 0, KS_OFF = QS_OFF + 64 * QP * 2, VS_OFF = KS_OFF + 64 * QP * 2, CT_OFF = VS_OFF + 64 * VP * 2, PS_OFF = CT_OFF + 80 * QP * 2, SC_OFF = PS_OFF + 64 * PP * 2, BYTES = SC_OFF + 2048;
typedef short s16x4 __attribute__((ext_vector_type(4)));
typedef float f32x2_t __attribute__((ext_vector_type(2)));
typedef __bf16 bf16x2_t __attribute__((ext_vector_type(2)));
__device__ __forceinline__ unsigned cvtpk(float lo, float hi) { f32x2_t v = {lo, hi}; bf16x2_t b = __builtin_convertvector(v, bf16x2_t); return __builtin_bit_cast(unsigned, b); }
__device__ __forceinline__ s16x4 tr16(LAS unsigned char* p) { return __builtin_bit_cast(s16x4, __builtin_amdgcn_ds_read_tr16_b64_v4i16((LAS s16x4*)p)); }
__device__ __forceinline__ bf16x8 frag_tr(LAS unsigned char* p, int pitch_bytes) {
    const s16x4 lo = tr16(p), hi = tr16(p + 4 * pitch_bytes);
    return (bf16x8){lo.x, lo.y, lo.z, lo.w, hi.x, hi.y, hi.z, hi.w};
}
}
__device__ void p3_mlstm_mfma(const Params& P, LAS unsigned char* lds) {
    using namespace mlm;
    const int tid = threadIdx.x, lane = tid & 63, wave = __builtin_amdgcn_readfirstlane(tid >> 6), fr = lane & 15, fq = lane >> 4, q_ = fr >> 2, p_ = fr & 3;
    const int tau = wave >> 1, par = wave & 1;
    unsigned char* ws = P.ws;
    const bf16_t* Q = (const bf16_t*)P.out; const bf16_t* K = Q + (size_t)NTOK * DM; bf16_t* V = (bf16_t*)(ws + WS_XN);
    const float* GATES = (const float*)(ws + WS_GATES);
    LAS float* sc = (LAS float*)(lds + SC_OFF);
    for (int item = blockIdx.x; item < 256; item += gridDim.x) {
        const int b = item >> 4, h = (item >> 2) & 3, j = item & 3;
        for (int i = tid; i < 80 * QP * 2 / 16; i += NTHR) ((LAS u32x4*)(lds + CT_OFF))[i] = (u32x4){0u, 0u, 0u, 0u};
        if (tid < 64) { LAS bf16_t* r = (LAS bf16_t*)(lds + VS_OFF) + tid * VP + 64; r[0] = 0x3F80;
#pragma unroll
            for (int i = 1; i < 24; ++i) r[i] = 0; }
        f32x4 cacc[2][5];
#pragma unroll
        for (int a = 0; a < 2; ++a)
#pragma unroll
            for (int e = 0; e < 5; ++e) cacc[a][e] = (f32x4){0.f, 0.f, 0.f, 0.f};
        float m = 0.f;
        u32x4 pq[4], pk[4], pv; float pig = 0.f, plf = 0.f;
        const bf16_t* qb = Q + (size_t)b * SEQ * DM + h * 256; const bf16_t* kb = K + (size_t)b * SEQ * DM + h * 256; bf16_t* vb = V + (size_t)b * SEQ * DM + h * 256 + j * 64;
#define ML_LOAD(c_) do { const size_t r0_ = (size_t)(c_) * 64; \
            _Pragma("unroll") for (int i = 0; i < 4; ++i) { const int p = tid + i * NTHR, r = p >> 5, cc = p & 31; pq[i] = *(const u32x4*)(qb + (r0_ + r) * DM + cc * 8); pk[i] = *(const u32x4*)(kb + (r0_ + r) * DM + cc * 8); } \
            pv = *(const u32x4*)(vb + (r0_ + (tid >> 3)) * DM + (tid & 7) * 8); \
            if (wave == 0) { pig = GATES[((size_t)b * SEQ + r0_ + lane) * 8 + h]; plf = GATES[((size_t)b * SEQ + r0_ + lane) * 8 + 4 + h]; } } while (0)
        ML_LOAD(0);
        __syncthreads();
        for (int c = 0; c < 32; ++c) {
#pragma unroll
            for (int i = 0; i < 4; ++i) { const int p = tid + i * NTHR, r = p >> 5, cc = p & 31; *(LAS u32x4*)(lds + QS_OFF + r * QP * 2 + cc * 16) = pq[i]; *(LAS u32x4*)(lds + KS_OFF + r * QP * 2 + cc * 16) = pk[i]; }
            *(LAS u32x4*)(lds + VS_OFF + (tid >> 3) * VP * 2 + (tid & 7) * 16) = pv;
            if (wave == 0) {
                float bs = plf;
#pragma unroll
                for (int o = 1; o < 64; o <<= 1) { const float t = __shfl_up(bs, o); if (lane >= o) bs += t; }
                const float u = pig - bs; float gm = u;
#pragma unroll
                for (int o = 1; o < 64; o <<= 1) { const float t = __shfl_up(gm, o); if (lane >= o) gm = fmaxf(gm, t); }
                const float g = fmaxf(gm, m), gL = __shfl(g, 63), bL = __shfl(bs, 63);
                sc[lane] = u; sc[64 + lane] = g; sc[128 + lane] = expf(m - g); sc[192 + lane] = expf(-bs - g); sc[256 + lane] = expf(u - gL) * 0.0625f;
                if (lane == 0) sc[320] = expf(m - gL);
                m = bL + gL;
            }
            __syncthreads();
            if (c + 1 < 32) ML_LOAD(c + 1);
            bf16x8 qf[8];
#pragma unroll
            for (int kap = 0; kap < 8; ++kap) qf[kap] = *(const LAS bf16x8*)(lds + QS_OFF + ((16 * tau + fr) * QP + 32 * kap + 8 * fq) * 2);
            const float gt = sc[64 + 16 * tau + fr];
#pragma unroll
            for (int si = 0; si < 2; ++si) {
                const int sig = 2 * par + si; f32x4 acc = (f32x4){0.f, 0.f, 0.f, 0.f};
                if (sig <= tau) {
#pragma unroll
                    for (int kap = 0; kap < 8; ++kap) acc = __builtin_amdgcn_mfma_f32_16x16x32_bf16(*(const LAS bf16x8*)(lds + KS_OFF + ((16 * sig + fr) * QP + 32 * kap + 8 * fq) * 2), qf[kap], acc, 0, 0, 0);
                }
                const f32x4 us = *(const LAS f32x4*)(sc + 16 * sig + 4 * fq);
                const int t = 16 * tau + fr, s0 = 16 * sig + 4 * fq;
                const float w0 = (s0 + 0 <= t) ? acc.x * 0.0625f * __expf(us.x - gt) : 0.f, w1 = (s0 + 1 <= t) ? acc.y * 0.0625f * __expf(us.y - gt) : 0.f;
                const float w2 = (s0 + 2 <= t) ? acc.z * 0.0625f * __expf(us.z - gt) : 0.f, w3 = (s0 + 3 <= t) ? acc.w * 0.0625f * __expf(us.w - gt) : 0.f;
                u32x2 o; o.x = cvtpk(w0, w1); o.y = cvtpk(w2, w3);
                *(LAS u32x2*)(lds + PS_OFF + (t * PP + s0) * 2) = o;
            }
            f32x4 nacc[3];
#pragma unroll
            for (int ei = 0; ei < 3; ++ei) {
                const int eps = (ei == 2) ? 4 : 2 * par + ei; f32x4 acc = (f32x4){0.f, 0.f, 0.f, 0.f};
#pragma unroll
                for (int kap = 0; kap < 8; ++kap) acc = __builtin_amdgcn_mfma_f32_16x16x32_bf16(*(const LAS bf16x8*)(lds + CT_OFF + ((16 * eps + fr) * QP + 32 * kap + 8 * fq) * 2), qf[kap], acc, 0, 0, 0);
                nacc[ei] = acc * sc[128 + 16 * tau + fr];
            }
            __syncthreads();
            {
                bf16x8 pf[2];
#pragma unroll
                for (int kp = 0; kp < 2; ++kp) pf[kp] = *(const LAS bf16x8*)(lds + PS_OFF + ((16 * tau + fr) * PP + 32 * kp + 8 * fq) * 2);
#pragma unroll
                for (int ei = 0; ei < 3; ++ei) {
                    const int eps = (ei == 2) ? 4 : 2 * par + ei;
#pragma unroll
                    for (int kp = 0; kp < 2; ++kp) nacc[ei] = __builtin_amdgcn_mfma_f32_16x16x32_bf16(frag_tr(lds + VS_OFF + ((32 * kp + 8 * fq + q_) * VP + 16 * eps + 4 * p_) * 2, VP * 2), pf[kp], nacc[ei], 0, 0, 0);
                }
                const float den = __shfl(nacc[2].x, fr);
                const float rinv = 1.0f / fmaxf(fabsf(den), sc[192 + 16 * tau + fr]);
                bf16_t* hrow = vb + ((size_t)c * 64 + 16 * tau + fr) * DM;
#pragma unroll
                for (int ei = 0; ei < 2; ++ei) { const int eps = 2 * par + ei; u32x2 o; o.x = cvtpk(nacc[ei].x * rinv, nacc[ei].y * rinv); o.y = cvtpk(nacc[ei].z * rinv, nacc[ei].w * rinv);
                    *(u32x2*)(hrow + 16 * eps + 4 * fq) = o; }
            }
            {
                const float decay = sc[320];
                bf16x8 kw[2][2];
#pragma unroll
                for (int dl = 0; dl < 2; ++dl)
#pragma unroll
                    for (int kp = 0; kp < 2; ++kp) {
                        const bf16x8 f = frag_tr(lds + KS_OFF + ((32 * kp + 8 * fq + q_) * QP + 16 * (2 * wave + dl) + 4 * p_) * 2, QP * 2);
                        const u32x4 fw = __builtin_bit_cast(u32x4, f);
                        const f32x4 wa = *(const LAS f32x4*)(sc + 256 + 32 * kp + 8 * fq), wb = *(const LAS f32x4*)(sc + 256 + 32 * kp + 8 * fq + 4);
                        u32x4 o; o.x = cvtpk(bflo(fw.x) * wa.x, bfhi(fw.x) * wa.y); o.y = cvtpk(bflo(fw.y) * wa.z, bfhi(fw.y) * wa.w); o.z = cvtpk(bflo(fw.z) * wb.x, bfhi(fw.z) * wb.y); o.w = cvtpk(bflo(fw.w) * wb.z, bfhi(fw.w) * wb.w);
                        kw[dl][kp] = __builtin_bit_cast(bf16x8, o);
                    }
#pragma unroll
                for (int eps = 0; eps < 5; ++eps) {
                    bf16x8 vf[2];
#pragma unroll
                    for (int kp = 0; kp < 2; ++kp) vf[kp] = frag_tr(lds + VS_OFF + ((32 * kp + 8 * fq + q_) * VP + 16 * eps + 4 * p_) * 2, VP * 2);
#pragma unroll
                    for (int dl = 0; dl < 2; ++dl) {
                        f32x4 a = cacc[dl][eps] * decay;
                        a = __builtin_amdgcn_mfma_f32_16x16x32_bf16(kw[dl][0], vf[0], a, 0, 0, 0);
                        a = __builtin_amdgcn_mfma_f32_16x16x32_bf16(kw[dl][1], vf[1], a, 0, 0, 0);
                        cacc[dl][eps] = a;
                        u32x2 o; o.x = cvtpk(a.x, a.y); o.y = cvtpk(a.z, a.w);
                        *(LAS u32x2*)(lds + CT_OFF + ((16 * eps + fr) * QP + 16 * (2 * wave + dl) + 4 * fq) * 2) = o;
                    }
                }
            }
            __syncthreads();
        }
#undef ML_LOAD
    }
}

__device__ void p4_ym(const Params& P, LAS unsigned char*) {
    const int tid = threadIdx.x, lane = tid & 63, wave = tid >> 6, h = wave & 3, half = wave >> 2;
    bf16_t* PROJ = (bf16_t*)(P.ws + WS_PROJ); const bf16_t* HM = (const bf16_t*)(P.ws + WS_XN);
    const int ch = h * 256 + lane * 4;
    float cw[4][4], cb[4], ng[4], sk[4];
#pragma unroll
    for (int j = 0; j < 4; ++j)
#pragma unroll
        for (int d = 0; d < 4; ++d) cw[j][d] = P.in[I_CONV_W][j * DM + ch + d];
#pragma unroll
    for (int d = 0; d < 4; ++d) { cb[d] = P.in[I_CONV_B][ch + d]; ng[d] = P.in[I_M_NORM_G][ch + d]; sk[d] = P.in[I_M_SKIP][ch + d]; }
    for (int item = blockIdx.x; item < NTOK / 16; item += gridDim.x) {
        const int tb = item * 16 + half * 8;
        float x0[4], x1[4], x2[4], x3[4];
        if ((tb & (SEQ - 1)) == 0) {
#pragma unroll
            for (int d = 0; d < 4; ++d) { x0[d] = 0.f; x1[d] = 0.f; x2[d] = 0.f; }
        } else { ld4(PROJ + (size_t)(tb - 3) * PROJW + ch, x0); ld4(PROJ + (size_t)(tb - 2) * PROJW + ch, x1); ld4(PROJ + (size_t)(tb - 1) * PROJW + ch, x2); }
#pragma unroll 1
        for (int i = 0; i < 8; ++i) {
            const int t = tb + i;
            ld4(PROJ + (size_t)t * PROJW + ch, x3);
            float hm[4], sz[4], y[4];
            ld4(HM + (size_t)t * DM + ch, hm); ld4(PROJ + (size_t)t * PROJW + DM + ch, sz);
            const float mu = wave_sum(hm[0] + hm[1] + hm[2] + hm[3]) * (1.f / 256.f);
            float s2 = 0.f;
#pragma unroll
            for (int d = 0; d < 4; ++d) { hm[d] -= mu; s2 += hm[d] * hm[d]; }
            const float r = 1.0f / sqrtf(wave_sum(s2) * (1.f / 256.f) + EPS);
#pragma unroll
            for (int d = 0; d < 4; ++d) { const float mc = siluf_(cw[0][d] * x0[d] + cw[1][d] * x1[d] + cw[2][d] * x2[d] + cw[3][d] * x3[d] + cb[d]);
                y[d] = (hm[d] * r * ng[d] + sk[d] * mc) * sz[d]; }
            st4(PROJ + (size_t)t * PROJW + DM + ch, y);
#pragma unroll
            for (int d = 0; d < 4; ++d) { x0[d] = x1[d]; x1[d] = x2[d]; x2[d] = x3[d]; }
        }
    }
}

__device__ void norm_pass(const float* xi, const float* y, const float* g1, float* xo, const float* g2, bf16_t* hn, int ldh, int hoff, const float* pin) {
    const int tid = threadIdx.x, lane = tid & 63, wave = tid >> 6;
    const int gw = blockIdx.x * NWAVES + wave, NGW = gridDim.x * NWAVES;
    for (int m = gw; m < NTOK; m += NGW) {
        const f32x4* yr = (const f32x4*)(y + (size_t)m * DM) + lane; const f32x4* xr = (const f32x4*)(xi + (size_t)m * DM) + lane; f32x4* orow = (f32x4*)(xo + (size_t)m * DM) + lane;
        f32x4 v[4]; float s = 0.f;
#pragma unroll
        for (int j = 0; j < 4; ++j) { v[j] = yr[64 * j]; s += (v[j].x * v[j].x + v[j].y * v[j].y) + (v[j].z * v[j].z + v[j].w * v[j].w); }
        const float r = 1.0f / sqrtf(wave_sum(s) * (1.f / DM) + EPS); float s2 = 0.f;
#pragma unroll
        for (int j = 0; j < 4; ++j) { const f32x4 gv = ((const f32x4*)g1 + lane)[64 * j]; v[j] = xr[64 * j] + v[j] * r * gv; orow[64 * j] = v[j];
            s2 += (v[j].x * v[j].x + v[j].y * v[j].y) + (v[j].z * v[j].z + v[j].w * v[j].w); }
        if (hn) {
            const float r2 = 1.0f / sqrtf(wave_sum(s2) * (1.f / DM) + EPS);
            u32x2* o8 = (u32x2*)(hn + (size_t)m * ldh + hoff) + lane;
#pragma unroll
            for (int j = 0; j < 4; ++j) { const f32x4 gv = ((const f32x4*)g2 + lane)[64 * j]; u32x2 o; o.x = pk2(v[j].x * r2 * gv.x, v[j].y * r2 * gv.y); o.y = pk2(v[j].z * r2 * gv.z, v[j].w * r2 * gv.w); o8[64 * j] = o; }
            if (pin) { const f32x4 pv = ((const f32x4*)(pin + (size_t)m * PLE))[lane]; u32x2 o; o.x = pk2(pv.x, pv.y); o.y = pk2(pv.z, pv.w); ((u32x2*)(hn + (size_t)m * ldh))[lane] = o; }
        }
    }
}

#ifndef MEGA
#define MEGA 1
#endif
namespace cg = cooperative_groups;
constexpr int NPHASE = 13;
constexpr int LDS_BYTES = 160 * 1024 - 1024;
static_assert(ML_BYTES <= LDS_BYTES && pg8::STAGE_BYTES <= LDS_BYTES && mlm::BYTES <= LDS_BYTES, "lds");

template <int LO, int HI> __global__ void __launch_bounds__(NTHR, 2) fwd_kernel(Params P) {
    extern __shared__ __attribute__((aligned(16))) unsigned char lds_raw[];
    LAS unsigned char* lds = (LAS unsigned char*)lds_raw;
    unsigned char* ws = P.ws;
    bf16_t* PROJ = (bf16_t*)(ws + WS_PROJ); bf16_t* XN = (bf16_t*)(ws + WS_XN); bf16_t* HB = (bf16_t*)(ws + WS_HB); float* Y = (float*)(ws + WS_Y);
    const int G = gridDim.x, bid = blockIdx.x;
#define IN(k) (LO <= (k) && (k) < HI)
#define SEAM(k) do { if (IN(k) && IN((k) + 1)) cg::this_grid().sync(); } while (0)
    if (IN(0)) p0_prologue(P, lds);
    SEAM(0);
    if (IN(1)) { pg8::Gemm g{XN, (const bf16_t*)(ws + WS_WIN), DM, DM, NTOK, PROJW, DM}; pg8::StaticOrder S; S.init(NTOK, PROJW, G, bid);
        pg8::Epi8<ProjF> E{ProjF{PROJ}}; pg8::gemm_phase<pg8::Epi8<ProjF>, -1, true>(lds, g, S, E); }
    SEAM(1);
    if (IN(2)) p2_qkv(P, lds);
    SEAM(2);
    if (IN(3)) { p3_mlstm_mfma(P, lds); __syncthreads(); p3_gmlp_naive(P, lds); }
    SEAM(3);
    if (IN(4)) p4_ym(P, lds);
    SEAM(4);
    if (IN(5)) { pg8::Gemm g{PROJ + DM, (const bf16_t*)(ws + WS_WBR), PROJW, 2 * DM, NTOK, DM, 2 * DM}; pg8::StaticOrder S; S.init(NTOK, DM, G, bid);
        pg8::Epi8<MergeF> E{MergeF{PROJ, XN}}; pg8::gemm_phase<pg8::Epi8<MergeF>, 16, true>(lds, g, S, E); }
    SEAM(5);
    if (IN(6)) { pg8::Gemm g{XN, (const bf16_t*)(ws + WS_WOUT), DM, DM, NTOK, DM, DM}; pg8::StaticOrder S; S.init(NTOK, DM, G, bid);
        pg8::Epi4<F32F> E{F32F{Y, DM}}; pg8::gemm_phase<pg8::Epi4<F32F>, -1, true>(lds, g, S, E); }
    SEAM(6);
    if (IN(7)) norm_pass(P.in[I_X], Y, P.in[I_MIX_POST_G], P.out, P.in[I_MLP_PRE_G], XN, DM, 0, nullptr);
    SEAM(7);
    if (IN(8)) { pg8::Gemm g{XN, (const bf16_t*)(ws + WS_WUP), DM, DM, NTOK, DFF, DM}; pg8::StaticOrder S; S.init(NTOK, DFF, G, bid);
        pg8::Epi8<Relu2F> E{Relu2F{HB, DFF}}; pg8::gemm_phase<pg8::Epi8<Relu2F>, -1, true>(lds, g, S, E); }
    SEAM(8);
    if (IN(9)) { pg8::Gemm g{HB, (const bf16_t*)(ws + WS_WDN), DFF, DFF, NTOK, DM, DFF}; pg8::StaticOrder S; S.init(NTOK, DM, G, bid);
        pg8::Epi4<F32F> E{F32F{Y, DM}}; pg8::gemm_phase<pg8::Epi4<F32F>, -1, true>(lds, g, S, E); }
    SEAM(9);
    if (IN(10)) norm_pass(P.out, Y, P.in[I_MLP_POST_G], P.out, P.in[I_PLE_PRE_G], HB, PLEK, PLE, P.in[I_P]);
    SEAM(10);
    if (IN(11)) { pg8::Gemm g{HB, (const bf16_t*)(ws + WS_WPLE), PLEK, PLEK, NTOK, DM, PLEK}; pg8::StaticOrder S; S.init(NTOK, DM, G, bid);
        pg8::Epi4<PleF> E{PleF{Y, (f32x4*)(ws + WS_XN)}}; pg8::gemm_phase<pg8::Epi4<PleF>, 4, true>(lds, g, S, E); }
    SEAM(11);
    if (IN(12)) norm_pass(P.out, Y, P.in[I_PLE_POST_G], P.out, nullptr, nullptr, 0, 0, nullptr);
#undef IN
#undef SEAM
}

template <int LO, int HI> static void launch_range(const Params& P, int grid, hipStream_t stream, bool coop) {
    static bool attr = false;
    if (!attr) { (void)hipFuncSetAttribute((const void*)fwd_kernel<LO, HI>, hipFuncAttributeMaxDynamicSharedMemorySize, LDS_BYTES); attr = true; }
    if (coop) {
        Params p = P; void* args[] = {&p};
        const hipError_t e = hipLaunchCooperativeKernel((const void*)fwd_kernel<LO, HI>, dim3(grid), dim3(NTHR), args, LDS_BYTES, stream);
        if (e != hipSuccess) fprintf(stderr, "cooperative launch failed: %s (grid %d)\n", hipGetErrorString(e), grid);
    } else hipLaunchKernelGGL((fwd_kernel<LO, HI>), dim3(grid), dim3(NTHR), LDS_BYTES, stream, P);
}
template <int I> static void launch_each(const Params& P, int grid, hipStream_t stream) {
    if constexpr (I < NPHASE) { launch_range<I, I + 1>(P, grid, stream, false); launch_each<I + 1>(P, grid, stream); }
}

extern "C" void kernel_launch(void* const* d_in, const int* in_sizes, int n_in, void* d_out, int out_size, void* d_ws, size_t ws_size, hipStream_t stream) {
    if (n_in != 29 || out_size != NTOK * DM || ws_size < WS_END) { fprintf(stderr, "kernel_launch: unexpected shapes (n_in %d out %d ws %zu)\n", n_in, out_size, ws_size); return; }
    Params P{};
    for (int i = 0; i < 29; ++i) P.in[i] = (const float*)d_in[i];
    P.out = (float*)d_out; P.ws = (unsigned char*)d_ws;
#if MEGA
    static int grid = 0;
    if (!grid) {
        int dev = 0, cus = 0, per_cu = 0;
        (void)hipGetDevice(&dev); (void)hipDeviceGetAttribute(&cus, hipDeviceAttributeMultiprocessorCount, dev);
        (void)hipFuncSetAttribute((const void*)fwd_kernel<0, NPHASE>, hipFuncAttributeMaxDynamicSharedMemorySize, LDS_BYTES);
        (void)hipOccupancyMaxActiveBlocksPerMultiprocessor(&per_cu, (const void*)fwd_kernel<0, NPHASE>, NTHR, LDS_BYTES);
        if (per_cu < 1) per_cu = 1;
        grid = cus;
        if (grid > cus * per_cu) grid = cus * per_cu;
    }
    launch_range<0, NPHASE>(P, grid, stream, true);
#else
    launch_each<0>(P, 256, stream);
#endif
}
```

```cpp
#include <hip/hip_runtime.h>
#include <hip/hip_cooperative_groups.h>
#include <cstdio>
#include <cstdint>
#include <cmath>

#define LAS __attribute__((address_space(3)))
typedef unsigned short bf16_t;
typedef short bf16x8 __attribute__((ext_vector_type(8)));
typedef float f32x4 __attribute__((ext_vector_type(4)));
typedef unsigned u32x4 __attribute__((ext_vector_type(4)));
typedef unsigned u32x2 __attribute__((ext_vector_type(2)));

constexpr int NTOK = 32768, DM = 1024, SEQ = 2048, PROJW = 6144, DFF = 4096, PLE = 256, PLEK = PLE + DM;
constexpr float EPS = 1e-6f;
constexpr int NWAVES = 8, NTHR = 512;
constexpr size_t MiB = 1u << 20;
constexpr size_t WS_CTL = 0;
constexpr size_t WS_WIN = 1 * MiB;
constexpr size_t WS_WBR = 13 * MiB;
constexpr size_t WS_WOUT = 17 * MiB;
constexpr size_t WS_WUP = 19 * MiB;
constexpr size_t WS_WDN = 27 * MiB;
constexpr size_t WS_WPLE = 35 * MiB;
constexpr size_t WS_WCX = 38 * MiB;
constexpr size_t WS_WSP = 38 * MiB + 256 * 1024;
constexpr size_t WS_GATES = 39 * MiB;
constexpr size_t WS_XN = 40 * MiB;
constexpr size_t WS_PROJ = 104 * MiB;
constexpr size_t WS_HB = WS_PROJ;
constexpr size_t WS_Y = WS_PROJ + 256 * MiB;
constexpr size_t WS_END = 488 * MiB;

struct Params {
    const float* in[29];
    float* out;
    unsigned char* ws;
};
enum { I_X = 0, I_P, I_MIX_PRE_G, I_W_IN, I_CONV_W, I_CONV_B, I_WQ, I_WK, I_WV, I_W_IF, I_B_IF, I_M_NORM_G, I_M_SKIP, I_G_LN_W, I_G_LN_B, I_W_SP, I_B_SP,
       I_W_BR_M, I_W_BR_G, I_W_OUT, I_MIX_POST_G, I_MLP_PRE_G, I_W_UP, I_W_DOWN, I_MLP_POST_G, I_PLE_PRE_G, I_W_PLE_GATE, I_W_PLE_PROJ, I_PLE_POST_G };

__device__ __forceinline__ unsigned f2bf(float f) { unsigned u = __builtin_bit_cast(unsigned, f); return (u + 0x7fffu + ((u >> 16) & 1u)) >> 16; }
__device__ __forceinline__ unsigned pk2(float lo, float hi) { return f2bf(lo) | (f2bf(hi) << 16); }
__device__ __forceinline__ float bflo(unsigned w) { return __builtin_bit_cast(float, w << 16); }
__device__ __forceinline__ float bfhi(unsigned w) { return __builtin_bit_cast(float, w & 0xffff0000u); }
__device__ __forceinline__ float bf2f(bf16_t h) { return __builtin_bit_cast(float, (unsigned)h << 16); }
__device__ __forceinline__ float sigmoidf_(float x) { return 1.0f / (1.0f + __expf(-x)); }
__device__ __forceinline__ float siluf_(float x) { return x * sigmoidf_(x); }
__device__ __forceinline__ float gelu_tanh(float x) { const float z = 0.7978845608028654f * (x + 0.044715f * x * x * x); return x * sigmoidf_(2.0f * z); }
__device__ __forceinline__ float log_sigmoid(float x) { return fminf(x, 0.f) - log1pf(expf(-fabsf(x))); }
__device__ __forceinline__ float wave_sum(float v) {
#pragma unroll
    for (int o = 1; o < 64; o <<= 1) v += __shfl_xor(v, o);
    return v;
}
#define LDS_WAIT() asm volatile("s_waitcnt lgkmcnt(0)" ::: "memory")

template <bool GATE_REMAP = false>
__device__ __forceinline__ void transpose_item(const float* W, int K, int N, bf16_t* WT, int ldw, int koff, LAS float* scr, int item, int lane) {
    const int nblk = N / 32, kb = item / nblk, nb = item % nblk, k0 = 64 * kb, n0 = 32 * nb;
    int r0 = n0; if (GATE_REMAP && n0 >= 4 * DM) { const int g = n0 - 4 * DM, j = g & (DM - 1); r0 = 4 * DM + (j >> 7) * 256 + (g >= DM ? 128 : 0) + (j & 127); }
#pragma unroll 8
    for (int i = 0; i < 32; ++i) { const int kk = 2 * i + (lane >> 5); scr[kk * 33 + (lane & 31)] = W[(size_t)(k0 + kk) * N + n0 + (lane & 31)]; }
    LDS_WAIT();
    const int c = lane & 7;
#pragma unroll
    for (int j = 0; j < 4; ++j) { const int n = (lane >> 3) + 8 * j; const LAS float* s = scr + (8 * c) * 33 + n;
        u32x4 o; o.x = pk2(s[0 * 33], s[1 * 33]); o.y = pk2(s[2 * 33], s[3 * 33]); o.z = pk2(s[4 * 33], s[5 * 33]); o.w = pk2(s[6 * 33], s[7 * 33]);
        *(u32x4*)(WT + (size_t)(r0 + n) * ldw + koff + k0 + 8 * c) = o; }
    LDS_WAIT();
}
__device__ __forceinline__ void rms_row_to_bf16(const float* xrow, const float* g, bf16_t* orow, int lane) {
    const f32x4* xr = (const f32x4*)xrow + lane; const f32x4* gr = (const f32x4*)g + lane;
    f32x4 v[4]; float s = 0.f;
#pragma unroll
    for (int j = 0; j < 4; ++j) { v[j] = xr[64 * j]; s += (v[j].x * v[j].x + v[j].y * v[j].y) + (v[j].z * v[j].z + v[j].w * v[j].w); }
    const float r = 1.0f / sqrtf(wave_sum(s) * (1.f / DM) + EPS);
    u32x2* o8 = (u32x2*)orow + lane;
#pragma unroll
    for (int j = 0; j < 4; ++j) { const f32x4 gv = gr[64 * j]; u32x2 o; o.x = pk2(v[j].x * r * gv.x, v[j].y * r * gv.y); o.y = pk2(v[j].z * r * gv.z, v[j].w * r * gv.w); o8[64 * j] = o; }
}
__device__ void p0_prologue(const Params& P, LAS unsigned char* lds) {
    const int tid = threadIdx.x, lane = tid & 63, wave = tid >> 6;
    LAS float* scr = (LAS float*)(lds + wave * 16384);
    const int gw = blockIdx.x * NWAVES + wave, NGW = gridDim.x * NWAVES;
    unsigned char* ws = P.ws;
    constexpr int I_IN = 16 * 192, I_SQ = 16 * 32, I_UP = 16 * 128, I_DN = 64 * 32, I_PP = 4 * 32;
    constexpr int NIT = I_IN + 4 * I_SQ + I_UP + I_DN + I_PP;
    for (int it = gw; it < NIT; it += NGW) {
        int r = it;
        if (r < I_IN) { transpose_item<true>(P.in[I_W_IN], DM, PROJW, (bf16_t*)(ws + WS_WIN), DM, 0, scr, r, lane); continue; } r -= I_IN;
        if (r < I_SQ) { transpose_item(P.in[I_W_BR_M], DM, DM, (bf16_t*)(ws + WS_WBR), 2 * DM, 0, scr, r, lane); continue; } r -= I_SQ;
        if (r < I_SQ) { transpose_item(P.in[I_W_BR_G], DM, DM, (bf16_t*)(ws + WS_WBR), 2 * DM, DM, scr, r, lane); continue; } r -= I_SQ;
        if (r < I_SQ) { transpose_item(P.in[I_W_OUT], DM, DM, (bf16_t*)(ws + WS_WOUT), DM, 0, scr, r, lane); continue; } r -= I_SQ;
        if (r < I_SQ) { transpose_item(P.in[I_W_PLE_GATE], DM, DM, (bf16_t*)(ws + WS_WPLE), PLEK, PLE, scr, r, lane); continue; } r -= I_SQ;
        if (r < I_UP) { transpose_item(P.in[I_W_UP], DM, DFF, (bf16_t*)(ws + WS_WUP), DM, 0, scr, r, lane); continue; } r -= I_UP;
        if (r < I_DN) { transpose_item(P.in[I_W_DOWN], DFF, DM, (bf16_t*)(ws + WS_WDN), DFF, 0, scr, r, lane); continue; } r -= I_DN;
        transpose_item(P.in[I_W_PLE_PROJ], PLE, DM, (bf16_t*)(ws + WS_WPLE), PLEK, 0, scr, r, lane);
    }
    {
        float* wcx = (float*)(ws + WS_WCX);
        const float* wq = P.in[I_WQ]; const float* wk = P.in[I_WK]; const float* wv = P.in[I_WV]; const float* wif = P.in[I_W_IF];
        for (int i = blockIdx.x * NTHR + tid; i < DM * 8; i += gridDim.x * NTHR) {
            const int c = i >> 3, j = i & 7, blk = c >> 2, d = c & 3; float sc = 0.f, sx = 0.f;
#pragma unroll
            for (int e = 0; e < 4; ++e) {
                sc += wq[blk * 16 + d * 4 + e] * wif[(size_t)(blk * 4 + e) * 8 + j] + wk[blk * 16 + d * 4 + e] * wif[(size_t)(DM + blk * 4 + e) * 8 + j];
                sx += wv[blk * 16 + d * 4 + e] * wif[(size_t)(2 * DM + blk * 4 + e) * 8 + j]; }
            wcx[i] = sc; wcx[DM * 8 + i] = sx;
        }
    }
    { bf16_t* wsp = (bf16_t*)(ws + WS_WSP); const float* w = P.in[I_W_SP];
      for (int i = blockIdx.x * NTHR + tid; i < 8 * 128 * 128; i += gridDim.x * NTHR) { const int t = (i >> 7) & 127, s = i & 127; wsp[i] = (bf16_t)f2bf(s <= t ? w[i] : 0.f); } }
    bf16_t* XN = (bf16_t*)(ws + WS_XN);
    for (int m = gw; m < NTOK; m += NGW) rms_row_to_bf16(P.in[I_X] + (size_t)m * DM, P.in[I_MIX_PRE_G], XN + (size_t)m * DM, lane);
}

namespace pg8 {
constexpr int BM = 256, BK = 64, HALF = 128, HTB = HALF * BK * 2, STAGE_BYTES = 8 * HTB, NXCD = 8, WGM = 8;
__host__ __device__ __forceinline__ int lds_byte(int r, int c) { const int st = (r >> 4) * 2 + (c >> 5), rr = r & 15, cc = c & 31, ob = rr * 64 + cc * 2; return st * 1024 + (ob ^ (((ob >> 9) & 1) << 5)); }
__host__ __device__ __forceinline__ void stage_rc(int b, int& R, int& C) { const int st = b / 1024, sb = b % 1024, swz = sb ^ (((sb >> 9) & 1) << 5); R = (st >> 1) * 16 + swz / 64; C = (st & 1) * 32 + (swz % 64) / 2; }
__host__ __device__ __forceinline__ int perm32(int rho) { const int n = rho >> 4, i = rho & 15; return 8 * (i >> 2) + 4 * n + (i & 3); }
struct Unit { int pm, pn; };
struct Gemm { const bf16_t* A; const bf16_t* Bt; int lda, ldb, M, N, K; };
struct StaticOrder {
    int nM, nN, nwg, G, c;
    __host__ __device__ void init(int M, int N, int G_, int c_) { nM = M / BM; nN = N / BM; nwg = nM * nN; G = G_; c = c_; }
    __host__ __device__ bool next(int i, Unit& u) const {
        const long L = (long)i * G + c; if (L >= nwg) return false;
        int wgid = (int)L; { const int q = nwg / NXCD, r = nwg % NXCD, xcd = wgid % NXCD, off = wgid / NXCD; wgid = (xcd < r ? xcd * (q + 1) : r * (q + 1) + (xcd - r) * q) + off; }
        const int nig = WGM * nN, gid = wgid / nig, fm = gid * WGM, gsz = (nM - fm) < WGM ? (nM - fm) : WGM;
        u.pm = fm + ((wgid % nig) % gsz); u.pn = (wgid % nig) / gsz; return true;
    }
};
template <class F> struct Epi8 {
    static constexpr bool PERM = true; F f;
    __device__ __forceinline__ void operator()(f32x4 (&acc)[2][2][4][2], const Unit& u_, int wr, int wc, int fr, int fq) const {
        Unit u = u_; asm volatile("" : "+s"(u.pm), "+s"(u.pn));
#pragma unroll
        for (int ai = 0; ai < 2; ++ai)
#pragma unroll
            for (int m = 0; m < 4; ++m)
                { f.store16(u.pm * BM + ai * HALF + wr * 64 + m * 16 + fr, u.pn, wc * 32 + 8 * fq, acc[ai][0][m][0], acc[ai][0][m][1], acc[ai][1][m][0], acc[ai][1][m][1]); asm volatile("" ::: "memory"); }
    }
    __device__ __forceinline__ void mid(f32x4 (&acc)[2][2][4][2], const Unit& u_, int wr, int wc, int fr, int fq) const {
        Unit u = u_; asm volatile("" : "+s"(u.pm), "+s"(u.pn));
#pragma unroll
        for (int ai = 0; ai < 2; ++ai)
#pragma unroll
            for (int m = 0; m < 4; ++m)
#pragma unroll
                for (int bj = 0; bj < 2; ++bj) { f.mid8(u.pm * BM + ai * HALF + wr * 64 + m * 16 + fr, u.pn * BM + bj * HALF + wc * 32 + 8 * fq, acc[ai][bj][m][0], acc[ai][bj][m][1]); asm volatile("" ::: "memory"); }
    }
};
template <class F> struct Epi4 {
    static constexpr bool PERM = false; F f;
    __device__ __forceinline__ void operator()(f32x4 (&acc)[2][2][4][2], const Unit& u_, int wr, int wc, int fr, int fq) const {
        Unit u = u_; asm volatile("" : "+s"(u.pm), "+s"(u.pn));
#pragma unroll
        for (int ai = 0; ai < 2; ++ai)
#pragma unroll
            for (int m = 0; m < 4; ++m)
#pragma unroll
                for (int bj = 0; bj < 2; ++bj)
#pragma unroll
                    for (int n = 0; n < 2; ++n) { f.store4(u.pm * BM + ai * HALF + wr * 64 + m * 16 + fr, u.pn * BM + bj * HALF + wc * 32 + 16 * n + 4 * fq, acc[ai][bj][m][n], ((ai * 4 + m) * 2 + bj) * 2 + n); if (n) asm volatile("" ::: "memory"); }
    }
    __device__ __forceinline__ void mid(f32x4 (&acc)[2][2][4][2], const Unit& u_, int wr, int wc, int fr, int fq) const {
        Unit u = u_; asm volatile("" : "+s"(u.pm), "+s"(u.pn));
#pragma unroll
        for (int ai = 0; ai < 2; ++ai)
#pragma unroll
            for (int m = 0; m < 4; ++m)
#pragma unroll
                for (int bj = 0; bj < 2; ++bj)
#pragma unroll
                    for (int n = 0; n < 2; ++n) { f.mid4(u.pm * BM + ai * HALF + wr * 64 + m * 16 + fr, u.pn * BM + bj * HALF + wc * 32 + 16 * n + 4 * fq, acc[ai][bj][m][n], ((ai * 4 + m) * 2 + bj) * 2 + n); if (n) asm volatile("" ::: "memory"); }
    }
};
template <class Epi, int HOOK_T, bool ALIGN_EPI>
__device__ __forceinline__ void gemm_phase(LAS unsigned char* lds, const Gemm g, const StaticOrder& S, const Epi& E) {
    const int tid = threadIdx.x, wid = __builtin_amdgcn_readfirstlane(tid >> 6), lane = tid & 63, wr = wid >> 2, wc = wid & 3, fr = lane & 15, fq = lane >> 4;
    const int K = g.K, nt = K / BK;
    unsigned voffA[2], voffB[2];
#pragma unroll
    for (int i = 0; i < 2; ++i) { int R, C; stage_rc(tid * 16 + i * 8192, R, C); const int Rb = Epi::PERM ? ((R & ~31) + perm32(R & 31)) : R;
        voffA[i] = (unsigned)(R * g.lda + C) * 2u; voffB[i] = (unsigned)(Rb * g.ldb + C) * 2u; }
    const size_t kstep = (size_t)(BK * 2);
    const size_t hstepA = (size_t)HALF * g.lda * 2, hstepB = (size_t)HALF * g.ldb * 2;
    const size_t tstepA = 2 * hstepA, tstepB = 2 * hstepB;
    const unsigned ldsw = (unsigned)wid * 1024u;
    const int aoff = lds_byte(wr * 64 + fr, fq * 8), boff = lds_byte(wc * 32 + fr, fq * 8);
#define PG8_SA(b, h) (((b) * 2 + (h)) * HTB)
#define PG8_SB(b, h) ((4 + (b) * 2 + (h)) * HTB)
#define PG8_STAGE(bufoff, gbase, voff) do { _Pragma("unroll") for (int _i = 0; _i < 2; ++_i) \
        __builtin_amdgcn_global_load_lds((const unsigned*)((const char*)(gbase) + (voff)[_i]), (LAS unsigned*)(lds + (bufoff) + ldsw + _i * 8192), 16, 0, 0); } while (0)
#define PG8_LDA(dst, b, h) do { _Pragma("unroll") for (int m = 0; m < 4; ++m) _Pragma("unroll") for (int k = 0; k < 2; ++k) dst[m][k] = *(const LAS bf16x8*)(lds + PG8_SA(b, h) + aoff + m * 2048 + k * 1024); } while (0)
#define PG8_LDB(dst, b, h) do { _Pragma("unroll") for (int n = 0; n < 2; ++n) _Pragma("unroll") for (int k = 0; k < 2; ++k) dst[n][k] = *(const LAS bf16x8*)(lds + PG8_SB(b, h) + boff + n * 2048 + k * 1024); } while (0)
#define PG8_MMA(ai, bj, At, Bt) do { __builtin_amdgcn_s_setprio(1); _Pragma("unroll") for (int m = 0; m < 4; ++m) _Pragma("unroll") for (int n = 0; n < 2; ++n) _Pragma("unroll") for (int k = 0; k < 2; ++k) \
        acc[ai][bj][m][n] = __builtin_amdgcn_mfma_f32_16x16x32_bf16(Bt[n][k], At[m][k], acc[ai][bj][m][n], 0, 0, 0); __builtin_amdgcn_s_setprio(0); } while (0)
#define PG8_WAIT_V(n) asm volatile("s_waitcnt vmcnt(" #n ")" ::: "memory")
#define PG8_WAIT_L(n) asm volatile("s_waitcnt lgkmcnt(" #n ")" ::: "memory")
#define PG8_BAR __builtin_amdgcn_s_barrier()
#define PG8_SCHED __builtin_amdgcn_sched_barrier(0)
    Unit cur, nxt; int ui = 0;
    if (!S.next(0, cur)) return;
    f32x4 acc[2][2][4][2];
#pragma unroll
    for (int a = 0; a < 2; ++a)
#pragma unroll
        for (int b = 0; b < 2; ++b)
#pragma unroll
            for (int m = 0; m < 4; ++m)
#pragma unroll
                for (int n = 0; n < 2; ++n) acc[a][b][m][n] = (f32x4){0.f, 0.f, 0.f, 0.f};
    bf16x8 At[4][2], B0[2][2], B1[2][2];
    const char* cA = (const char*)g.A + (size_t)cur.pm * tstepA; const char* cB = (const char*)g.Bt + (size_t)cur.pn * tstepB;
    PG8_STAGE(PG8_SB(0, 0), cB, voffB); PG8_STAGE(PG8_SB(0, 1), cB + hstepB, voffB); PG8_STAGE(PG8_SA(0, 0), cA, voffA); PG8_STAGE(PG8_SA(0, 1), cA + hstepA, voffA);
    if (wr == 1) PG8_BAR;
    PG8_WAIT_V(2); PG8_BAR;
    PG8_STAGE(PG8_SB(1, 0), cB + kstep, voffB); PG8_STAGE(PG8_SA(1, 0), cA + kstep, voffA); PG8_STAGE(PG8_SB(1, 1), cB + hstepB + kstep, voffB);
    PG8_WAIT_V(6); PG8_BAR;
    for (;;) {
        const bool has_next = S.next(ui + 1, nxt);
        const char* nA = has_next ? (const char*)g.A + (size_t)nxt.pm * tstepA : cA; const char* nB = has_next ? (const char*)g.Bt + (size_t)nxt.pn * tstepB : cB;
#define PG8_KBODY() do { \
            const bool last = (t == nt - 2); \
            const char* a1 = cA + (size_t)(t + 1) * kstep; \
            const char* a2 = last ? nA : cA + (size_t)(t + 2) * kstep; const char* b2 = last ? nB : cB + (size_t)(t + 2) * kstep; \
            const char* a3 = a2 + kstep; const char* b3 = b2 + kstep; \
            PG8_LDB(B0, 0, 0); PG8_LDB(B1, 0, 1); PG8_SCHED; PG8_LDA(At, 0, 0); PG8_STAGE(PG8_SA(1, 1), a1 + hstepA, voffA); \
            PG8_WAIT_V(8); PG8_WAIT_L(0); PG8_BAR; PG8_MMA(0, 0, At, B0); PG8_MMA(0, 1, At, B1); PG8_BAR; PG8_SCHED; \
            PG8_LDA(At, 0, 1); PG8_STAGE(PG8_SB(0, 0), b2, voffB); PG8_STAGE(PG8_SB(0, 1), b2 + hstepB, voffB); PG8_STAGE(PG8_SA(0, 0), a2, voffA); \
            PG8_WAIT_V(8); PG8_WAIT_L(0); PG8_BAR; PG8_MMA(1, 0, At, B0); PG8_MMA(1, 1, At, B1); PG8_BAR; PG8_SCHED; \
            PG8_LDB(B0, 1, 0); PG8_LDB(B1, 1, 1); PG8_SCHED; PG8_LDA(At, 1, 0); PG8_STAGE(PG8_SA(0, 1), a2 + hstepA, voffA); \
            PG8_WAIT_V(8); PG8_WAIT_L(0); PG8_BAR; PG8_MMA(0, 0, At, B0); PG8_MMA(0, 1, At, B1); PG8_BAR; PG8_SCHED; \
            PG8_LDA(At, 1, 1); PG8_STAGE(PG8_SB(1, 0), b3, voffB); PG8_STAGE(PG8_SB(1, 1), b3 + hstepB, voffB); PG8_STAGE(PG8_SA(1, 0), a3, voffA); \
            PG8_WAIT_V(8); PG8_WAIT_L(0); PG8_BAR; PG8_MMA(1, 0, At, B0); PG8_MMA(1, 1, At, B1); PG8_BAR; PG8_SCHED; \
        } while (0)
        int t = 0;
        if constexpr (HOOK_T > 0) {
            for (; t < HOOK_T; t += 2) PG8_KBODY();
            PG8_SCHED; E.mid(acc, cur, wr, wc, fr, fq); PG8_SCHED;
        }
        for (; t < nt; t += 2) PG8_KBODY();
#undef PG8_KBODY
        if constexpr (ALIGN_EPI) { if (wr == 0) PG8_BAR; }
        E(acc, cur, wr, wc, fr, fq);
        if (!has_next) break;
#pragma unroll
        for (int a = 0; a < 2; ++a)
#pragma unroll
            for (int b = 0; b < 2; ++b)
#pragma unroll
                for (int m = 0; m < 4; ++m)
#pragma unroll
                    for (int n = 0; n < 2; ++n) acc[a][b][m][n] = (f32x4){0.f, 0.f, 0.f, 0.f};
        cur = nxt; cA = nA; cB = nB; ++ui;
        if constexpr (ALIGN_EPI) { if (wr == 1) PG8_BAR; }
    }
    PG8_WAIT_V(0);
    if constexpr (!ALIGN_EPI) { if (wr == 0) PG8_BAR; }
    PG8_BAR;
#undef PG8_SA
#undef PG8_SB
#undef PG8_STAGE
#undef PG8_LDA
#undef PG8_LDB
#undef PG8_MMA
#undef PG8_WAIT_V
#undef PG8_WAIT_L
#undef PG8_BAR
#undef PG8_SCHED
}
}
__device__ __forceinline__ void st_bf16x8(bf16_t* p, f32x4 a, f32x4 b) { u32x4 o; o.x = pk2(a.x, a.y); o.y = pk2(a.z, a.w); o.z = pk2(b.x, b.y); o.w = pk2(b.z, b.w); *(u32x4*)p = o; }
__device__ __forceinline__ void ld_bf16x8(const bf16_t* p, f32x4& a, f32x4& b) { const u32x4 w = *(const u32x4*)p; a = (f32x4){bflo(w.x), bfhi(w.x), bflo(w.y), bfhi(w.y)}; b = (f32x4){bflo(w.z), bfhi(w.z), bflo(w.w), bfhi(w.w)}; }
template <class FN> __device__ __forceinline__ f32x4 map4(f32x4 v, FN fn) { return (f32x4){fn(v.x), fn(v.y), fn(v.z), fn(v.w)}; }
struct ProjF {
    bf16_t* proj;
    __device__ __forceinline__ void store16(int row, int pn, int cl, f32x4 a0, f32x4 a1, f32x4 b0, f32x4 b1) const {
        bf16_t* rp = proj + (size_t)row * PROJW;
        if (pn < 16) {
            const int sec = pn >> 2;
            if (sec == 1) { a0 = map4(a0, siluf_); a1 = map4(a1, siluf_); b0 = map4(b0, siluf_); b1 = map4(b1, siluf_); }
            else if (sec >= 2) { a0 = map4(a0, gelu_tanh); a1 = map4(a1, gelu_tanh); b0 = map4(b0, gelu_tanh); b1 = map4(b1, gelu_tanh); }
            st_bf16x8(rp + pn * 256 + cl, a0, a1); st_bf16x8(rp + pn * 256 + 128 + cl, b0, b1);
        } else {
            const int j = (pn - 16) * 128 + cl;
            a0 = map4(a0, sigmoidf_); a1 = map4(a1, sigmoidf_); b0 = map4(b0, sigmoidf_); b1 = map4(b1, sigmoidf_);
            st_bf16x8(rp + 4 * DM + j, a0 / b0, a1 / b1); st_bf16x8(rp + 5 * DM + j, b0, b1);
        }
    }
    __device__ __forceinline__ void mid8(int, int, f32x4&, f32x4&) const {}
};
struct MergeF {
    const bf16_t* proj; bf16_t* merged;
    __device__ __forceinline__ void mid8(int row, int col, f32x4& a, f32x4& b) const {
        f32x4 r0, r1; ld_bf16x8(proj + (size_t)row * PROJW + 4 * DM + col, r0, r1); a = a * r0; b = b * r1;
    }
    __device__ __forceinline__ void store16(int row, int pn, int cl, f32x4 a0, f32x4 a1, f32x4 b0, f32x4 b1) const {
        const int col = pn * 256 + cl; f32x4 g0, g1;
        ld_bf16x8(proj + (size_t)row * PROJW + 5 * DM + col, g0, g1); st_bf16x8(merged + (size_t)row * DM + col, a0 * g0, a1 * g1);
        ld_bf16x8(proj + (size_t)row * PROJW + 5 * DM + col + 128, g0, g1); st_bf16x8(merged + (size_t)row * DM + col + 128, b0 * g0, b1 * g1);
    }
};
struct F32F {
    float* o; int ldc;
    __device__ __forceinline__ void store4(int row, int col, f32x4 v, int) const { *(f32x4*)(o + (size_t)row * ldc + col) = v; }
    __device__ __forceinline__ void mid4(int, int, f32x4&, int) const {}
};
struct Relu2F {
    bf16_t* o; int ldc;
    __device__ __forceinline__ void store16(int row, int pn, int cl, f32x4 a0, f32x4 a1, f32x4 b0, f32x4 b1) const {
        auto r2 = [](float x) { const float r = fmaxf(x, 0.f); return r * r; };
        bf16_t* p = o + (size_t)row * ldc + pn * 256 + cl;
        st_bf16x8(p, map4(a0, r2), map4(a1, r2)); st_bf16x8(p + 128, map4(b0, r2), map4(b1, r2));
    }
    __device__ __forceinline__ void mid8(int, int, f32x4&, f32x4&) const {}
};
struct PleF {
    float* o; f32x4* stash;
    __device__ __forceinline__ void mid4(int, int, f32x4& v, int idx) const { unsigned t = threadIdx.x; asm volatile("" : "+v"(t)); stash[((size_t)blockIdx.x * 32 + idx) * NTHR + t] = v; v = (f32x4){0.f, 0.f, 0.f, 0.f}; }
    __device__ __forceinline__ void store4(int row, int col, f32x4 v, int idx) const {
        unsigned t = threadIdx.x; asm volatile("" : "+v"(t)); const f32x4 p = stash[((size_t)blockIdx.x * 32 + idx) * NTHR + t];
        *(f32x4*)(o + (size_t)row * DM + col) = map4(v, sigmoidf_) * p;
    }
};

__device__ __forceinline__ void ld4(const bf16_t* p, float (&x)[4]) { const u32x2 w = *(const u32x2*)p; x[0] = bflo(w.x); x[1] = bfhi(w.x); x[2] = bflo(w.y); x[3] = bfhi(w.y); }
__device__ __forceinline__ void st4(bf16_t* p, const float (&x)[4]) { u32x2 o; o.x = pk2(x[0], x[1]); o.y = pk2(x[2], x[3]); *(u32x2*)p = o; }
__device__ void p2_qkv(const Params& P, LAS unsigned char* lds) {
    const int tid = threadIdx.x, lane = tid & 63, wave = tid >> 6, h = wave & 3, half = wave >> 2;
    unsigned char* ws = P.ws;
    const bf16_t* PROJ = (const bf16_t*)(ws + WS_PROJ);
    bf16_t* Q = (bf16_t*)P.out; bf16_t* K = Q + (size_t)NTOK * DM; bf16_t* V = (bf16_t*)(ws + WS_XN);
    float* GATES = (float*)(ws + WS_GATES);
    LAS float* part = (LAS float*)lds;
    const int ch = h * 256 + lane * 4, blk = ch >> 2;
    float cw[4][4], cb[4], wq[4][4], wk[4][4], wv[4][4], wc[4][8], wx[4][8];
#pragma unroll
    for (int j = 0; j < 4; ++j)
#pragma unroll
        for (int d = 0; d < 4; ++d) cw[j][d] = P.in[I_CONV_W][j * DM + ch + d];
#pragma unroll
    for (int d = 0; d < 4; ++d) { cb[d] = P.in[I_CONV_B][ch + d];
#pragma unroll
        for (int e = 0; e < 4; ++e) { wq[d][e] = P.in[I_WQ][blk * 16 + d * 4 + e]; wk[d][e] = P.in[I_WK][blk * 16 + d * 4 + e]; wv[d][e] = P.in[I_WV][blk * 16 + d * 4 + e]; }
#pragma unroll
        for (int j = 0; j < 8; ++j) { wc[d][j] = ((const float*)(ws + WS_WCX))[(ch + d) * 8 + j]; wx[d][j] = ((const float*)(ws + WS_WCX))[DM * 8 + (ch + d) * 8 + j]; } }
    for (int item = blockIdx.x; item < NTOK / 16; item += gridDim.x) {
        const int tb = item * 16 + half * 8;
        float x0[4], x1[4], x2[4], x3[4];
        if ((tb & (SEQ - 1)) == 0) {
#pragma unroll
            for (int d = 0; d < 4; ++d) { x0[d] = 0.f; x1[d] = 0.f; x2[d] = 0.f; }
        } else { ld4(PROJ + (size_t)(tb - 3) * PROJW + ch, x0); ld4(PROJ + (size_t)(tb - 2) * PROJW + ch, x1); ld4(PROJ + (size_t)(tb - 1) * PROJW + ch, x2); }
#pragma unroll 1
        for (int i = 0; i < 8; ++i) {
            const int t = tb + i;
            ld4(PROJ + (size_t)t * PROJW + ch, x3);
            float mc[4], q[4], k[4], v[4], gp[8];
#pragma unroll
            for (int d = 0; d < 4; ++d) mc[d] = siluf_(cw[0][d] * x0[d] + cw[1][d] * x1[d] + cw[2][d] * x2[d] + cw[3][d] * x3[d] + cb[d]);
#pragma unroll
            for (int e = 0; e < 4; ++e) { q[e] = mc[0] * wq[0][e] + mc[1] * wq[1][e] + mc[2] * wq[2][e] + mc[3] * wq[3][e];
                k[e] = mc[0] * wk[0][e] + mc[1] * wk[1][e] + mc[2] * wk[2][e] + mc[3] * wk[3][e];
                v[e] = x3[0] * wv[0][e] + x3[1] * wv[1][e] + x3[2] * wv[2][e] + x3[3] * wv[3][e]; }
            st4(Q + (size_t)t * DM + ch, q); st4(K + (size_t)t * DM + ch, k); st4(V + (size_t)t * DM + ch, v);
#pragma unroll
            for (int j = 0; j < 8; ++j) { float s = 0.f;
#pragma unroll
                for (int d = 0; d < 4; ++d) s += mc[d] * wc[d][j] + x3[d] * wx[d][j];
                gp[j] = wave_sum(s); }
            if (lane == 0) {
#pragma unroll
                for (int j = 0; j < 8; ++j) part[((half * 8 + i) * 4 + h) * 8 + j] = gp[j]; }
#pragma unroll
            for (int d = 0; d < 4; ++d) { x0[d] = x1[d]; x1[d] = x2[d]; x2[d] = x3[d]; }
        }
        __syncthreads();
        if (tid < 128) { const int tok = tid >> 3, j = tid & 7;
            const float val = part[(tok * 4 + 0) * 8 + j] + part[(tok * 4 + 1) * 8 + j] + part[(tok * 4 + 2) * 8 + j] + part[(tok * 4 + 3) * 8 + j] + P.in[I_B_IF][j];
            GATES[(size_t)(item * 16 + tok) * 8 + j] = (j < 4) ? val : log_sigmoid(val); }
        __syncthreads();
    }
    bf16_t* PW = (bf16_t*)(ws + WS_PROJ);
    const int gw = blockIdx.x * NWAVES + wave, NGW = gridDim.x * NWAVES;
    for (int m = gw; m < NTOK; m += NGW) {
        bf16_t* row = PW + (size_t)m * PROJW + 3 * DM + lane * 16;
        const u32x4 a = *(const u32x4*)row, b = *(const u32x4*)(row + 8);
        float x[16] = {bflo(a.x), bfhi(a.x), bflo(a.y), bfhi(a.y), bflo(a.z), bfhi(a.z), bflo(a.w), bfhi(a.w), bflo(b.x), bfhi(b.x), bflo(b.y), bfhi(b.y), bflo(b.z), bfhi(b.z), bflo(b.w), bfhi(b.w)};
        float s = 0.f;
#pragma unroll
        for (int i = 0; i < 16; ++i) s += x[i];
        const float mu = wave_sum(s) * (1.f / DM); float s2 = 0.f;
#pragma unroll
        for (int i = 0; i < 16; ++i) { x[i] -= mu; s2 += x[i] * x[i]; }
        const float r = 1.0f / sqrtf(wave_sum(s2) * (1.f / DM) + EPS);
        const float* lw = P.in[I_G_LN_W] + lane * 16; const float* lb = P.in[I_G_LN_B] + lane * 16;
#pragma unroll
        for (int i = 0; i < 16; ++i) x[i] = x[i] * r * lw[i] + lb[i];
        u32x4 oa, ob; oa.x = pk2(x[0], x[1]); oa.y = pk2(x[2], x[3]); oa.z = pk2(x[4], x[5]); oa.w = pk2(x[6], x[7]); ob.x = pk2(x[8], x[9]); ob.y = pk2(x[10], x[11]); ob.z = pk2(x[12], x[13]); ob.w = pk2(x[14], x[15]);
        *(u32x4*)row = oa; *(u32x4*)(row + 8) = ob;
    }
}

constexpr int ML_C = 0, ML_N = 65536, ML_Q = ML_N + 1024, ML_K = ML_Q + 32768, ML_V = ML_K + 32768, ML_P = ML_V + 8192, ML_S = ML_P + 16384, ML_BYTES = ML_S + 2048;
__device__ void p3_mlstm_naive(const Params& P, LAS unsigned char* lds) {
    const int tid = threadIdx.x, lane = tid & 63, wave = tid >> 6;
    unsigned char* ws = P.ws;
    const bf16_t* Q = (const bf16_t*)P.out; const bf16_t* K = Q + (size_t)NTOK * DM; bf16_t* V = (bf16_t*)(ws + WS_XN);
    const float* GATES = (const float*)(ws + WS_GATES);
    LAS float* Cs = (LAS float*)(lds + ML_C); LAS float* ns = (LAS float*)(lds + ML_N);
    LAS unsigned* qs = (LAS unsigned*)(lds + ML_Q); LAS unsigned* ks = (LAS unsigned*)(lds + ML_K);
    LAS bf16_t* vs = (LAS bf16_t*)(lds + ML_V);
    LAS float* Ps = (LAS float*)(lds + ML_P);
    LAS float* sc = (LAS float*)(lds + ML_S);
    for (int item = blockIdx.x; item < 256; item += gridDim.x) {
        const int b = item >> 4, h = (item >> 2) & 3, j = item & 3;
        for (int i = tid; i < 256 * 64; i += NTHR) Cs[i] = 0.f;
        if (tid < 256) ns[tid] = 0.f;
        float m = 0.f;
        __syncthreads();
        for (int c = 0; c < 32; ++c) {
            const size_t t0 = (size_t)b * SEQ + c * 64;
#pragma unroll
            for (int i = 0; i < 4; ++i) { const int p = tid + i * NTHR, r = p >> 5, cc = p & 31;
                *(LAS u32x4*)(qs + r * 128 + cc * 4) = *(const u32x4*)(Q + (t0 + r) * DM + h * 256 + cc * 8);
                *(LAS u32x4*)(ks + r * 128 + cc * 4) = *(const u32x4*)(K + (t0 + r) * DM + h * 256 + cc * 8); }
            { const int r = tid >> 3, cc = tid & 7; *(LAS u32x4*)(vs + r * 64 + cc * 8) = *(const u32x4*)(V + (t0 + r) * DM + h * 256 + j * 64 + cc * 8); }
            if (wave == 0) {
                const float ig = GATES[(t0 + lane) * 8 + h], lf = GATES[(t0 + lane) * 8 + 4 + h];
                float bs = lf;
#pragma unroll
                for (int o = 1; o < 64; o <<= 1) { const float t = __shfl_up(bs, o); if (lane >= o) bs += t; }
                const float u = ig - bs; float gm = u;
#pragma unroll
                for (int o = 1; o < 64; o <<= 1) { const float t = __shfl_up(gm, o); if (lane >= o) gm = fmaxf(gm, t); }
                const float g = fmaxf(gm, m), gL = __shfl(g, 63), bL = __shfl(bs, 63);
                sc[lane] = u; sc[64 + lane] = g; sc[128 + lane] = expf(m - g); sc[192 + lane] = expf(-bs - g); sc[256 + lane] = expf(u - gL);
                if (lane == 0) sc[384] = expf(m - gL);
                m = bL + gL;
            }
            __syncthreads();
            { const int t = tid >> 3, sg = tid & 7; float acc[8];
#pragma unroll
                for (int i = 0; i < 8; ++i) acc[i] = 0.f;
                if (sg * 8 <= t) {
                    for (int d2 = 0; d2 < 128; ++d2) { const unsigned qw = qs[t * 128 + d2]; const float ql = bflo(qw), qh = bfhi(qw);
#pragma unroll
                        for (int i = 0; i < 8; ++i) { const unsigned kw = ks[(sg * 8 + i) * 128 + d2]; acc[i] += ql * bflo(kw) + qh * bfhi(kw); } } }
                const float gt = sc[64 + t];
#pragma unroll
                for (int i = 0; i < 8; ++i) { const int s = sg * 8 + i; Ps[t * 64 + s] = (s <= t) ? acc[i] * 0.0625f * expf(sc[s] - gt) : 0.f; } }
            __syncthreads();
            if (tid < 64) { const int t = tid; float qn = 0.f;
                for (int d2 = 0; d2 < 128; ++d2) { const unsigned qw = qs[t * 128 + d2]; qn += bflo(qw) * ns[2 * d2] + bfhi(qw) * ns[2 * d2 + 1]; }
                float ps = 0.f;
                for (int s = 0; s <= t; ++s) ps += Ps[t * 64 + s];
                sc[320 + t] = sc[128 + t] * qn + ps; }
            __syncthreads();
            { const int t = tid >> 3, eg = tid & 7; float acc[8];
#pragma unroll
                for (int i = 0; i < 8; ++i) acc[i] = 0.f;
                for (int d2 = 0; d2 < 128; ++d2) { const unsigned qw = qs[t * 128 + d2]; const float ql = bflo(qw), qh = bfhi(qw);
#pragma unroll
                    for (int i = 0; i < 8; ++i) acc[i] += ql * Cs[(2 * d2) * 64 + eg * 8 + i] + qh * Cs[(2 * d2 + 1) * 64 + eg * 8 + i]; }
                const float iw = sc[128 + t];
#pragma unroll
                for (int i = 0; i < 8; ++i) acc[i] *= iw;
                for (int s = 0; s <= t; ++s) { const float pv = Ps[t * 64 + s];
#pragma unroll
                    for (int i = 0; i < 8; ++i) acc[i] += pv * bf2f(vs[s * 64 + eg * 8 + i]); }
                const float dn = 1.0f / fmaxf(fabsf(sc[320 + t]), sc[192 + t]);
                u32x4 o; o.x = pk2(acc[0] * dn, acc[1] * dn); o.y = pk2(acc[2] * dn, acc[3] * dn); o.z = pk2(acc[4] * dn, acc[5] * dn); o.w = pk2(acc[6] * dn, acc[7] * dn);
                *(u32x4*)(V + (t0 + t) * DM + h * 256 + j * 64 + eg * 8) = o;
            }
            __syncthreads();
            { const int d = tid >> 1, eh = tid & 1; const float decay = sc[384]; float acc[32];
#pragma unroll
                for (int i = 0; i < 32; ++i) acc[i] = decay * Cs[d * 64 + eh * 32 + i];
                float nacc = decay * ns[d];
                for (int s = 0; s < 64; ++s) { const unsigned kw = ks[s * 128 + (d >> 1)]; const float kv = ((d & 1) ? bfhi(kw) : bflo(kw)) * 0.0625f * sc[256 + s];
                    nacc += kv;
#pragma unroll
                    for (int i = 0; i < 32; ++i) acc[i] += kv * bf2f(vs[s * 64 + eh * 32 + i]); }
#pragma unroll
                for (int i = 0; i < 32; ++i) Cs[d * 64 + eh * 32 + i] = acc[i];
                if (eh == 0) ns[d] = nacc; }
            __syncthreads();
        }
    }
}

__device__ void p3_gmlp_naive(const Params& P, LAS unsigned char* lds) {
    const int tid = threadIdx.x;
    bf16_t* PROJ = (bf16_t*)(P.ws + WS_PROJ);
    LAS bf16_t* vv = (LAS bf16_t*)lds;
    const float* WSP = P.in[I_W_SP]; const float* BSP = P.in[I_B_SP];
    for (int item = blockIdx.x; item < 2048; item += gridDim.x) {
        const int g = item & 7, c = (item >> 3) & 15, b = item >> 7; const size_t t0 = (size_t)b * SEQ + c * 128;
#pragma unroll
        for (int i = 0; i < 4; ++i) { const int p = tid + i * NTHR, r = p >> 4, cc = p & 15; *(LAS u32x4*)(vv + r * 128 + cc * 8) = *(const u32x4*)(PROJ + (t0 + r) * PROJW + 3 * DM + g * 128 + cc * 8); }
        __syncthreads();
        const int t = tid >> 2, dg = tid & 3; float acc[32];
#pragma unroll
        for (int i = 0; i < 32; ++i) acc[i] = 0.f;
        const float* wrow = WSP + ((size_t)g * 128 + t) * 128;
        for (int s = 0; s <= t; ++s) { const float w = wrow[s];
#pragma unroll
            for (int i = 0; i < 32; ++i) acc[i] += w * bf2f(vv[s * 128 + dg * 32 + i]); }
        const float bs = BSP[g * 128 + t];
        bf16_t* gu = PROJ + (t0 + t) * PROJW + 2 * DM + g * 128 + dg * 32;
#pragma unroll
        for (int i = 0; i < 4; ++i) { const u32x4 w = *(const u32x4*)(gu + i * 8); u32x4 o;
            o.x = pk2(bflo(w.x) * (acc[i * 8 + 0] + bs), bfhi(w.x) * (acc[i * 8 + 1] + bs)); o.y = pk2(bflo(w.y) * (acc[i * 8 + 2] + bs), bfhi(w.y) * (acc[i * 8 + 3] + bs));
            o.z = pk2(bflo(w.z) * (acc[i * 8 + 4] + bs), bfhi(w.z) * (acc[i * 8 + 5] + bs)); o.w = pk2(bflo(w.w) * (acc[i * 8 + 6] + bs), bfhi(w.w) * (acc[i * 8 + 7] + bs));
            *(u32x4*)(gu + i * 8) = o; }
        __syncthreads();
    }
}

namespace mlm {
constexpr int QP = 264, VP = 88, PP = 72;
constexpr int QS_OFF = 0, KS_OFF = QS_OFF + 64 * QP * 2, VS_OFF = KS_OFF + 64 * QP * 2, CT_OFF = VS_OFF + 64 * VP * 2, PS_OFF = CT_OFF + 80 * QP * 2, SC_OFF = PS_OFF + 64 * PP * 2, BYTES = SC_OFF + 2048;
typedef short s16x4 __attribute__((ext_vector_type(4)));
typedef float f32x2_t __attribute__((ext_vector_type(2)));
typedef __bf16 bf16x2_t __attribute__((ext_vector_type(2)));
__device__ __forceinline__ unsigned cvtpk(float lo, float hi) { f32x2_t v = {lo, hi}; bf16x2_t b = __builtin_convertvector(v, bf16x2_t); return __builtin_bit_cast(unsigned, b); }
__device__ __forceinline__ s16x4 tr16(LAS unsigned char* p) { return __builtin_bit_cast(s16x4, __builtin_amdgcn_ds_read_tr16_b64_v4i16((LAS s16x4*)p)); }
__device__ __forceinline__ bf16x8 frag_tr(LAS unsigned char* p, int pitch_bytes) {
    const s16x4 lo = tr16(p), hi = tr16(p + 4 * pitch_bytes);
    return (bf16x8){lo.x, lo.y, lo.z, lo.w, hi.x, hi.y, hi.z, hi.w};
}
}
__device__ void p3_mlstm_mfma(const Params& P, LAS unsigned char* lds) {
    using namespace mlm;
    const int tid = threadIdx.x, lane = tid & 63, wave = __builtin_amdgcn_readfirstlane(tid >> 6), fr = lane & 15, fq = lane >> 4, q_ = fr >> 2, p_ = fr & 3;
    const int tau = wave >> 1, par = wave & 1;
    unsigned char* ws = P.ws;
    const bf16_t* Q = (const bf16_t*)P.out; const bf16_t* K = Q + (size_t)NTOK * DM; bf16_t* V = (bf16_t*)(ws + WS_XN);
    const float* GATES = (const float*)(ws + WS_GATES);
    LAS float* sc = (LAS float*)(lds + SC_OFF);
    for (int item = blockIdx.x; item < 256; item += gridDim.x) {
        const int b = item >> 4, h = (item >> 2) & 3, j = item & 3;
        for (int i = tid; i < 80 * QP * 2 / 16; i += NTHR) ((LAS u32x4*)(lds + CT_OFF))[i] = (u32x4){0u, 0u, 0u, 0u};
        if (tid < 64) { LAS bf16_t* r = (LAS bf16_t*)(lds + VS_OFF) + tid * VP + 64; r[0] = 0x3F80;
#pragma unroll
            for (int i = 1; i < 24; ++i) r[i] = 0; }
        f32x4 cacc[2][5];
#pragma unroll
        for (int a = 0; a < 2; ++a)
#pragma unroll
            for (int e = 0; e < 5; ++e) cacc[a][e] = (f32x4){0.f, 0.f, 0.f, 0.f};
        float m = 0.f;
        u32x4 pq[4], pk[4], pv; float pig = 0.f, plf = 0.f;
        const bf16_t* qb = Q + (size_t)b * SEQ * DM + h * 256; const bf16_t* kb = K + (size_t)b * SEQ * DM + h * 256; bf16_t* vb = V + (size_t)b * SEQ * DM + h * 256 + j * 64;
#define ML_LOAD(c_) do { const size_t r0_ = (size_t)(c_) * 64; \
            _Pragma("unroll") for (int i = 0; i < 4; ++i) { const int p = tid + i * NTHR, r = p >> 5, cc = p & 31; pq[i] = *(const u32x4*)(qb + (r0_ + r) * DM + cc * 8); pk[i] = *(const u32x4*)(kb + (r0_ + r) * DM + cc * 8); } \
            pv = *(const u32x4*)(vb + (r0_ + (tid >> 3)) * DM + (tid & 7) * 8); \
            if (wave == 0) { pig = GATES[((size_t)b * SEQ + r0_ + lane) * 8 + h]; plf = GATES[((size_t)b * SEQ + r0_ + lane) * 8 + 4 + h]; } } while (0)
        ML_LOAD(0);
        __syncthreads();
        for (int c = 0; c < 32; ++c) {
#pragma unroll
            for (int i = 0; i < 4; ++i) { const int p = tid + i * NTHR, r = p >> 5, cc = p & 31; *(LAS u32x4*)(lds + QS_OFF + r * QP * 2 + cc * 16) = pq[i]; *(LAS u32x4*)(lds + KS_OFF + r * QP * 2 + cc * 16) = pk[i]; }
            *(LAS u32x4*)(lds + VS_OFF + (tid >> 3) * VP * 2 + (tid & 7) * 16) = pv;
            if (wave == 0) {
                float bs = plf;
#pragma unroll
                for (int o = 1; o < 64; o <<= 1) { const float t = __shfl_up(bs, o); if (lane >= o) bs += t; }
                const float u = pig - bs; float gm = u;
#pragma unroll
                for (int o = 1; o < 64; o <<= 1) { const float t = __shfl_up(gm, o); if (lane >= o) gm = fmaxf(gm, t); }
                const float g = fmaxf(gm, m), gL = __shfl(g, 63), bL = __shfl(bs, 63);
                sc[lane] = u; sc[64 + lane] = g; sc[128 + lane] = expf(m - g); sc[192 + lane] = expf(-bs - g); sc[256 + lane] = expf(u - gL) * 0.0625f;
                if (lane == 0) sc[320] = expf(m - gL);
                m = bL + gL;
            }
            __syncthreads();
            if (c + 1 < 32) ML_LOAD(c + 1);
            bf16x8 qf[8];
#pragma unroll
            for (int kap = 0; kap < 8; ++kap) qf[kap] = *(const LAS bf16x8*)(lds + QS_OFF + ((16 * tau + fr) * QP + 32 * kap + 8 * fq) * 2);
            const float gt = sc[64 + 16 * tau + fr];
#pragma unroll
            for (int si = 0; si < 2; ++si) {
                const int sig = 2 * par + si; f32x4 acc = (f32x4){0.f, 0.f, 0.f, 0.f};
                if (sig <= tau) {
#pragma unroll
                    for (int kap = 0; kap < 8; ++kap) acc = __builtin_amdgcn_mfma_f32_16x16x32_bf16(*(const LAS bf16x8*)(lds + KS_OFF + ((16 * sig + fr) * QP + 32 * kap + 8 * fq) * 2), qf[kap], acc, 0, 0, 0);
                }
                const f32x4 us = *(const LAS f32x4*)(sc + 16 * sig + 4 * fq);
                const int t = 16 * tau + fr, s0 = 16 * sig + 4 * fq;
                const float w0 = (s0 + 0 <= t) ? acc.x * 0.0625f * __expf(us.x - gt) : 0.f, w1 = (s0 + 1 <= t) ? acc.y * 0.0625f * __expf(us.y - gt) : 0.f;
                const float w2 = (s0 + 2 <= t) ? acc.z * 0.0625f * __expf(us.z - gt) : 0.f, w3 = (s0 + 3 <= t) ? acc.w * 0.0625f * __expf(us.w - gt) : 0.f;
                u32x2 o; o.x = cvtpk(w0, w1); o.y = cvtpk(w2, w3);
                *(LAS u32x2*)(lds + PS_OFF + (t * PP + s0) * 2) = o;
            }
            f32x4 nacc[3];
#pragma unroll
            for (int ei = 0; ei < 3; ++ei) {
                const int eps = (ei == 2) ? 4 : 2 * par + ei; f32x4 acc = (f32x4){0.f, 0.f, 0.f, 0.f};
#pragma unroll
                for (int kap = 0; kap < 8; ++kap) acc = __builtin_amdgcn_mfma_f32_16x16x32_bf16(*(const LAS bf16x8*)(lds + CT_OFF + ((16 * eps + fr) * QP + 32 * kap + 8 * fq) * 2), qf[kap], acc, 0, 0, 0);
                nacc[ei] = acc * sc[128 + 16 * tau + fr];
            }
            __syncthreads();
            {
                bf16x8 pf[2];
#pragma unroll
                for (int kp = 0; kp < 2; ++kp) pf[kp] = *(const LAS bf16x8*)(lds + PS_OFF + ((16 * tau + fr) * PP + 32 * kp + 8 * fq) * 2);
#pragma unroll
                for (int ei = 0; ei < 3; ++ei) {
                    const int eps = (ei == 2) ? 4 : 2 * par + ei;
#pragma unroll
                    for (int kp = 0; kp < 2; ++kp) nacc[ei] = __builtin_amdgcn_mfma_f32_16x16x32_bf16(frag_tr(lds + VS_OFF + ((32 * kp + 8 * fq + q_) * VP + 16 * eps + 4 * p_) * 2, VP * 2), pf[kp], nacc[ei], 0, 0, 0);
                }
                const float den = __shfl(nacc[2].x, fr);
                const float rinv = 1.0f / fmaxf(fabsf(den), sc[192 + 16 * tau + fr]);
                bf16_t* hrow = vb + ((size_t)c * 64 + 16 * tau + fr) * DM;
#pragma unroll
                for (int ei = 0; ei < 2; ++ei) { const int eps = 2 * par + ei; u32x2 o; o.x = cvtpk(nacc[ei].x * rinv, nacc[ei].y * rinv); o.y = cvtpk(nacc[ei].z * rinv, nacc[ei].w * rinv);
                    *(u32x2*)(hrow + 16 * eps + 4 * fq) = o; }
            }
            {
                const float decay = sc[320];
                bf16x8 kw[2][2];
#pragma unroll
                for (int dl = 0; dl < 2; ++dl)
#pragma unroll
                    for (int kp = 0; kp < 2; ++kp) {
                        const bf16x8 f = frag_tr(lds + KS_OFF + ((32 * kp + 8 * fq + q_) * QP + 16 * (2 * wave + dl) + 4 * p_) * 2, QP * 2);
                        const u32x4 fw = __builtin_bit_cast(u32x4, f);
                        const f32x4 wa = *(const LAS f32x4*)(sc + 256 + 32 * kp + 8 * fq), wb = *(const LAS f32x4*)(sc + 256 + 32 * kp + 8 * fq + 4);
                        u32x4 o; o.x = cvtpk(bflo(fw.x) * wa.x, bfhi(fw.x) * wa.y); o.y = cvtpk(bflo(fw.y) * wa.z, bfhi(fw.y) * wa.w); o.z = cvtpk(bflo(fw.z) * wb.x, bfhi(fw.z) * wb.y); o.w = cvtpk(bflo(fw.w) * wb.z, bfhi(fw.w) * wb.w);
                        kw[dl][kp] = __builtin_bit_cast(bf16x8, o);
                    }
#pragma unroll
                for (int eps = 0; eps < 5; ++eps) {
                    bf16x8 vf[2];
#pragma unroll
                    for (int kp = 0; kp < 2; ++kp) vf[kp] = frag_tr(lds + VS_OFF + ((32 * kp + 8 * fq + q_) * VP + 16 * eps + 4 * p_) * 2, VP * 2);
#pragma unroll
                    for (int dl = 0; dl < 2; ++dl) {
                        f32x4 a = cacc[dl][eps] * decay;
                        a = __builtin_amdgcn_mfma_f32_16x16x32_bf16(kw[dl][0], vf[0], a, 0, 0, 0);
                        a = __builtin_amdgcn_mfma_f32_16x16x32_bf16(kw[dl][1], vf[1], a, 0, 0, 0);
                        cacc[dl][eps] = a;
                        u32x2 o; o.x = cvtpk(a.x, a.y); o.y = cvtpk(a.z, a.w);
                        *(LAS u32x2*)(lds + CT_OFF + ((16 * eps + fr) * QP + 16 * (2 * wave + dl) + 4 * fq) * 2) = o;
                    }
                }
            }
            __syncthreads();
        }
#undef ML_LOAD
    }
}

namespace gmm { constexpr int VVP = 136, VV_OFF = 0, WS_OFF = 128 * VVP * 2, BYTES = 2 * 128 * VVP * 2; }
__device__ void p3_gmlp_mfma(const Params& P, LAS unsigned char* lds) {
    using namespace gmm;
    const int tid = threadIdx.x, lane = tid & 63, wave = __builtin_amdgcn_readfirstlane(tid >> 6), fr = lane & 15, fq = lane >> 4, q_ = fr >> 2, p_ = fr & 3;
    bf16_t* PROJ = (bf16_t*)(P.ws + WS_PROJ); const bf16_t* WSPb = (const bf16_t*)(P.ws + WS_WSP); const float* BSP = P.in[I_B_SP];
    int g_staged = -1;
    u32x4 pre[4];
#define GM_LOAD(it_) do { const int g_ = (it_) & 7, c_ = ((it_) >> 3) & 15, b_ = (it_) >> 7; const size_t t0_ = (size_t)b_ * SEQ + c_ * 128; \
        _Pragma("unroll") for (int i = 0; i < 4; ++i) { const int p = tid + i * NTHR, r = p >> 4, cc = p & 15; pre[i] = *(const u32x4*)(PROJ + (t0_ + r) * PROJW + 3 * DM + g_ * 128 + cc * 8); } } while (0)
    if ((int)blockIdx.x < 2048) GM_LOAD(blockIdx.x);
    for (int item = blockIdx.x; item < 2048; item += gridDim.x) {
        const int g = item & 7, c = (item >> 3) & 15, b = item >> 7; const size_t t0 = (size_t)b * SEQ + c * 128;
#pragma unroll
        for (int i = 0; i < 4; ++i) { const int p = tid + i * NTHR, r = p >> 4, cc = p & 15; *(LAS u32x4*)(lds + VV_OFF + (r * VVP + cc * 8) * 2) = pre[i]; }
        if (g != g_staged) {
#pragma unroll
            for (int i = 0; i < 4; ++i) { const int p = tid + i * NTHR, r = p >> 4, cc = p & 15; *(LAS u32x4*)(lds + WS_OFF + (r * VVP + cc * 8) * 2) = *(const u32x4*)(WSPb + ((size_t)g * 128 + r) * 128 + cc * 8); }
            g_staged = g;
        }
        __syncthreads();
        if (item + (int)gridDim.x < 2048) GM_LOAD(item + gridDim.x);
        bf16x8 af[4];
#pragma unroll
        for (int kap = 0; kap < 4; ++kap) af[kap] = mlm::frag_tr(lds + VV_OFF + ((32 * kap + 8 * fq + q_) * VVP + 16 * wave + 4 * p_) * 2, VVP * 2);
#pragma unroll
        for (int th = 0; th < 8; ++th) {
            f32x4 acc = (f32x4){0.f, 0.f, 0.f, 0.f};
#pragma unroll
            for (int kap = 0; kap <= (th >> 1); ++kap) acc = __builtin_amdgcn_mfma_f32_16x16x32_bf16(af[kap], *(const LAS bf16x8*)(lds + WS_OFF + ((16 * th + fr) * VVP + 32 * kap + 8 * fq) * 2), acc, 0, 0, 0);
            const int t = 16 * th + fr; const float bs = BSP[g * 128 + t];
            bf16_t* gu = PROJ + (t0 + t) * PROJW + 2 * DM + g * 128 + 16 * wave + 4 * fq;
            const u32x2 w = *(const u32x2*)gu; u32x2 o;
            o.x = mlm::cvtpk(bflo(w.x) * (acc.x + bs), bfhi(w.x) * (acc.y + bs)); o.y = mlm::cvtpk(bflo(w.y) * (acc.z + bs), bfhi(w.y) * (acc.w + bs));
            *(u32x2*)gu = o;
        }
        __syncthreads();
    }
#undef GM_LOAD
}

__device__ void p4_ym(const Params& P, LAS unsigned char*) {
    const int tid = threadIdx.x, lane = tid & 63, wave = tid >> 6, h = wave & 3, half = wave >> 2;
    bf16_t* PROJ = (bf16_t*)(P.ws + WS_PROJ); const bf16_t* HM = (const bf16_t*)(P.ws + WS_XN);
    const int ch = h * 256 + lane * 4;
    float cw[4][4], cb[4], ng[4], sk[4];
#pragma unroll
    for (int j = 0; j < 4; ++j)
#pragma unroll
        for (int d = 0; d < 4; ++d) cw[j][d] = P.in[I_CONV_W][j * DM + ch + d];
#pragma unroll
    for (int d = 0; d < 4; ++d) { cb[d] = P.in[I_CONV_B][ch + d]; ng[d] = P.in[I_M_NORM_G][ch + d]; sk[d] = P.in[I_M_SKIP][ch + d]; }
    for (int item = blockIdx.x; item < NTOK / 16; item += gridDim.x) {
        const int tb = item * 16 + half * 8;
        float x0[4], x1[4], x2[4], x3[4];
        if ((tb & (SEQ - 1)) == 0) {
#pragma unroll
            for (int d = 0; d < 4; ++d) { x0[d] = 0.f; x1[d] = 0.f; x2[d] = 0.f; }
        } else { ld4(PROJ + (size_t)(tb - 3) * PROJW + ch, x0); ld4(PROJ + (size_t)(tb - 2) * PROJW + ch, x1); ld4(PROJ + (size_t)(tb - 1) * PROJW + ch, x2); }
#pragma unroll 1
        for (int i = 0; i < 8; ++i) {
            const int t = tb + i;
            ld4(PROJ + (size_t)t * PROJW + ch, x3);
            float hm[4], sz[4], y[4];
            ld4(HM + (size_t)t * DM + ch, hm); ld4(PROJ + (size_t)t * PROJW + DM + ch, sz);
            const float mu = wave_sum(hm[0] + hm[1] + hm[2] + hm[3]) * (1.f / 256.f);
            float s2 = 0.f;
#pragma unroll
            for (int d = 0; d < 4; ++d) { hm[d] -= mu; s2 += hm[d] * hm[d]; }
            const float r = 1.0f / sqrtf(wave_sum(s2) * (1.f / 256.f) + EPS);
#pragma unroll
            for (int d = 0; d < 4; ++d) { const float mc = siluf_(cw[0][d] * x0[d] + cw[1][d] * x1[d] + cw[2][d] * x2[d] + cw[3][d] * x3[d] + cb[d]);
                y[d] = (hm[d] * r * ng[d] + sk[d] * mc) * sz[d]; }
            st4(PROJ + (size_t)t * PROJW + DM + ch, y);
#pragma unroll
            for (int d = 0; d < 4; ++d) { x0[d] = x1[d]; x1[d] = x2[d]; x2[d] = x3[d]; }
        }
    }
}

__device__ void norm_pass(const float* xi, const float* y, const float* g1, float* xo, const float* g2, bf16_t* hn, int ldh, int hoff, const float* pin) {
    const int tid = threadIdx.x, lane = tid & 63, wave = tid >> 6;
    const int gw = blockIdx.x * NWAVES + wave, NGW = gridDim.x * NWAVES;
    for (int m = gw; m < NTOK; m += NGW) {
        const f32x4* yr = (const f32x4*)(y + (size_t)m * DM) + lane; const f32x4* xr = (const f32x4*)(xi + (size_t)m * DM) + lane; f32x4* orow = (f32x4*)(xo + (size_t)m * DM) + lane;
        f32x4 v[4]; float s = 0.f;
#pragma unroll
        for (int j = 0; j < 4; ++j) { v[j] = yr[64 * j]; s += (v[j].x * v[j].x + v[j].y * v[j].y) + (v[j].z * v[j].z + v[j].w * v[j].w); }
        const float r = 1.0f / sqrtf(wave_sum(s) * (1.f / DM) + EPS); float s2 = 0.f;
#pragma unroll
        for (int j = 0; j < 4; ++j) { const f32x4 gv = ((const f32x4*)g1 + lane)[64 * j]; v[j] = xr[64 * j] + v[j] * r * gv; orow[64 * j] = v[j];
            s2 += (v[j].x * v[j].x + v[j].y * v[j].y) + (v[j].z * v[j].z + v[j].w * v[j].w); }
        if (hn) {
            const float r2 = 1.0f / sqrtf(wave_sum(s2) * (1.f / DM) + EPS);
            u32x2* o8 = (u32x2*)(hn + (size_t)m * ldh + hoff) + lane;
#pragma unroll
            for (int j = 0; j < 4; ++j) { const f32x4 gv = ((const f32x4*)g2 + lane)[64 * j]; u32x2 o; o.x = pk2(v[j].x * r2 * gv.x, v[j].y * r2 * gv.y); o.y = pk2(v[j].z * r2 * gv.z, v[j].w * r2 * gv.w); o8[64 * j] = o; }
            if (pin) { const f32x4 pv = ((const f32x4*)(pin + (size_t)m * PLE))[lane]; u32x2 o; o.x = pk2(pv.x, pv.y); o.y = pk2(pv.z, pv.w); ((u32x2*)(hn + (size_t)m * ldh))[lane] = o; }
        }
    }
}

#ifndef MEGA
#define MEGA 1
#endif
namespace cg = cooperative_groups;
constexpr int NPHASE = 13;
constexpr int LDS_BYTES = 160 * 1024 - 1024;
static_assert(ML_BYTES <= LDS_BYTES && pg8::STAGE_BYTES <= LDS_BYTES && mlm::BYTES <= LDS_BYTES, "lds");

template <int LO, int HI> __global__ void __launch_bounds__(NTHR, 2) fwd_kernel(Params P) {
    extern __shared__ __attribute__((aligned(16))) unsigned char lds_raw[];
    LAS unsigned char* lds = (LAS unsigned char*)lds_raw;
    unsigned char* ws = P.ws;
    bf16_t* PROJ = (bf16_t*)(ws + WS_PROJ); bf16_t* XN = (bf16_t*)(ws + WS_XN); bf16_t* HB = (bf16_t*)(ws + WS_HB); float* Y = (float*)(ws + WS_Y);
    const int G = gridDim.x, bid = blockIdx.x;
#define IN(k) (LO <= (k) && (k) < HI)
#define SEAM(k) do { if (IN(k) && IN((k) + 1)) cg::this_grid().sync(); } while (0)
    if (IN(0)) p0_prologue(P, lds);
    SEAM(0);
    if (IN(1)) { pg8::Gemm g{XN, (const bf16_t*)(ws + WS_WIN), DM, DM, NTOK, PROJW, DM}; pg8::StaticOrder S; S.init(NTOK, PROJW, G, bid);
        pg8::Epi8<ProjF> E{ProjF{PROJ}}; pg8::gemm_phase<pg8::Epi8<ProjF>, -1, true>(lds, g, S, E); }
    SEAM(1);
    if (IN(2)) p2_qkv(P, lds);
    SEAM(2);
    if (IN(3)) { p3_mlstm_mfma(P, lds); __syncthreads(); p3_gmlp_mfma(P, lds); }
    SEAM(3);
    if (IN(4)) p4_ym(P, lds);
    SEAM(4);
    if (IN(5)) { pg8::Gemm g{PROJ + DM, (const bf16_t*)(ws + WS_WBR), PROJW, 2 * DM, NTOK, DM, 2 * DM}; pg8::StaticOrder S; S.init(NTOK, DM, G, bid);
        pg8::Epi8<MergeF> E{MergeF{PROJ, XN}}; pg8::gemm_phase<pg8::Epi8<MergeF>, 16, true>(lds, g, S, E); }
    SEAM(5);
    if (IN(6)) { pg8::Gemm g{XN, (const bf16_t*)(ws + WS_WOUT), DM, DM, NTOK, DM, DM}; pg8::StaticOrder S; S.init(NTOK, DM, G, bid);
        pg8::Epi4<F32F> E{F32F{Y, DM}}; pg8::gemm_phase<pg8::Epi4<F32F>, -1, true>(lds, g, S, E); }
    SEAM(6);
    if (IN(7)) norm_pass(P.in[I_X], Y, P.in[I_MIX_POST_G], P.out, P.in[I_MLP_PRE_G], XN, DM, 0, nullptr);
    SEAM(7);
    if (IN(8)) { pg8::Gemm g{XN, (const bf16_t*)(ws + WS_WUP), DM, DM, NTOK, DFF, DM}; pg8::StaticOrder S; S.init(NTOK, DFF, G, bid);
        pg8::Epi8<Relu2F> E{Relu2F{HB, DFF}}; pg8::gemm_phase<pg8::Epi8<Relu2F>, -1, true>(lds, g, S, E); }
    SEAM(8);
    if (IN(9)) { pg8::Gemm g{HB, (const bf16_t*)(ws + WS_WDN), DFF, DFF, NTOK, DM, DFF}; pg8::StaticOrder S; S.init(NTOK, DM, G, bid);
        pg8::Epi4<F32F> E{F32F{Y, DM}}; pg8::gemm_phase<pg8::Epi4<F32F>, -1, true>(lds, g, S, E); }
    SEAM(9);
    if (IN(10)) norm_pass(P.out, Y, P.in[I_MLP_POST_G], P.out, P.in[I_PLE_PRE_G], HB, PLEK, PLE, P.in[I_P]);
    SEAM(10);
    if (IN(11)) { pg8::Gemm g{HB, (const bf16_t*)(ws + WS_WPLE), PLEK, PLEK, NTOK, DM, PLEK}; pg8::StaticOrder S; S.init(NTOK, DM, G, bid);
        pg8::Epi4<PleF> E{PleF{Y, (f32x4*)(ws + WS_XN)}}; pg8::gemm_phase<pg8::Epi4<PleF>, 4, true>(lds, g, S, E); }
    SEAM(11);
    if (IN(12)) norm_pass(P.out, Y, P.in[I_PLE_POST_G], P.out, nullptr, nullptr, 0, 0, nullptr);
#undef IN
#undef SEAM
}

template <int LO, int HI> static void launch_range(const Params& P, int grid, hipStream_t stream, bool coop) {
    static bool attr = false;
    if (!attr) { (void)hipFuncSetAttribute((const void*)fwd_kernel<LO, HI>, hipFuncAttributeMaxDynamicSharedMemorySize, LDS_BYTES); attr = true; }
    if (coop) {
        Params p = P; void* args[] = {&p};
        const hipError_t e = hipLaunchCooperativeKernel((const void*)fwd_kernel<LO, HI>, dim3(grid), dim3(NTHR), args, LDS_BYTES, stream);
        if (e != hipSuccess) fprintf(stderr, "cooperative launch failed: %s (grid %d)\n", hipGetErrorString(e), grid);
    } else hipLaunchKernelGGL((fwd_kernel<LO, HI>), dim3(grid), dim3(NTHR), LDS_BYTES, stream, P);
}
template <int I> static void launch_each(const Params& P, int grid, hipStream_t stream) {
    if constexpr (I < NPHASE) { launch_range<I, I + 1>(P, grid, stream, false); launch_each<I + 1>(P, grid, stream); }
}

extern "C" void kernel_launch(void* const* d_in, const int* in_sizes, int n_in, void* d_out, int out_size, void* d_ws, size_t ws_size, hipStream_t stream) {
    if (n_in != 29 || out_size != NTOK * DM || ws_size < WS_END) { fprintf(stderr, "kernel_launch: unexpected shapes (n_in %d out %d ws %zu)\n", n_in, out_size, ws_size); return; }
    Params P{};
    for (int i = 0; i < 29; ++i) P.in[i] = (const float*)d_in[i];
    P.out = (float*)d_out; P.ws = (unsigned char*)d_ws;
#if MEGA
    static int grid = 0;
    if (!grid) {
        int dev = 0, cus = 0, per_cu = 0;
        (void)hipGetDevice(&dev); (void)hipDeviceGetAttribute(&cus, hipDeviceAttributeMultiprocessorCount, dev);
        (void)hipFuncSetAttribute((const void*)fwd_kernel<0, NPHASE>, hipFuncAttributeMaxDynamicSharedMemorySize, LDS_BYTES);
        (void)hipOccupancyMaxActiveBlocksPerMultiprocessor(&per_cu, (const void*)fwd_kernel<0, NPHASE>, NTHR, LDS_BYTES);
        if (per_cu < 1) per_cu = 1;
        grid = cus;
        if (grid > cus * per_cu) grid = cus * per_cu;
    }
    launch_range<0, NPHASE>(P, grid, stream, true);
#else
    launch_each<0>(P, 256, stream);
#endif
}
```

```cpp
#include <hip/hip_runtime.h>
#include <hip/hip_cooperative_groups.h>
#include <cstdio>
#include <cstdint>
#include <cmath>

#define LAS __attribute__((address_space(3)))
typedef unsigned short bf16_t;
typedef short bf16x8 __attribute__((ext_vector_type(8)));
typedef float f32x4 __attribute__((ext_vector_type(4)));
typedef unsigned u32x4 __attribute__((ext_vector_type(4)));
typedef unsigned u32x2 __attribute__((ext_vector_type(2)));

constexpr int NTOK = 32768, DM = 1024, SEQ = 2048, PROJW = 6144, DFF = 4096, PLE = 256, PLEK = PLE + DM;
constexpr float EPS = 1e-6f;
constexpr int NWAVES = 8, NTHR = 512;
constexpr size_t MiB = 1u << 20;
constexpr size_t WS_CTL = 0;
constexpr size_t WS_WIN = 1 * MiB;
constexpr size_t WS_WBR = 13 * MiB;
constexpr size_t WS_WOUT = 17 * MiB;
constexpr size_t WS_WUP = 19 * MiB;
constexpr size_t WS_WDN = 27 * MiB;
constexpr size_t WS_WPLE = 35 * MiB;
constexpr size_t WS_WCX = 38 * MiB;
constexpr size_t WS_WSP = 38 * MiB + 256 * 1024;
constexpr size_t WS_GATES = 39 * MiB;
constexpr size_t WS_XN = 40 * MiB;
constexpr size_t WS_PROJ = 104 * MiB;
constexpr size_t WS_HB = WS_PROJ;
constexpr size_t WS_Y = WS_PROJ + 256 * MiB;
constexpr size_t WS_END = 488 * MiB;

struct Params {
    const float* in[29];
    float* out;
    unsigned char* ws;
};
enum { I_X = 0, I_P, I_MIX_PRE_G, I_W_IN, I_CONV_W, I_CONV_B, I_WQ, I_WK, I_WV, I_W_IF, I_B_IF, I_M_NORM_G, I_M_SKIP, I_G_LN_W, I_G_LN_B, I_W_SP, I_B_SP,
       I_W_BR_M, I_W_BR_G, I_W_OUT, I_MIX_POST_G, I_MLP_PRE_G, I_W_UP, I_W_DOWN, I_MLP_POST_G, I_PLE_PRE_G, I_W_PLE_GATE, I_W_PLE_PROJ, I_PLE_POST_G };

__device__ __forceinline__ unsigned f2bf(float f) { unsigned u = __builtin_bit_cast(unsigned, f); return (u + 0x7fffu + ((u >> 16) & 1u)) >> 16; }
__device__ __forceinline__ unsigned pk2(float lo, float hi) { return f2bf(lo) | (f2bf(hi) << 16); }
__device__ __forceinline__ float bflo(unsigned w) { return __builtin_bit_cast(float, w << 16); }
__device__ __forceinline__ float bfhi(unsigned w) { return __builtin_bit_cast(float, w & 0xffff0000u); }
__device__ __forceinline__ float bf2f(bf16_t h) { return __builtin_bit_cast(float, (unsigned)h << 16); }
__device__ __forceinline__ float sigmoidf_(float x) { return 1.0f / (1.0f + __expf(-x)); }
__device__ __forceinline__ float siluf_(float x) { return x * sigmoidf_(x); }
__device__ __forceinline__ float gelu_tanh(float x) { const float z = 0.7978845608028654f * (x + 0.044715f * x * x * x); return x * sigmoidf_(2.0f * z); }
__device__ __forceinline__ float log_sigmoid(float x) { return fminf(x, 0.f) - log1pf(expf(-fabsf(x))); }
__device__ __forceinline__ float wave_sum(float v) {
#pragma unroll
    for (int o = 1; o < 64; o <<= 1) v += __shfl_xor(v, o);
    return v;
}
#define LDS_WAIT() asm volatile("s_waitcnt lgkmcnt(0)" ::: "memory")

template <bool GATE_REMAP = false>
__device__ __forceinline__ void transpose_item(const float* W, int K, int N, bf16_t* WT, int ldw, int koff, LAS float* scr, int item, int lane) {
    const int nblk = N / 32, kb = item / nblk, nb = item % nblk, k0 = 64 * kb, n0 = 32 * nb;
    int r0 = n0; if (GATE_REMAP && n0 >= 4 * DM) { const int g = n0 - 4 * DM, j = g & (DM - 1); r0 = 4 * DM + (j >> 7) * 256 + (g >= DM ? 128 : 0) + (j & 127); }
#pragma unroll 8
    for (int i = 0; i < 32; ++i) { const int kk = 2 * i + (lane >> 5); scr[kk * 33 + (lane & 31)] = W[(size_t)(k0 + kk) * N + n0 + (lane & 31)]; }
    LDS_WAIT();
    const int c = lane & 7;
#pragma unroll
    for (int j = 0; j < 4; ++j) { const int n = (lane >> 3) + 8 * j; const LAS float* s = scr + (8 * c) * 33 + n;
        u32x4 o; o.x = pk2(s[0 * 33], s[1 * 33]); o.y = pk2(s[2 * 33], s[3 * 33]); o.z = pk2(s[4 * 33], s[5 * 33]); o.w = pk2(s[6 * 33], s[7 * 33]);
        *(u32x4*)(WT + (size_t)(r0 + n) * ldw + koff + k0 + 8 * c) = o; }
    LDS_WAIT();
}
__device__ __forceinline__ void rms_row_to_bf16(const float* xrow, const float* g, bf16_t* orow, int lane) {
    const f32x4* xr = (const f32x4*)xrow + lane; const f32x4* gr = (const f32x4*)g + lane;
    f32x4 v[4]; float s = 0.f;
#pragma unroll
    for (int j = 0; j < 4; ++j) { v[j] = xr[64 * j]; s += (v[j].x * v[j].x + v[j].y * v[j].y) + (v[j].z * v[j].z + v[j].w * v[j].w); }
    const float r = 1.0f / sqrtf(wave_sum(s) * (1.f / DM) + EPS);
    u32x2* o8 = (u32x2*)orow + lane;
#pragma unroll
    for (int j = 0; j < 4; ++j) { const f32x4 gv = gr[64 * j]; u32x2 o; o.x = pk2(v[j].x * r * gv.x, v[j].y * r * gv.y); o.y = pk2(v[j].z * r * gv.z, v[j].w * r * gv.w); o8[64 * j] = o; }
}
__device__ void p0_prologue(const Params& P, LAS unsigned char* lds) {
    const int tid = threadIdx.x, lane = tid & 63, wave = tid >> 6;
    LAS float* scr = (LAS float*)(lds + wave * 16384);
    const int gw = blockIdx.x * NWAVES + wave, NGW = gridDim.x * NWAVES;
    unsigned char* ws = P.ws;
    constexpr int I_IN = 16 * 192, I_SQ = 16 * 32, I_UP = 16 * 128, I_DN = 64 * 32, I_PP = 4 * 32;
    constexpr int NIT = I_IN + 4 * I_SQ + I_UP + I_DN + I_PP;
    for (int it = gw; it < NIT; it += NGW) {
        int r = it;
        if (r < I_IN) { transpose_item<true>(P.in[I_W_IN], DM, PROJW, (bf16_t*)(ws + WS_WIN), DM, 0, scr, r, lane); continue; } r -= I_IN;
        if (r < I_SQ) { transpose_item(P.in[I_W_BR_M], DM, DM, (bf16_t*)(ws + WS_WBR), 2 * DM, 0, scr, r, lane); continue; } r -= I_SQ;
        if (r < I_SQ) { transpose_item(P.in[I_W_BR_G], DM, DM, (bf16_t*)(ws + WS_WBR), 2 * DM, DM, scr, r, lane); continue; } r -= I_SQ;
        if (r < I_SQ) { transpose_item(P.in[I_W_OUT], DM, DM, (bf16_t*)(ws + WS_WOUT), DM, 0, scr, r, lane); continue; } r -= I_SQ;
        if (r < I_SQ) { transpose_item(P.in[I_W_PLE_GATE], DM, DM, (bf16_t*)(ws + WS_WPLE), PLEK, PLE, scr, r, lane); continue; } r -= I_SQ;
        if (r < I_UP) { transpose_item(P.in[I_W_UP], DM, DFF, (bf16_t*)(ws + WS_WUP), DM, 0, scr, r, lane); continue; } r -= I_UP;
        if (r < I_DN) { transpose_item(P.in[I_W_DOWN], DFF, DM, (bf16_t*)(ws + WS_WDN), DFF, 0, scr, r, lane); continue; } r -= I_DN;
        transpose_item(P.in[I_W_PLE_PROJ], PLE, DM, (bf16_t*)(ws + WS_WPLE), PLEK, 0, scr, r, lane);
    }
    {
        float* wcx = (float*)(ws + WS_WCX);
        const float* wq = P.in[I_WQ]; const float* wk = P.in[I_WK]; const float* wv = P.in[I_WV]; const float* wif = P.in[I_W_IF];
        for (int i = blockIdx.x * NTHR + tid; i < DM * 8; i += gridDim.x * NTHR) {
            const int c = i >> 3, j = i & 7, blk = c >> 2, d = c & 3; float sc = 0.f, sx = 0.f;
#pragma unroll
            for (int e = 0; e < 4; ++e) {
                sc += wq[blk * 16 + d * 4 + e] * wif[(size_t)(blk * 4 + e) * 8 + j] + wk[blk * 16 + d * 4 + e] * wif[(size_t)(DM + blk * 4 + e) * 8 + j];
                sx += wv[blk * 16 + d * 4 + e] * wif[(size_t)(2 * DM + blk * 4 + e) * 8 + j]; }
            wcx[i] = sc; wcx[DM * 8 + i] = sx;
        }
    }
    { bf16_t* wsp = (bf16_t*)(ws + WS_WSP); const float* w = P.in[I_W_SP];
      for (int i = blockIdx.x * NTHR + tid; i < 8 * 128 * 128; i += gridDim.x * NTHR) { const int t = (i >> 7) & 127, s = i & 127; wsp[i] = (bf16_t)f2bf(s <= t ? w[i] : 0.f); } }
    bf16_t* XN = (bf16_t*)(ws + WS_XN);
    for (int m = gw; m < NTOK; m += NGW) rms_row_to_bf16(P.in[I_X] + (size_t)m * DM, P.in[I_MIX_PRE_G], XN + (size_t)m * DM, lane);
}

namespace pg8 {
constexpr int BM = 256, BK = 64, HALF = 128, HTB = HALF * BK * 2, STAGE_BYTES = 8 * HTB, NXCD = 8, WGM = 8;
__host__ __device__ __forceinline__ int lds_byte(int r, int c) { const int st = (r >> 4) * 2 + (c >> 5), rr = r & 15, cc = c & 31, ob = rr * 64 + cc * 2; return st * 1024 + (ob ^ (((ob >> 9) & 1) << 5)); }
__host__ __device__ __forceinline__ void stage_rc(int b, int& R, int& C) { const int st = b / 1024, sb = b % 1024, swz = sb ^ (((sb >> 9) & 1) << 5); R = (st >> 1) * 16 + swz / 64; C = (st & 1) * 32 + (swz % 64) / 2; }
__host__ __device__ __forceinline__ int perm32(int rho) { const int n = rho >> 4, i = rho & 15; return 8 * (i >> 2) + 4 * n + (i & 3); }
struct Unit { int pm, pn; };
struct Gemm { const bf16_t* A; const bf16_t* Bt; int lda, ldb, M, N, K; };
struct StaticOrder {
    int nM, nN, nwg, G, c;
    __host__ __device__ void init(int M, int N, int G_, int c_) { nM = M / BM; nN = N / BM; nwg = nM * nN; G = G_; c = c_; }
    __host__ __device__ bool next(int i, Unit& u) const {
        const long L = (long)i * G + c; if (L >= nwg) return false;
        int wgid = (int)L; { const int q = nwg / NXCD, r = nwg % NXCD, xcd = wgid % NXCD, off = wgid / NXCD; wgid = (xcd < r ? xcd * (q + 1) : r * (q + 1) + (xcd - r) * q) + off; }
        const int nig = WGM * nN, gid = wgid / nig, fm = gid * WGM, gsz = (nM - fm) < WGM ? (nM - fm) : WGM;
        u.pm = fm + ((wgid % nig) % gsz); u.pn = (wgid % nig) / gsz; return true;
    }
};
template <class F> struct Epi8 {
    static constexpr bool PERM = true; F f;
    __device__ __forceinline__ void operator()(f32x4 (&acc)[2][2][4][2], const Unit& u_, int wr, int wc, int fr, int fq) const {
        Unit u = u_; asm volatile("" : "+s"(u.pm), "+s"(u.pn));
#pragma unroll
        for (int ai = 0; ai < 2; ++ai)
#pragma unroll
            for (int m = 0; m < 4; ++m)
                { f.store16(u.pm * BM + ai * HALF + wr * 64 + m * 16 + fr, u.pn, wc * 32 + 8 * fq, acc[ai][0][m][0], acc[ai][0][m][1], acc[ai][1][m][0], acc[ai][1][m][1]); asm volatile("" ::: "memory"); }
    }
    __device__ __forceinline__ void mid(f32x4 (&acc)[2][2][4][2], const Unit& u_, int wr, int wc, int fr, int fq) const {
        Unit u = u_; asm volatile("" : "+s"(u.pm), "+s"(u.pn));
#pragma unroll
        for (int ai = 0; ai < 2; ++ai)
#pragma unroll
            for (int m = 0; m < 4; ++m)
#pragma unroll
                for (int bj = 0; bj < 2; ++bj) { f.mid8(u.pm * BM + ai * HALF + wr * 64 + m * 16 + fr, u.pn * BM + bj * HALF + wc * 32 + 8 * fq, acc[ai][bj][m][0], acc[ai][bj][m][1]); asm volatile("" ::: "memory"); }
    }
};
template <class F> struct Epi4 {
    static constexpr bool PERM = false; F f;
    __device__ __forceinline__ void operator()(f32x4 (&acc)[2][2][4][2], const Unit& u_, int wr, int wc, int fr, int fq) const {
        Unit u = u_; asm volatile("" : "+s"(u.pm), "+s"(u.pn));
#pragma unroll
        for (int ai = 0; ai < 2; ++ai)
#pragma unroll
            for (int m = 0; m < 4; ++m)
#pragma unroll
                for (int bj = 0; bj < 2; ++bj)
#pragma unroll
                    for (int n = 0; n < 2; ++n) { f.store4(u.pm * BM + ai * HALF + wr * 64 + m * 16 + fr, u.pn * BM + bj * HALF + wc * 32 + 16 * n + 4 * fq, acc[ai][bj][m][n], ((ai * 4 + m) * 2 + bj) * 2 + n); if (n) asm volatile("" ::: "memory"); }
    }
    __device__ __forceinline__ void mid(f32x4 (&acc)[2][2][4][2], const Unit& u_, int wr, int wc, int fr, int fq) const {
        Unit u = u_; asm volatile("" : "+s"(u.pm), "+s"(u.pn));
#pragma unroll
        for (int ai = 0; ai < 2; ++ai)
#pragma unroll
            for (int m = 0; m < 4; ++m)
#pragma unroll
                for (int bj = 0; bj < 2; ++bj)
#pragma unroll
                    for (int n = 0; n < 2; ++n) { f.mid4(u.pm * BM + ai * HALF + wr * 64 + m * 16 + fr, u.pn * BM + bj * HALF + wc * 32 + 16 * n + 4 * fq, acc[ai][bj][m][n], ((ai * 4 + m) * 2 + bj) * 2 + n); if (n) asm volatile("" ::: "memory"); }
    }
};
template <class Epi, int HOOK_T, bool ALIGN_EPI>
__device__ __forceinline__ void gemm_phase(LAS unsigned char* lds, const Gemm g, const StaticOrder& S, const Epi& E) {
    int tid_ = threadIdx.x; asm volatile("" : "+v"(tid_));
    const int tid = tid_, wid = __builtin_amdgcn_readfirstlane(tid >> 6), lane = tid & 63, wr = wid >> 2, wc = wid & 3, fr = lane & 15, fq = lane >> 4;
    const int K = g.K, nt = K / BK;
    unsigned voffA[2], voffB[2];
#pragma unroll
    for (int i = 0; i < 2; ++i) { int R, C; stage_rc(tid * 16 + i * 8192, R, C); const int Rb = Epi::PERM ? ((R & ~31) + perm32(R & 31)) : R;
        voffA[i] = (unsigned)(R * g.lda + C) * 2u; voffB[i] = (unsigned)(Rb * g.ldb + C) * 2u; }
    const size_t kstep = (size_t)(BK * 2);
    const size_t hstepA = (size_t)HALF * g.lda * 2, hstepB = (size_t)HALF * g.ldb * 2;
    const size_t tstepA = 2 * hstepA, tstepB = 2 * hstepB;
    const unsigned ldsw = (unsigned)wid * 1024u;
    const int aoff = lds_byte(wr * 64 + fr, fq * 8), boff = lds_byte(wc * 32 + fr, fq * 8);
#define PG8_SA(b, h) (((b) * 2 + (h)) * HTB)
#define PG8_SB(b, h) ((4 + (b) * 2 + (h)) * HTB)
#define PG8_STAGE(bufoff, gbase, voff) do { _Pragma("unroll") for (int _i = 0; _i < 2; ++_i) \
        __builtin_amdgcn_global_load_lds((const unsigned*)((const char*)(gbase) + (voff)[_i]), (LAS unsigned*)(lds + (bufoff) + ldsw + _i * 8192), 16, 0, 0); } while (0)
#define PG8_LDA(dst, b, h) do { _Pragma("unroll") for (int m = 0; m < 4; ++m) _Pragma("unroll") for (int k = 0; k < 2; ++k) dst[m][k] = *(const LAS bf16x8*)(lds + PG8_SA(b, h) + aoff + m * 2048 + k * 1024); } while (0)
#define PG8_LDB(dst, b, h) do { _Pragma("unroll") for (int n = 0; n < 2; ++n) _Pragma("unroll") for (int k = 0; k < 2; ++k) dst[n][k] = *(const LAS bf16x8*)(lds + PG8_SB(b, h) + boff + n * 2048 + k * 1024); } while (0)
#define PG8_MMA(ai, bj, At, Bt) do { __builtin_amdgcn_s_setprio(1); _Pragma("unroll") for (int m = 0; m < 4; ++m) _Pragma("unroll") for (int n = 0; n < 2; ++n) _Pragma("unroll") for (int k = 0; k < 2; ++k) \
        acc[ai][bj][m][n] = __builtin_amdgcn_mfma_f32_16x16x32_bf16(Bt[n][k], At[m][k], acc[ai][bj][m][n], 0, 0, 0); __builtin_amdgcn_s_setprio(0); } while (0)
#define PG8_WAIT_V(n) asm volatile("s_waitcnt vmcnt(" #n ")" ::: "memory")
#define PG8_WAIT_L(n) asm volatile("s_waitcnt lgkmcnt(" #n ")" ::: "memory")
#define PG8_BAR __builtin_amdgcn_s_barrier()
#define PG8_SCHED __builtin_amdgcn_sched_barrier(0)
    Unit cur, nxt; int ui = 0;
    if (!S.next(0, cur)) return;
    f32x4 acc[2][2][4][2];
#pragma unroll
    for (int a = 0; a < 2; ++a)
#pragma unroll
        for (int b = 0; b < 2; ++b)
#pragma unroll
            for (int m = 0; m < 4; ++m)
#pragma unroll
                for (int n = 0; n < 2; ++n) acc[a][b][m][n] = (f32x4){0.f, 0.f, 0.f, 0.f};
    bf16x8 At[4][2], B0[2][2], B1[2][2];
    const char* cA = (const char*)g.A + (size_t)cur.pm * tstepA; const char* cB = (const char*)g.Bt + (size_t)cur.pn * tstepB;
    PG8_STAGE(PG8_SB(0, 0), cB, voffB); PG8_STAGE(PG8_SB(0, 1), cB + hstepB, voffB); PG8_STAGE(PG8_SA(0, 0), cA, voffA); PG8_STAGE(PG8_SA(0, 1), cA + hstepA, voffA);
    if (wr == 1) PG8_BAR;
    PG8_WAIT_V(2); PG8_BAR;
    PG8_STAGE(PG8_SB(1, 0), cB + kstep, voffB); PG8_STAGE(PG8_SA(1, 0), cA + kstep, voffA); PG8_STAGE(PG8_SB(1, 1), cB + hstepB + kstep, voffB);
    PG8_WAIT_V(6); PG8_BAR;
    for (;;) {
        const bool has_next = S.next(ui + 1, nxt);
        const char* nA = has_next ? (const char*)g.A + (size_t)nxt.pm * tstepA : cA; const char* nB = has_next ? (const char*)g.Bt + (size_t)nxt.pn * tstepB : cB;
#define PG8_KBODY() do { \
            const bool last = (t == nt - 2); \
            const char* a1 = cA + (size_t)(t + 1) * kstep; \
            const char* a2 = last ? nA : cA + (size_t)(t + 2) * kstep; const char* b2 = last ? nB : cB + (size_t)(t + 2) * kstep; \
            const char* a3 = a2 + kstep; const char* b3 = b2 + kstep; \
            PG8_LDB(B0, 0, 0); PG8_LDB(B1, 0, 1); PG8_SCHED; PG8_LDA(At, 0, 0); PG8_STAGE(PG8_SA(1, 1), a1 + hstepA, voffA); \
            PG8_WAIT_V(8); PG8_WAIT_L(0); PG8_BAR; PG8_MMA(0, 0, At, B0); PG8_MMA(0, 1, At, B1); PG8_BAR; PG8_SCHED; \
            PG8_LDA(At, 0, 1); PG8_STAGE(PG8_SB(0, 0), b2, voffB); PG8_STAGE(PG8_SB(0, 1), b2 + hstepB, voffB); PG8_STAGE(PG8_SA(0, 0), a2, voffA); \
            PG8_WAIT_V(8); PG8_WAIT_L(0); PG8_BAR; PG8_MMA(1, 0, At, B0); PG8_MMA(1, 1, At, B1); PG8_BAR; PG8_SCHED; \
            PG8_LDB(B0, 1, 0); PG8_LDB(B1, 1, 1); PG8_SCHED; PG8_LDA(At, 1, 0); PG8_STAGE(PG8_SA(0, 1), a2 + hstepA, voffA); \
            PG8_WAIT_V(8); PG8_WAIT_L(0); PG8_BAR; PG8_MMA(0, 0, At, B0); PG8_MMA(0, 1, At, B1); PG8_BAR; PG8_SCHED; \
            PG8_LDA(At, 1, 1); PG8_STAGE(PG8_SB(1, 0), b3, voffB); PG8_STAGE(PG8_SB(1, 1), b3 + hstepB, voffB); PG8_STAGE(PG8_SA(1, 0), a3, voffA); \
            PG8_WAIT_V(8); PG8_WAIT_L(0); PG8_BAR; PG8_MMA(1, 0, At, B0); PG8_MMA(1, 1, At, B1); PG8_BAR; PG8_SCHED; \
        } while (0)
        int t = 0;
        if constexpr (HOOK_T > 0) {
            for (; t < HOOK_T; t += 2) PG8_KBODY();
            PG8_SCHED; E.mid(acc, cur, wr, wc, fr, fq); PG8_SCHED;
        }
        for (; t < nt; t += 2) PG8_KBODY();
#undef PG8_KBODY
        if constexpr (ALIGN_EPI) { if (wr == 0) PG8_BAR; }
        E(acc, cur, wr, wc, fr, fq);
        if (!has_next) break;
#pragma unroll
        for (int a = 0; a < 2; ++a)
#pragma unroll
            for (int b = 0; b < 2; ++b)
#pragma unroll
                for (int m = 0; m < 4; ++m)
#pragma unroll
                    for (int n = 0; n < 2; ++n) acc[a][b][m][n] = (f32x4){0.f, 0.f, 0.f, 0.f};
        cur = nxt; cA = nA; cB = nB; ++ui;
        if constexpr (ALIGN_EPI) { if (wr == 1) PG8_BAR; }
    }
    PG8_WAIT_V(0);
    if constexpr (!ALIGN_EPI) { if (wr == 0) PG8_BAR; }
    PG8_BAR;
#undef PG8_SA
#undef PG8_SB
#undef PG8_STAGE
#undef PG8_LDA
#undef PG8_LDB
#undef PG8_MMA
#undef PG8_WAIT_V
#undef PG8_WAIT_L
#undef PG8_BAR
#undef PG8_SCHED
}
}
__device__ __forceinline__ void st_bf16x8(bf16_t* p, f32x4 a, f32x4 b) { u32x4 o; o.x = pk2(a.x, a.y); o.y = pk2(a.z, a.w); o.z = pk2(b.x, b.y); o.w = pk2(b.z, b.w); *(u32x4*)p = o; }
__device__ __forceinline__ void ld_bf16x8(const bf16_t* p, f32x4& a, f32x4& b) { const u32x4 w = *(const u32x4*)p; a = (f32x4){bflo(w.x), bfhi(w.x), bflo(w.y), bfhi(w.y)}; b = (f32x4){bflo(w.z), bfhi(w.z), bflo(w.w), bfhi(w.w)}; }
template <class FN> __device__ __forceinline__ f32x4 map4(f32x4 v, FN fn) { return (f32x4){fn(v.x), fn(v.y), fn(v.z), fn(v.w)}; }
struct ProjF {
    bf16_t* proj;
    __device__ __forceinline__ void store16(int row, int pn, int cl, f32x4 a0, f32x4 a1, f32x4 b0, f32x4 b1) const {
        bf16_t* rp = proj + (size_t)row * PROJW;
        if (pn < 16) {
            const int sec = pn >> 2;
            if (sec == 1) { a0 = map4(a0, siluf_); a1 = map4(a1, siluf_); b0 = map4(b0, siluf_); b1 = map4(b1, siluf_); }
            else if (sec >= 2) { a0 = map4(a0, gelu_tanh); a1 = map4(a1, gelu_tanh); b0 = map4(b0, gelu_tanh); b1 = map4(b1, gelu_tanh); }
            st_bf16x8(rp + pn * 256 + cl, a0, a1); st_bf16x8(rp + pn * 256 + 128 + cl, b0, b1);
        } else {
            const int j = (pn - 16) * 128 + cl;
            a0 = map4(a0, sigmoidf_); a1 = map4(a1, sigmoidf_); b0 = map4(b0, sigmoidf_); b1 = map4(b1, sigmoidf_);
            st_bf16x8(rp + 4 * DM + j, a0 / b0, a1 / b1); st_bf16x8(rp + 5 * DM + j, b0, b1);
        }
    }
    __device__ __forceinline__ void mid8(int, int, f32x4&, f32x4&) const {}
};
struct MergeF {
    const bf16_t* proj; bf16_t* merged;
    __device__ __forceinline__ void mid8(int row, int col, f32x4& a, f32x4& b) const {
        f32x4 r0, r1; ld_bf16x8(proj + (size_t)row * PROJW + 4 * DM + col, r0, r1); a = a * r0; b = b * r1;
    }
    __device__ __forceinline__ void store16(int row, int pn, int cl, f32x4 a0, f32x4 a1, f32x4 b0, f32x4 b1) const {
        const int col = pn * 256 + cl; f32x4 g0, g1;
        ld_bf16x8(proj + (size_t)row * PROJW + 5 * DM + col, g0, g1); st_bf16x8(merged + (size_t)row * DM + col, a0 * g0, a1 * g1);
        ld_bf16x8(proj + (size_t)row * PROJW + 5 * DM + col + 128, g0, g1); st_bf16x8(merged + (size_t)row * DM + col + 128, b0 * g0, b1 * g1);
    }
};
struct F32F {
    float* o; int ldc;
    __device__ __forceinline__ void store4(int row, int col, f32x4 v, int) const { *(f32x4*)(o + (size_t)row * ldc + col) = v; }
    __device__ __forceinline__ void mid4(int, int, f32x4&, int) const {}
};
struct Relu2F {
    bf16_t* o; int ldc;
    __device__ __forceinline__ void store16(int row, int pn, int cl, f32x4 a0, f32x4 a1, f32x4 b0, f32x4 b1) const {
        auto r2 = [](float x) { const float r = fmaxf(x, 0.f); return r * r; };
        bf16_t* p = o + (size_t)row * ldc + pn * 256 + cl;
        st_bf16x8(p, map4(a0, r2), map4(a1, r2)); st_bf16x8(p + 128, map4(b0, r2), map4(b1, r2));
    }
    __device__ __forceinline__ void mid8(int, int, f32x4&, f32x4&) const {}
};
struct PleF {
    float* o; f32x4* stash;
    __device__ __forceinline__ void mid4(int, int, f32x4& v, int idx) const { unsigned t = threadIdx.x; asm volatile("" : "+v"(t)); stash[((size_t)blockIdx.x * 32 + idx) * NTHR + t] = v; v = (f32x4){0.f, 0.f, 0.f, 0.f}; }
    __device__ __forceinline__ void store4(int row, int col, f32x4 v, int idx) const {
        unsigned t = threadIdx.x; asm volatile("" : "+v"(t)); const f32x4 p = stash[((size_t)blockIdx.x * 32 + idx) * NTHR + t];
        *(f32x4*)(o + (size_t)row * DM + col) = map4(v, sigmoidf_) * p;
    }
};

__device__ __forceinline__ void ld4(const bf16_t* p, float (&x)[4]) { const u32x2 w = *(const u32x2*)p; x[0] = bflo(w.x); x[1] = bfhi(w.x); x[2] = bflo(w.y); x[3] = bfhi(w.y); }
__device__ __forceinline__ void st4(bf16_t* p, const float (&x)[4]) { u32x2 o; o.x = pk2(x[0], x[1]); o.y = pk2(x[2], x[3]); *(u32x2*)p = o; }
__device__ void p2_qkv(const Params& P, LAS unsigned char* lds) {
    const int tid = threadIdx.x, lane = tid & 63, wave = tid >> 6, h = wave & 3, half = wave >> 2;
    unsigned char* ws = P.ws;
    const bf16_t* PROJ = (const bf16_t*)(ws + WS_PROJ);
    bf16_t* Q = (bf16_t*)P.out; bf16_t* K = Q + (size_t)NTOK * DM; bf16_t* V = (bf16_t*)(ws + WS_XN);
    float* GATES = (float*)(ws + WS_GATES);
    LAS float* part = (LAS float*)lds;
    const int ch = h * 256 + lane * 4, blk = ch >> 2;
    float cw[4][4], cb[4], wq[4][4], wk[4][4], wv[4][4], wc[4][8], wx[4][8];
#pragma unroll
    for (int j = 0; j < 4; ++j)
#pragma unroll
        for (int d = 0; d < 4; ++d) cw[j][d] = P.in[I_CONV_W][j * DM + ch + d];
#pragma unroll
    for (int d = 0; d < 4; ++d) { cb[d] = P.in[I_CONV_B][ch + d];
#pragma unroll
        for (int e = 0; e < 4; ++e) { wq[d][e] = P.in[I_WQ][blk * 16 + d * 4 + e]; wk[d][e] = P.in[I_WK][blk * 16 + d * 4 + e]; wv[d][e] = P.in[I_WV][blk * 16 + d * 4 + e]; }
#pragma unroll
        for (int j = 0; j < 8; ++j) { wc[d][j] = ((const float*)(ws + WS_WCX))[(ch + d) * 8 + j]; wx[d][j] = ((const float*)(ws + WS_WCX))[DM * 8 + (ch + d) * 8 + j]; } }
    for (int item = blockIdx.x; item < NTOK / 16; item += gridDim.x) {
        const int tb = item * 16 + half * 8;
        float x0[4], x1[4], x2[4], x3[4];
        if ((tb & (SEQ - 1)) == 0) {
#pragma unroll
            for (int d = 0; d < 4; ++d) { x0[d] = 0.f; x1[d] = 0.f; x2[d] = 0.f; }
        } else { ld4(PROJ + (size_t)(tb - 3) * PROJW + ch, x0); ld4(PROJ + (size_t)(tb - 2) * PROJW + ch, x1); ld4(PROJ + (size_t)(tb - 1) * PROJW + ch, x2); }
#pragma unroll 1
        for (int i = 0; i < 8; ++i) {
            const int t = tb + i;
            ld4(PROJ + (size_t)t * PROJW + ch, x3);
            float mc[4], q[4], k[4], v[4], gp[8];
#pragma unroll
            for (int d = 0; d < 4; ++d) mc[d] = siluf_(cw[0][d] * x0[d] + cw[1][d] * x1[d] + cw[2][d] * x2[d] + cw[3][d] * x3[d] + cb[d]);
#pragma unroll
            for (int e = 0; e < 4; ++e) { q[e] = mc[0] * wq[0][e] + mc[1] * wq[1][e] + mc[2] * wq[2][e] + mc[3] * wq[3][e];
                k[e] = mc[0] * wk[0][e] + mc[1] * wk[1][e] + mc[2] * wk[2][e] + mc[3] * wk[3][e];
                v[e] = x3[0] * wv[0][e] + x3[1] * wv[1][e] + x3[2] * wv[2][e] + x3[3] * wv[3][e]; }
            st4(Q + (size_t)t * DM + ch, q); st4(K + (size_t)t * DM + ch, k); st4(V + (size_t)t * DM + ch, v);
#pragma unroll
            for (int j = 0; j < 8; ++j) { float s = 0.f;
#pragma unroll
                for (int d = 0; d < 4; ++d) s += mc[d] * wc[d][j] + x3[d] * wx[d][j];
                gp[j] = wave_sum(s); }
            if (lane == 0) {
#pragma unroll
                for (int j = 0; j < 8; ++j) part[((half * 8 + i) * 4 + h) * 8 + j] = gp[j]; }
#pragma unroll
            for (int d = 0; d < 4; ++d) { x0[d] = x1[d]; x1[d] = x2[d]; x2[d] = x3[d]; }
        }
        __syncthreads();
        if (tid < 128) { const int tok = tid >> 3, j = tid & 7;
            const float val = part[(tok * 4 + 0) * 8 + j] + part[(tok * 4 + 1) * 8 + j] + part[(tok * 4 + 2) * 8 + j] + part[(tok * 4 + 3) * 8 + j] + P.in[I_B_IF][j];
            GATES[(size_t)(item * 16 + tok) * 8 + j] = (j < 4) ? val : log_sigmoid(val); }
        __syncthreads();
    }
    bf16_t* PW = (bf16_t*)(ws + WS_PROJ);
    const int gw = blockIdx.x * NWAVES + wave, NGW = gridDim.x * NWAVES;
    for (int m = gw; m < NTOK; m += NGW) {
        bf16_t* row = PW + (size_t)m * PROJW + 3 * DM + lane * 16;
        const u32x4 a = *(const u32x4*)row, b = *(const u32x4*)(row + 8);
        float x[16] = {bflo(a.x), bfhi(a.x), bflo(a.y), bfhi(a.y), bflo(a.z), bfhi(a.z), bflo(a.w), bfhi(a.w), bflo(b.x), bfhi(b.x), bflo(b.y), bfhi(b.y), bflo(b.z), bfhi(b.z), bflo(b.w), bfhi(b.w)};
        float s = 0.f;
#pragma unroll
        for (int i = 0; i < 16; ++i) s += x[i];
        const float mu = wave_sum(s) * (1.f / DM); float s2 = 0.f;
#pragma unroll
        for (int i = 0; i < 16; ++i) { x[i] -= mu; s2 += x[i] * x[i]; }
        const float r = 1.0f / sqrtf(wave_sum(s2) * (1.f / DM) + EPS);
        const float* lw = P.in[I_G_LN_W] + lane * 16; const float* lb = P.in[I_G_LN_B] + lane * 16;
#pragma unroll
        for (int i = 0; i < 16; ++i) x[i] = x[i] * r * lw[i] + lb[i];
        u32x4 oa, ob; oa.x = pk2(x[0], x[1]); oa.y = pk2(x[2], x[3]); oa.z = pk2(x[4], x[5]); oa.w = pk2(x[6], x[7]); ob.x = pk2(x[8], x[9]); ob.y = pk2(x[10], x[11]); ob.z = pk2(x[12], x[13]); ob.w = pk2(x[14], x[15]);
        *(u32x4*)row = oa; *(u32x4*)(row + 8) = ob;
    }
}

constexpr int ML_C = 0, ML_N = 65536, ML_Q = ML_N + 1024, ML_K = ML_Q + 32768, ML_V = ML_K + 32768, ML_P = ML_V + 8192, ML_S = ML_P + 16384, ML_BYTES = ML_S + 2048;
__device__ void p3_mlstm_naive(const Params& P, LAS unsigned char* lds) {
    const int tid = threadIdx.x, lane = tid & 63, wave = tid >> 6;
    unsigned char* ws = P.ws;
    const bf16_t* Q = (const bf16_t*)P.out; const bf16_t* K = Q + (size_t)NTOK * DM; bf16_t* V = (bf16_t*)(ws + WS_XN);
    const float* GATES = (const float*)(ws + WS_GATES);
    LAS float* Cs = (LAS float*)(lds + ML_C); LAS float* ns = (LAS float*)(lds + ML_N);
    LAS unsigned* qs = (LAS unsigned*)(lds + ML_Q); LAS unsigned* ks = (LAS unsigned*)(lds + ML_K);
    LAS bf16_t* vs = (LAS bf16_t*)(lds + ML_V);
    LAS float* Ps = (LAS float*)(lds + ML_P);
    LAS float* sc = (LAS float*)(lds + ML_S);
    for (int item = blockIdx.x; item < 256; item += gridDim.x) {
        const int b = item >> 4, h = (item >> 2) & 3, j = item & 3;
        for (int i = tid; i < 256 * 64; i += NTHR) Cs[i] = 0.f;
        if (tid < 256) ns[tid] = 0.f;
        float m = 0.f;
        __syncthreads();
        for (int c = 0; c < 32; ++c) {
            const size_t t0 = (size_t)b * SEQ + c * 64;
#pragma unroll
            for (int i = 0; i < 4; ++i) { const int p = tid + i * NTHR, r = p >> 5, cc = p & 31;
                *(LAS u32x4*)(qs + r * 128 + cc * 4) = *(const u32x4*)(Q + (t0 + r) * DM + h * 256 + cc * 8);
                *(LAS u32x4*)(ks + r * 128 + cc * 4) = *(const u32x4*)(K + (t0 + r) * DM + h * 256 + cc * 8); }
            { const int r = tid >> 3, cc = tid & 7; *(LAS u32x4*)(vs + r * 64 + cc * 8) = *(const u32x4*)(V + (t0 + r) * DM + h * 256 + j * 64 + cc * 8); }
            if (wave == 0) {
                const float ig = GATES[(t0 + lane) * 8 + h], lf = GATES[(t0 + lane) * 8 + 4 + h];
                float bs = lf;
#pragma unroll
                for (int o = 1; o < 64; o <<= 1) { const float t = __shfl_up(bs, o); if (lane >= o) bs += t; }
                const float u = ig - bs; float gm = u;
#pragma unroll
                for (int o = 1; o < 64; o <<= 1) { const float t = __shfl_up(gm, o); if (lane >= o) gm = fmaxf(gm, t); }
                const float g = fmaxf(gm, m), gL = __shfl(g, 63), bL = __shfl(bs, 63);
                sc[lane] = u; sc[64 + lane] = g; sc[128 + lane] = expf(m - g); sc[192 + lane] = expf(-bs - g); sc[256 + lane] = expf(u - gL);
                if (lane == 0) sc[384] = expf(m - gL);
                m = bL + gL;
            }
            __syncthreads();
            { const int t = tid >> 3, sg = tid & 7; float acc[8];
#pragma unroll
                for (int i = 0; i < 8; ++i) acc[i] = 0.f;
                if (sg * 8 <= t) {
                    for (int d2 = 0; d2 < 128; ++d2) { const unsigned qw = qs[t * 128 + d2]; const float ql = bflo(qw), qh = bfhi(qw);
#pragma unroll
                        for (int i = 0; i < 8; ++i) { const unsigned kw = ks[(sg * 8 + i) * 128 + d2]; acc[i] += ql * bflo(kw) + qh * bfhi(kw); } } }
                const float gt = sc[64 + t];
#pragma unroll
                for (int i = 0; i < 8; ++i) { const int s = sg * 8 + i; Ps[t * 64 + s] = (s <= t) ? acc[i] * 0.0625f * expf(sc[s] - gt) : 0.f; } }
            __syncthreads();
            if (tid < 64) { const int t = tid; float qn = 0.f;
                for (int d2 = 0; d2 < 128; ++d2) { const unsigned qw = qs[t * 128 + d2]; qn += bflo(qw) * ns[2 * d2] + bfhi(qw) * ns[2 * d2 + 1]; }
                float ps = 0.f;
                for (int s = 0; s <= t; ++s) ps += Ps[t * 64 + s];
                sc[320 + t] = sc[128 + t] * qn + ps; }
            __syncthreads();
            { const int t = tid >> 3, eg = tid & 7; float acc[8];
#pragma unroll
                for (int i = 0; i < 8; ++i) acc[i] = 0.f;
                for (int d2 = 0; d2 < 128; ++d2) { const unsigned qw = qs[t * 128 + d2]; const float ql = bflo(qw), qh = bfhi(qw);
#pragma unroll
                    for (int i = 0; i < 8; ++i) acc[i] += ql * Cs[(2 * d2) * 64 + eg * 8 + i] + qh * Cs[(2 * d2 + 1) * 64 + eg * 8 + i]; }
                const float iw = sc[128 + t];
#pragma unroll
                for (int i = 0; i < 8; ++i) acc[i] *= iw;
                for (int s = 0; s <= t; ++s) { const float pv = Ps[t * 64 + s];
#pragma unroll
                    for (int i = 0; i < 8; ++i) acc[i] += pv * bf2f(vs[s * 64 + eg * 8 + i]); }
                const float dn = 1.0f / fmaxf(fabsf(sc[320 + t]), sc[192 + t]);
                u32x4 o; o.x = pk2(acc[0] * dn, acc[1] * dn); o.y = pk2(acc[2] * dn, acc[3] * dn); o.z = pk2(acc[4] * dn, acc[5] * dn); o.w = pk2(acc[6] * dn, acc[7] * dn);
                *(u32x4*)(V + (t0 + t) * DM + h * 256 + j * 64 + eg * 8) = o;
            }
            __syncthreads();
            { const int d = tid >> 1, eh = tid & 1; const float decay = sc[384]; float acc[32];
#pragma unroll
                for (int i = 0; i < 32; ++i) acc[i] = decay * Cs[d * 64 + eh * 32 + i];
                float nacc = decay * ns[d];
                for (int s = 0; s < 64; ++s) { const unsigned kw = ks[s * 128 + (d >> 1)]; const float kv = ((d & 1) ? bfhi(kw) : bflo(kw)) * 0.0625f * sc[256 + s];
                    nacc += kv;
#pragma unroll
                    for (int i = 0; i < 32; ++i) acc[i] += kv * bf2f(vs[s * 64 + eh * 32 + i]); }
#pragma unroll
                for (int i = 0; i < 32; ++i) Cs[d * 64 + eh * 32 + i] = acc[i];
                if (eh == 0) ns[d] = nacc; }
            __syncthreads();
        }
    }
}

__device__ void p3_gmlp_naive(const Params& P, LAS unsigned char* lds) {
    const int tid = threadIdx.x;
    bf16_t* PROJ = (bf16_t*)(P.ws + WS_PROJ);
    LAS bf16_t* vv = (LAS bf16_t*)lds;
    const float* WSP = P.in[I_W_SP]; const float* BSP = P.in[I_B_SP];
    for (int item = blockIdx.x; item < 2048; item += gridDim.x) {
        const int g = item & 7, c = (item >> 3) & 15, b = item >> 7; const size_t t0 = (size_t)b * SEQ + c * 128;
#pragma unroll
        for (int i = 0; i < 4; ++i) { const int p = tid + i * NTHR, r = p >> 4, cc = p & 15; *(LAS u32x4*)(vv + r * 128 + cc * 8) = *(const u32x4*)(PROJ + (t0 + r) * PROJW + 3 * DM + g * 128 + cc * 8); }
        __syncthreads();
        const int t = tid >> 2, dg = tid & 3; float acc[32];
#pragma unroll
        for (int i = 0; i < 32; ++i) acc[i] = 0.f;
        const float* wrow = WSP + ((size_t)g * 128 + t) * 128;
        for (int s = 0; s <= t; ++s) { const float w = wrow[s];
#pragma unroll
            for (int i = 0; i < 32; ++i) acc[i] += w * bf2f(vv[s * 128 + dg * 32 + i]); }
        const float bs = BSP[g * 128 + t];
        bf16_t* gu = PROJ + (t0 + t) * PROJW + 2 * DM + g * 128 + dg * 32;
#pragma unroll
        for (int i = 0; i < 4; ++i) { const u32x4 w = *(const u32x4*)(gu + i * 8); u32x4 o;
            o.x = pk2(bflo(w.x) * (acc[i * 8 + 0] + bs), bfhi(w.x) * (acc[i * 8 + 1] + bs)); o.y = pk2(bflo(w.y) * (acc[i * 8 + 2] + bs), bfhi(w.y) * (acc[i * 8 + 3] + bs));
            o.z = pk2(bflo(w.z) * (acc[i * 8 + 4] + bs), bfhi(w.z) * (acc[i * 8 + 5] + bs)); o.w = pk2(bflo(w.w) * (acc[i * 8 + 6] + bs), bfhi(w.w) * (acc[i * 8 + 7] + bs));
            *(u32x4*)(gu + i * 8) = o; }
        __syncthreads();
    }
}

namespace mlm {
constexpr int QP = 264, VP = 88, PP = 72;
constexpr int QS_OFF = 0, KS_OFF = QS_OFF + 64 * QP * 2, VS_OFF = KS_OFF + 64 * QP * 2, CT_OFF = VS_OFF + 64 * VP * 2, PS_OFF = CT_OFF + 80 * QP * 2, SC_OFF = PS_OFF + 64 * PP * 2, BYTES = SC_OFF + 2048;
typedef short s16x4 __attribute__((ext_vector_type(4)));
typedef float f32x2_t __attribute__((ext_vector_type(2)));
typedef __bf16 bf16x2_t __attribute__((ext_vector_type(2)));
__device__ __forceinline__ unsigned cvtpk(float lo, float hi) { f32x2_t v = {lo, hi}; bf16x2_t b = __builtin_convertvector(v, bf16x2_t); return __builtin_bit_cast(unsigned, b); }
__device__ __forceinline__ s16x4 tr16(LAS unsigned char* p) { return __builtin_bit_cast(s16x4, __builtin_amdgcn_ds_read_tr16_b64_v4i16((LAS s16x4*)p)); }
__device__ __forceinline__ bf16x8 frag_tr(LAS unsigned char* p, int pitch_bytes) {
    const s16x4 lo = tr16(p), hi = tr16(p + 4 * pitch_bytes);
    return (bf16x8){lo.x, lo.y, lo.z, lo.w, hi.x, hi.y, hi.z, hi.w};
}
}
__device__ void p3_mlstm_mfma(const Params& P, LAS unsigned char* lds) {
    using namespace mlm;
    const int tid = threadIdx.x, lane = tid & 63, wave = __builtin_amdgcn_readfirstlane(tid >> 6), fr = lane & 15, fq = lane >> 4, q_ = fr >> 2, p_ = fr & 3;
    const int tau = wave >> 1, par = wave & 1;
    unsigned char* ws = P.ws;
    const bf16_t* Q = (const bf16_t*)P.out; const bf16_t* K = Q + (size_t)NTOK * DM; bf16_t* V = (bf16_t*)(ws + WS_XN);
    const float* GATES = (const float*)(ws + WS_GATES);
    LAS float* sc = (LAS float*)(lds + SC_OFF);
    for (int item = blockIdx.x; item < 256; item += gridDim.x) {
        const int b = item >> 4, h = (item >> 2) & 3, j = item & 3;
        for (int i = tid; i < 80 * QP * 2 / 16; i += NTHR) ((LAS u32x4*)(lds + CT_OFF))[i] = (u32x4){0u, 0u, 0u, 0u};
        if (tid < 64) { LAS bf16_t* r = (LAS bf16_t*)(lds + VS_OFF) + tid * VP + 64; r[0] = 0x3F80;
#pragma unroll
            for (int i = 1; i < 24; ++i) r[i] = 0; }
        f32x4 cacc[2][5];
#pragma unroll
        for (int a = 0; a < 2; ++a)
#pragma unroll
            for (int e = 0; e < 5; ++e) cacc[a][e] = (f32x4){0.f, 0.f, 0.f, 0.f};
        float m = 0.f;
        u32x4 pq[4], pk[4], pv; float pig = 0.f, plf = 0.f;
        const bf16_t* qb = Q + (size_t)b * SEQ * DM + h * 256; const bf16_t* kb = K + (size_t)b * SEQ * DM + h * 256; bf16_t* vb = V + (size_t)b * SEQ * DM + h * 256 + j * 64;
#define ML_LOAD(c_) do { const size_t r0_ = (size_t)(c_) * 64; \
            _Pragma("unroll") for (int i = 0; i < 4; ++i) { const int p = tid + i * NTHR, r = p >> 5, cc = p & 31; pq[i] = *(const u32x4*)(qb + (r0_ + r) * DM + cc * 8); pk[i] = *(const u32x4*)(kb + (r0_ + r) * DM + cc * 8); } \
            pv = *(const u32x4*)(vb + (r0_ + (tid >> 3)) * DM + (tid & 7) * 8); \
            if (wave == 0) { pig = GATES[((size_t)b * SEQ + r0_ + lane) * 8 + h]; plf = GATES[((size_t)b * SEQ + r0_ + lane) * 8 + 4 + h]; } } while (0)
        ML_LOAD(0);
        __syncthreads();
        for (int c = 0; c < 32; ++c) {
#pragma unroll
            for (int i = 0; i < 4; ++i) { const int p = tid + i * NTHR, r = p >> 5, cc = p & 31; *(LAS u32x4*)(lds + QS_OFF + r * QP * 2 + cc * 16) = pq[i]; *(LAS u32x4*)(lds + KS_OFF + r * QP * 2 + cc * 16) = pk[i]; }
            *(LAS u32x4*)(lds + VS_OFF + (tid >> 3) * VP * 2 + (tid & 7) * 16) = pv;
            if (wave == 0) {
                float bs = plf;
#pragma unroll
                for (int o = 1; o < 64; o <<= 1) { const float t = __shfl_up(bs, o); if (lane >= o) bs += t; }
                const float u = pig - bs; float gm = u;
#pragma unroll
                for (int o = 1; o < 64; o <<= 1) { const float t = __shfl_up(gm, o); if (lane >= o) gm = fmaxf(gm, t); }
                const float g = fmaxf(gm, m), gL = __shfl(g, 63), bL = __shfl(bs, 63);
                sc[lane] = u; sc[64 + lane] = g; sc[128 + lane] = expf(m - g); sc[192 + lane] = expf(-bs - g); sc[256 + lane] = expf(u - gL) * 0.0625f;
                if (lane == 0) sc[320] = expf(m - gL);
                m = bL + gL;
            }
            __syncthreads();
            if (c + 1 < 32) ML_LOAD(c + 1);
            bf16x8 qf[8];
#pragma unroll
            for (int kap = 0; kap < 8; ++kap) qf[kap] = *(const LAS bf16x8*)(lds + QS_OFF + ((16 * tau + fr) * QP + 32 * kap + 8 * fq) * 2);
            const float gt = sc[64 + 16 * tau + fr];
#pragma unroll
            for (int si = 0; si < 2; ++si) {
                const int sig = 2 * par + si; f32x4 acc = (f32x4){0.f, 0.f, 0.f, 0.f};
                if (sig <= tau) {
#pragma unroll
                    for (int kap = 0; kap < 8; ++kap) acc = __builtin_amdgcn_mfma_f32_16x16x32_bf16(*(const LAS bf16x8*)(lds + KS_OFF + ((16 * sig + fr) * QP + 32 * kap + 8 * fq) * 2), qf[kap], acc, 0, 0, 0);
                }
                const f32x4 us = *(const LAS f32x4*)(sc + 16 * sig + 4 * fq);
                const int t = 16 * tau + fr, s0 = 16 * sig + 4 * fq;
                const float w0 = (s0 + 0 <= t) ? acc.x * 0.0625f * __expf(us.x - gt) : 0.f, w1 = (s0 + 1 <= t) ? acc.y * 0.0625f * __expf(us.y - gt) : 0.f;
                const float w2 = (s0 + 2 <= t) ? acc.z * 0.0625f * __expf(us.z - gt) : 0.f, w3 = (s0 + 3 <= t) ? acc.w * 0.0625f * __expf(us.w - gt) : 0.f;
                u32x2 o; o.x = cvtpk(w0, w1); o.y = cvtpk(w2, w3);
                *(LAS u32x2*)(lds + PS_OFF + (t * PP + s0) * 2) = o;
            }
            f32x4 nacc[3];
#pragma unroll
            for (int ei = 0; ei < 3; ++ei) {
                const int eps = (ei == 2) ? 4 : 2 * par + ei; f32x4 acc = (f32x4){0.f, 0.f, 0.f, 0.f};
#pragma unroll
                for (int kap = 0; kap < 8; ++kap) acc = __builtin_amdgcn_mfma_f32_16x16x32_bf16(*(const LAS bf16x8*)(lds + CT_OFF + ((16 * eps + fr) * QP + 32 * kap + 8 * fq) * 2), qf[kap], acc, 0, 0, 0);
                nacc[ei] = acc * sc[128 + 16 * tau + fr];
            }
            __syncthreads();
            {
                bf16x8 pf[2];
#pragma unroll
                for (int kp = 0; kp < 2; ++kp) pf[kp] = *(const LAS bf16x8*)(lds + PS_OFF + ((16 * tau + fr) * PP + 32 * kp + 8 * fq) * 2);
#pragma unroll
                for (int ei = 0; ei < 3; ++ei) {
                    const int eps = (ei == 2) ? 4 : 2 * par + ei;
#pragma unroll
                    for (int kp = 0; kp < 2; ++kp) nacc[ei] = __builtin_amdgcn_mfma_f32_16x16x32_bf16(frag_tr(lds + VS_OFF + ((32 * kp + 8 * fq + q_) * VP + 16 * eps + 4 * p_) * 2, VP * 2), pf[kp], nacc[ei], 0, 0, 0);
                }
                const float den = __shfl(nacc[2].x, fr);
                const float rinv = 1.0f / fmaxf(fabsf(den), sc[192 + 16 * tau + fr]);
                bf16_t* hrow = vb + ((size_t)c * 64 + 16 * tau + fr) * DM;
#pragma unroll
                for (int ei = 0; ei < 2; ++ei) { const int eps = 2 * par + ei; u32x2 o; o.x = cvtpk(nacc[ei].x * rinv, nacc[ei].y * rinv); o.y = cvtpk(nacc[ei].z * rinv, nacc[ei].w * rinv);
                    *(u32x2*)(hrow + 16 * eps + 4 * fq) = o; }
            }
            {
                const float decay = sc[320];
                bf16x8 kw[2][2];
#pragma unroll
                for (int dl = 0; dl < 2; ++dl)
#pragma unroll
                    for (int kp = 0; kp < 2; ++kp) {
                        const bf16x8 f = frag_tr(lds + KS_OFF + ((32 * kp + 8 * fq + q_) * QP + 16 * (2 * wave + dl) + 4 * p_) * 2, QP * 2);
                        const u32x4 fw = __builtin_bit_cast(u32x4, f);
                        const f32x4 wa = *(const LAS f32x4*)(sc + 256 + 32 * kp + 8 * fq), wb = *(const LAS f32x4*)(sc + 256 + 32 * kp + 8 * fq + 4);
                        u32x4 o; o.x = cvtpk(bflo(fw.x) * wa.x, bfhi(fw.x) * wa.y); o.y = cvtpk(bflo(fw.y) * wa.z, bfhi(fw.y) * wa.w); o.z = cvtpk(bflo(fw.z) * wb.x, bfhi(fw.z) * wb.y); o.w = cvtpk(bflo(fw.w) * wb.z, bfhi(fw.w) * wb.w);
                        kw[dl][kp] = __builtin_bit_cast(bf16x8, o);
                    }
#pragma unroll
                for (int eps = 0; eps < 5; ++eps) {
                    bf16x8 vf[2];
#pragma unroll
                    for (int kp = 0; kp < 2; ++kp) vf[kp] = frag_tr(lds + VS_OFF + ((32 * kp + 8 * fq + q_) * VP + 16 * eps + 4 * p_) * 2, VP * 2);
#pragma unroll
                    for (int dl = 0; dl < 2; ++dl) {
                        f32x4 a = cacc[dl][eps] * decay;
                        a = __builtin_amdgcn_mfma_f32_16x16x32_bf16(kw[dl][0], vf[0], a, 0, 0, 0);
                        a = __builtin_amdgcn_mfma_f32_16x16x32_bf16(kw[dl][1], vf[1], a, 0, 0, 0);
                        cacc[dl][eps] = a;
                        u32x2 o; o.x = cvtpk(a.x, a.y); o.y = cvtpk(a.z, a.w);
                        *(LAS u32x2*)(lds + CT_OFF + ((16 * eps + fr) * QP + 16 * (2 * wave + dl) + 4 * fq) * 2) = o;
                    }
                }
            }
            __syncthreads();
        }
#undef ML_LOAD
    }
}

namespace gmm { constexpr int VVP = 136, VV_OFF = 0, WS_OFF = 128 * VVP * 2, BYTES = 2 * 128 * VVP * 2; }
__device__ void p3_gmlp_mfma(const Params& P, LAS unsigned char* lds) {
    using namespace gmm;
    const int tid = threadIdx.x, lane = tid & 63, wave = __builtin_amdgcn_readfirstlane(tid >> 6), fr = lane & 15, fq = lane >> 4, q_ = fr >> 2, p_ = fr & 3;
    bf16_t* PROJ = (bf16_t*)(P.ws + WS_PROJ); const bf16_t* WSPb = (const bf16_t*)(P.ws + WS_WSP); const float* BSP = P.in[I_B_SP];
    int g_staged = -1;
    u32x4 pre[4];
#define GM_LOAD(it_) do { const int g_ = (it_) & 7, c_ = ((it_) >> 3) & 15, b_ = (it_) >> 7; const size_t t0_ = (size_t)b_ * SEQ + c_ * 128; \
        _Pragma("unroll") for (int i = 0; i < 4; ++i) { const int p = tid + i * NTHR, r = p >> 4, cc = p & 15; pre[i] = *(const u32x4*)(PROJ + (t0_ + r) * PROJW + 3 * DM + g_ * 128 + cc * 8); } } while (0)
    if ((int)blockIdx.x < 2048) GM_LOAD(blockIdx.x);
    for (int item = blockIdx.x; item < 2048; item += gridDim.x) {
        const int g = item & 7, c = (item >> 3) & 15, b = item >> 7; const size_t t0 = (size_t)b * SEQ + c * 128;
#pragma unroll
        for (int i = 0; i < 4; ++i) { const int p = tid + i * NTHR, r = p >> 4, cc = p & 15; *(LAS u32x4*)(lds + VV_OFF + (r * VVP + cc * 8) * 2) = pre[i]; }
        if (g != g_staged) {
#pragma unroll
            for (int i = 0; i < 4; ++i) { const int p = tid + i * NTHR, r = p >> 4, cc = p & 15; *(LAS u32x4*)(lds + WS_OFF + (r * VVP + cc * 8) * 2) = *(const u32x4*)(WSPb + ((size_t)g * 128 + r) * 128 + cc * 8); }
            g_staged = g;
        }
        __syncthreads();
        if (item + (int)gridDim.x < 2048) GM_LOAD(item + gridDim.x);
        bf16x8 af[4];
#pragma unroll
        for (int kap = 0; kap < 4; ++kap) af[kap] = mlm::frag_tr(lds + VV_OFF + ((32 * kap + 8 * fq + q_) * VVP + 16 * wave + 4 * p_) * 2, VVP * 2);
#pragma unroll
        for (int th = 0; th < 8; ++th) {
            f32x4 acc = (f32x4){0.f, 0.f, 0.f, 0.f};
#pragma unroll
            for (int kap = 0; kap <= (th >> 1); ++kap) acc = __builtin_amdgcn_mfma_f32_16x16x32_bf16(af[kap], *(const LAS bf16x8*)(lds + WS_OFF + ((16 * th + fr) * VVP + 32 * kap + 8 * fq) * 2), acc, 0, 0, 0);
            const int t = 16 * th + fr; const float bs = BSP[g * 128 + t];
            bf16_t* gu = PROJ + (t0 + t) * PROJW + 2 * DM + g * 128 + 16 * wave + 4 * fq;
            const u32x2 w = *(const u32x2*)gu; u32x2 o;
            o.x = mlm::cvtpk(bflo(w.x) * (acc.x + bs), bfhi(w.x) * (acc.y + bs)); o.y = mlm::cvtpk(bflo(w.y) * (acc.z + bs), bfhi(w.y) * (acc.w + bs));
            *(u32x2*)gu = o;
        }
        __syncthreads();
    }
#undef GM_LOAD
}

__device__ void p4_ym(const Params& P, LAS unsigned char*) {
    const int tid = threadIdx.x, lane = tid & 63, wave = tid >> 6, h = wave & 3, half = wave >> 2;
    bf16_t* PROJ = (bf16_t*)(P.ws + WS_PROJ); const bf16_t* HM = (const bf16_t*)(P.ws + WS_XN);
    const int ch = h * 256 + lane * 4;
    float cw[4][4], cb[4], ng[4], sk[4];
#pragma unroll
    for (int j = 0; j < 4; ++j)
#pragma unroll
        for (int d = 0; d < 4; ++d) cw[j][d] = P.in[I_CONV_W][j * DM + ch + d];
#pragma unroll
    for (int d = 0; d < 4; ++d) { cb[d] = P.in[I_CONV_B][ch + d]; ng[d] = P.in[I_M_NORM_G][ch + d]; sk[d] = P.in[I_M_SKIP][ch + d]; }
    for (int item = blockIdx.x; item < NTOK / 16; item += gridDim.x) {
        const int tb = item * 16 + half * 8;
        float x0[4], x1[4], x2[4], x3[4];
        if ((tb & (SEQ - 1)) == 0) {
#pragma unroll
            for (int d = 0; d < 4; ++d) { x0[d] = 0.f; x1[d] = 0.f; x2[d] = 0.f; }
        } else { ld4(PROJ + (size_t)(tb - 3) * PROJW + ch, x0); ld4(PROJ + (size_t)(tb - 2) * PROJW + ch, x1); ld4(PROJ + (size_t)(tb - 1) * PROJW + ch, x2); }
#pragma unroll 1
        for (int i = 0; i < 8; ++i) {
            const int t = tb + i;
            ld4(PROJ + (size_t)t * PROJW + ch, x3);
            float hm[4], sz[4], y[4];
            ld4(HM + (size_t)t * DM + ch, hm); ld4(PROJ + (size_t)t * PROJW + DM + ch, sz);
            const float mu = wave_sum(hm[0] + hm[1] + hm[2] + hm[3]) * (1.f / 256.f);
            float s2 = 0.f;
#pragma unroll
            for (int d = 0; d < 4; ++d) { hm[d] -= mu; s2 += hm[d] * hm[d]; }
            const float r = 1.0f / sqrtf(wave_sum(s2) * (1.f / 256.f) + EPS);
#pragma unroll
            for (int d = 0; d < 4; ++d) { const float mc = siluf_(cw[0][d] * x0[d] + cw[1][d] * x1[d] + cw[2][d] * x2[d] + cw[3][d] * x3[d] + cb[d]);
                y[d] = (hm[d] * r * ng[d] + sk[d] * mc) * sz[d]; }
            st4(PROJ + (size_t)t * PROJW + DM + ch, y);
#pragma unroll
            for (int d = 0; d < 4; ++d) { x0[d] = x1[d]; x1[d] = x2[d]; x2[d] = x3[d]; }
        }
    }
}

__device__ void norm_pass(const float* xi, const float* y, const float* g1, float* xo, const float* g2, bf16_t* hn, int ldh, int hoff, const float* pin) {
    const int tid = threadIdx.x, lane = tid & 63, wave = tid >> 6;
    const int gw = blockIdx.x * NWAVES + wave, NGW = gridDim.x * NWAVES;
    for (int m = gw; m < NTOK; m += NGW) {
        const f32x4* yr = (const f32x4*)(y + (size_t)m * DM) + lane; const f32x4* xr = (const f32x4*)(xi + (size_t)m * DM) + lane; f32x4* orow = (f32x4*)(xo + (size_t)m * DM) + lane;
        f32x4 v[4]; float s = 0.f;
#pragma unroll
        for (int j = 0; j < 4; ++j) { v[j] = yr[64 * j]; s += (v[j].x * v[j].x + v[j].y * v[j].y) + (v[j].z * v[j].z + v[j].w * v[j].w); }
        const float r = 1.0f / sqrtf(wave_sum(s) * (1.f / DM) + EPS); float s2 = 0.f;
#pragma unroll
        for (int j = 0; j < 4; ++j) { const f32x4 gv = ((const f32x4*)g1 + lane)[64 * j]; v[j] = xr[64 * j] + v[j] * r * gv; orow[64 * j] = v[j];
            s2 += (v[j].x * v[j].x + v[j].y * v[j].y) + (v[j].z * v[j].z + v[j].w * v[j].w); }
        if (hn) {
            const float r2 = 1.0f / sqrtf(wave_sum(s2) * (1.f / DM) + EPS);
            u32x2* o8 = (u32x2*)(hn + (size_t)m * ldh + hoff) + lane;
#pragma unroll
            for (int j = 0; j < 4; ++j) { const f32x4 gv = ((const f32x4*)g2 + lane)[64 * j]; u32x2 o; o.x = pk2(v[j].x * r2 * gv.x, v[j].y * r2 * gv.y); o.y = pk2(v[j].z * r2 * gv.z, v[j].w * r2 * gv.w); o8[64 * j] = o; }
            if (pin) { const f32x4 pv = ((const f32x4*)(pin + (size_t)m * PLE))[lane]; u32x2 o; o.x = pk2(pv.x, pv.y); o.y = pk2(pv.z, pv.w); ((u32x2*)(hn + (size_t)m * ldh))[lane] = o; }
        }
    }
}

#define XB_TMO      128
#define XB_XCNT(j)  (256  + 64 * (j))
#define XB_XSUB(j)  (1280 + 64 * (j))
#define XB_XGEN(j)  (2304 + 64 * (j))
#define XB_TOP      3328
#define XB_TOPGEN   3392
#define XCD_BAR_WORDS 3456
#define XB_SPIN_CAP (1u << 20)
__device__ __forceinline__ unsigned xb_ld(unsigned* p)              { return __hip_atomic_load(p, __ATOMIC_RELAXED, __HIP_MEMORY_SCOPE_AGENT); }
__device__ __forceinline__ unsigned xb_add(unsigned* p, unsigned v) { return __hip_atomic_fetch_add(p, v, __ATOMIC_RELAXED, __HIP_MEMORY_SCOPE_AGENT); }
__device__ __forceinline__ unsigned xb_xcc_id() { return (unsigned)__builtin_amdgcn_s_getreg((3 << 11) | 20) & 0xFu; }
#define XB_SPIN(cond, bar) do { unsigned _sp = 0; while (cond) { __builtin_amdgcn_s_sleep(1); \
    if ((++_sp & 255u) == 0u) { if (xb_ld(&(bar)[XB_TMO])) break; if (_sp > XB_SPIN_CAP) { atomicAdd(&(bar)[XB_TMO], 1u); break; } } } } while (0)
struct XcdBarrier { unsigned* bar; unsigned x; volatile LAS unsigned* st; };
__device__ __forceinline__ XcdBarrier xcd_barrier_post(unsigned* bar, volatile LAS unsigned* st) {
    XcdBarrier b; b.bar = bar; b.x = xb_xcc_id(); b.st = st;
    if (threadIdx.x == 0) (void)xb_add(&bar[XB_XCNT(b.x)], 1u);
    return b;
}
__device__ __forceinline__ void xcd_barrier_complete(unsigned* bar, unsigned x, unsigned& nloc, unsigned& nx) {
    const unsigned G = gridDim.x * gridDim.y * gridDim.z;
    unsigned sum, cnt, mine, sp = 0u;
    for (;;) {
        sum = 0u; cnt = 0u; mine = 0u;
#pragma unroll
        for (unsigned j = 0; j < 16; ++j) { const unsigned c = xb_ld(&bar[XB_XCNT(j)]); sum += c; cnt += (c > 0u) ? 1u : 0u; mine = (j == x) ? c : mine; }
        if (sum == G) break;
        __builtin_amdgcn_s_sleep(1);
        if ((++sp & 255u) == 0u) { if (xb_ld(&bar[XB_TMO])) break; if (sp > XB_SPIN_CAP) { atomicAdd(&bar[XB_TMO], 1u); break; } }
    }
    nloc = mine > 0u ? mine : 1u; nx = cnt > 0u ? cnt : 1u;
}
__device__ __forceinline__ void xcd_barrier(const XcdBarrier& b) {
    asm volatile("s_waitcnt vmcnt(0)" ::: "memory");
    __syncthreads();
    if (threadIdx.x == 0) {
        unsigned* bar = b.bar;
        __builtin_amdgcn_s_waitcnt(0);
        unsigned nloc = b.st[0], nx = b.st[1];
        if (nloc == 0u) { xcd_barrier_complete(bar, b.x, nloc, nx); b.st[0] = nloc; b.st[1] = nx; }
        const unsigned old = xb_add(&bar[XB_XSUB(b.x)], 1u);
        const unsigned gen = old / nloc;
        if (old + 1u == (gen + 1u) * nloc) {
            __builtin_amdgcn_fence(__ATOMIC_RELEASE, "agent");
            asm volatile("s_waitcnt vmcnt(0)" ::: "memory");
            const unsigned og = xb_add(&bar[XB_TOP], 1u);
            const unsigned tg = og / nx;
            if (og + 1u == (tg + 1u) * nx) xb_add(&bar[XB_TOPGEN], 1u);
            else XB_SPIN(xb_ld(&bar[XB_TOPGEN]) == tg, bar);
            __builtin_amdgcn_fence(__ATOMIC_ACQUIRE, "agent");
            xb_add(&bar[XB_XGEN(b.x)], 1u);
            asm volatile("s_waitcnt vmcnt(0)" ::: "memory");
        } else {
            XB_SPIN(xb_ld(&bar[XB_XGEN(b.x)]) == gen, bar);
            __builtin_amdgcn_fence(__ATOMIC_ACQUIRE, "agent");
            asm volatile("s_waitcnt vmcnt(0)" ::: "memory");
        }
    }
    __syncthreads();
}

#ifndef MEGA
#define MEGA 1
#endif
namespace cg = cooperative_groups;
constexpr int NPHASE = 13;
constexpr int LDS_BYTES = 160 * 1024 - 1024;
constexpr int MISC_OFF = LDS_BYTES - 256;
constexpr int CW_BAR = 4096;
constexpr size_t CTL_ZERO_BYTES = 64 * 1024;
#ifndef USE_CG_SYNC
#define USE_CG_SYNC 0
#endif
static_assert(ML_BYTES <= LDS_BYTES && pg8::STAGE_BYTES <= LDS_BYTES && mlm::BYTES <= MISC_OFF && ML_BYTES <= MISC_OFF && (CW_BAR + XCD_BAR_WORDS) * 4 <= (int)CTL_ZERO_BYTES, "lds");

template <int LO, int HI> __global__ void __launch_bounds__(NTHR, 2) fwd_kernel(Params P) {
    extern __shared__ __attribute__((aligned(16))) unsigned char lds_raw[];
    LAS unsigned char* lds = (LAS unsigned char*)lds_raw;
    unsigned char* ws = P.ws;
    bf16_t* PROJ = (bf16_t*)(ws + WS_PROJ); bf16_t* XN = (bf16_t*)(ws + WS_XN); bf16_t* HB = (bf16_t*)(ws + WS_HB); float* Y = (float*)(ws + WS_Y);
    const int G = gridDim.x, bid = blockIdx.x;
#define IN(k) (LO <= (k) && (k) < HI)
#if USE_CG_SYNC
#define SEAM(k) do { if (IN(k) && IN((k) + 1)) cg::this_grid().sync(); } while (0)
#else
    if (HI - LO > 1) { volatile LAS unsigned* misc = (volatile LAS unsigned*)(lds + MISC_OFF); if (threadIdx.x < 2) misc[threadIdx.x] = 0u; __syncthreads(); (void)xcd_barrier_post((unsigned*)(P.ws + WS_CTL) + CW_BAR, misc); }
#define SEAM(k) do { if (IN(k) && IN((k) + 1)) { XcdBarrier xb_; xb_.bar = (unsigned*)(P.ws + WS_CTL) + CW_BAR; xb_.x = xb_xcc_id(); xb_.st = (volatile LAS unsigned*)((LAS unsigned char*)lds_raw + MISC_OFF); xcd_barrier(xb_); } } while (0)
#endif
    if (IN(0)) p0_prologue(P, lds);
    SEAM(0);
    if (IN(1)) { pg8::Gemm g{XN, (const bf16_t*)(ws + WS_WIN), DM, DM, NTOK, PROJW, DM}; pg8::StaticOrder S; S.init(NTOK, PROJW, G, bid);
        pg8::Epi8<ProjF> E{ProjF{PROJ}}; pg8::gemm_phase<pg8::Epi8<ProjF>, -1, true>(lds, g, S, E); }
    SEAM(1);
    if (IN(2)) p2_qkv(P, lds);
    SEAM(2);
    if (IN(3)) { p3_mlstm_mfma(P, lds); __syncthreads(); p3_gmlp_mfma(P, lds); }
    SEAM(3);
    if (IN(4)) p4_ym(P, lds);
    SEAM(4);
    if (IN(5)) { pg8::Gemm g{PROJ + DM, (const bf16_t*)(ws + WS_WBR), PROJW, 2 * DM, NTOK, DM, 2 * DM}; pg8::StaticOrder S; S.init(NTOK, DM, G, bid);
        pg8::Epi8<MergeF> E{MergeF{PROJ, XN}}; pg8::gemm_phase<pg8::Epi8<MergeF>, 16, true>(lds, g, S, E); }
    SEAM(5);
    if (IN(6)) { pg8::Gemm g{XN, (const bf16_t*)(ws + WS_WOUT), DM, DM, NTOK, DM, DM}; pg8::StaticOrder S; S.init(NTOK, DM, G, bid);
        pg8::Epi4<F32F> E{F32F{Y, DM}}; pg8::gemm_phase<pg8::Epi4<F32F>, -1, true>(lds, g, S, E); }
    SEAM(6);
    if (IN(7)) norm_pass(P.in[I_X], Y, P.in[I_MIX_POST_G], P.out, P.in[I_MLP_PRE_G], XN, DM, 0, nullptr);
    SEAM(7);
    if (IN(8)) { pg8::Gemm g{XN, (const bf16_t*)(ws + WS_WUP), DM, DM, NTOK, DFF, DM}; pg8::StaticOrder S; S.init(NTOK, DFF, G, bid);
        pg8::Epi8<Relu2F> E{Relu2F{HB, DFF}}; pg8::gemm_phase<pg8::Epi8<Relu2F>, -1, true>(lds, g, S, E); }
    SEAM(8);
    if (IN(9)) { pg8::Gemm g{HB, (const bf16_t*)(ws + WS_WDN), DFF, DFF, NTOK, DM, DFF}; pg8::StaticOrder S; S.init(NTOK, DM, G, bid);
        pg8::Epi4<F32F> E{F32F{Y, DM}}; pg8::gemm_phase<pg8::Epi4<F32F>, -1, true>(lds, g, S, E); }
    SEAM(9);
    if (IN(10)) norm_pass(P.out, Y, P.in[I_MLP_POST_G], P.out, P.in[I_PLE_PRE_G], HB, PLEK, PLE, P.in[I_P]);
    SEAM(10);
    if (IN(11)) { pg8::Gemm g{HB, (const bf16_t*)(ws + WS_WPLE), PLEK, PLEK, NTOK, DM, PLEK}; pg8::StaticOrder S; S.init(NTOK, DM, G, bid);
        pg8::Epi4<PleF> E{PleF{Y, (f32x4*)(ws + WS_XN)}}; pg8::gemm_phase<pg8::Epi4<PleF>, 4, true>(lds, g, S, E); }
    SEAM(11);
    if (IN(12)) norm_pass(P.out, Y, P.in[I_PLE_POST_G], P.out, nullptr, nullptr, 0, 0, nullptr);
#undef IN
#undef SEAM
}

template <int LO, int HI> static void launch_range(const Params& P, int grid, hipStream_t stream, bool coop) {
    static bool attr = false;
    if (!attr) { (void)hipFuncSetAttribute((const void*)fwd_kernel<LO, HI>, hipFuncAttributeMaxDynamicSharedMemorySize, LDS_BYTES); attr = true; }
    if (coop) {
        Params p = P; void* args[] = {&p};
        const hipError_t e = hipLaunchCooperativeKernel((const void*)fwd_kernel<LO, HI>, dim3(grid), dim3(NTHR), args, LDS_BYTES, stream);
        if (e != hipSuccess) fprintf(stderr, "cooperative launch failed: %s (grid %d)\n", hipGetErrorString(e), grid);
    } else hipLaunchKernelGGL((fwd_kernel<LO, HI>), dim3(grid), dim3(NTHR), LDS_BYTES, stream, P);
}
template <int I> static void launch_each(const Params& P, int grid, hipStream_t stream) {
    if constexpr (I < NPHASE) { launch_range<I, I + 1>(P, grid, stream, false); launch_each<I + 1>(P, grid, stream); }
}

extern "C" void kernel_launch(void* const* d_in, const int* in_sizes, int n_in, void* d_out, int out_size, void* d_ws, size_t ws_size, hipStream_t stream) {
    if (n_in != 29 || out_size != NTOK * DM || ws_size < WS_END) { fprintf(stderr, "kernel_launch: unexpected shapes (n_in %d out %d ws %zu)\n", n_in, out_size, ws_size); return; }
    Params P{};
    for (int i = 0; i < 29; ++i) P.in[i] = (const float*)d_in[i];
    P.out = (float*)d_out; P.ws = (unsigned char*)d_ws;
#if MEGA
    static int grid = 0;
    if (!grid) {
        int dev = 0, cus = 0, per_cu = 0;
        (void)hipGetDevice(&dev); (void)hipDeviceGetAttribute(&cus, hipDeviceAttributeMultiprocessorCount, dev);
        (void)hipFuncSetAttribute((const void*)fwd_kernel<0, NPHASE>, hipFuncAttributeMaxDynamicSharedMemorySize, LDS_BYTES);
        (void)hipOccupancyMaxActiveBlocksPerMultiprocessor(&per_cu, (const void*)fwd_kernel<0, NPHASE>, NTHR, LDS_BYTES);
        if (per_cu < 1) per_cu = 1;
        grid = cus;
        if (grid > cus * per_cu) grid = cus * per_cu;
    }
    (void)hipMemsetAsync((char*)d_ws + WS_CTL, 0, CTL_ZERO_BYTES, stream);
    launch_range<0, NPHASE>(P, grid, stream, true);
#else
    launch_each<0>(P, 256, stream);
#endif
}
```

```cpp
#include <hip/hip_runtime.h>
#include <hip/hip_cooperative_groups.h>
#include <cstdio>
#include <cstdint>
#include <cmath>

#define LAS __attribute__((address_space(3)))
typedef unsigned short bf16_t;
typedef short bf16x8 __attribute__((ext_vector_type(8)));
typedef float f32x4 __attribute__((ext_vector_type(4)));
typedef unsigned u32x4 __attribute__((ext_vector_type(4)));
typedef unsigned u32x2 __attribute__((ext_vector_type(2)));

constexpr int NTOK = 32768, DM = 1024, SEQ = 2048, PROJW = 6144, DFF = 4096, PLE = 256, PLEK = PLE + DM;
constexpr float EPS = 1e-6f;
constexpr int NWAVES = 8, NTHR = 512;
constexpr size_t MiB = 1u << 20;
constexpr size_t WS_CTL = 0;
constexpr size_t WS_WIN = 1 * MiB;
constexpr size_t WS_WBR = 13 * MiB;
constexpr size_t WS_WOUT = 17 * MiB;
constexpr size_t WS_WUP = 19 * MiB;
constexpr size_t WS_WDN = 27 * MiB;
constexpr size_t WS_WPLE = 35 * MiB;
constexpr size_t WS_WCX = 38 * MiB;
constexpr size_t WS_WSP = 38 * MiB + 256 * 1024;
constexpr size_t WS_GATES = 39 * MiB;
constexpr size_t WS_XN = 40 * MiB;
constexpr size_t WS_PROJ = 104 * MiB;
constexpr size_t WS_HB = WS_PROJ;
constexpr size_t WS_Y = WS_PROJ + 256 * MiB;
constexpr size_t WS_END = 488 * MiB;

struct Params {
    const float* in[29];
    float* out;
    unsigned char* ws;
};
enum { I_X = 0, I_P, I_MIX_PRE_G, I_W_IN, I_CONV_W, I_CONV_B, I_WQ, I_WK, I_WV, I_W_IF, I_B_IF, I_M_NORM_G, I_M_SKIP, I_G_LN_W, I_G_LN_B, I_W_SP, I_B_SP,
       I_W_BR_M, I_W_BR_G, I_W_OUT, I_MIX_POST_G, I_MLP_PRE_G, I_W_UP, I_W_DOWN, I_MLP_POST_G, I_PLE_PRE_G, I_W_PLE_GATE, I_W_PLE_PROJ, I_PLE_POST_G };

__device__ __forceinline__ unsigned f2bf(float f) { unsigned u = __builtin_bit_cast(unsigned, f); return (u + 0x7fffu + ((u >> 16) & 1u)) >> 16; }
typedef float f32x2_t_ __attribute__((ext_vector_type(2)));
typedef __bf16 bf16x2_t_ __attribute__((ext_vector_type(2)));
__device__ __forceinline__ unsigned pk2(float lo, float hi) { f32x2_t_ v = {lo, hi}; bf16x2_t_ b = __builtin_convertvector(v, bf16x2_t_); return __builtin_bit_cast(unsigned, b); }
__device__ __forceinline__ float bflo(unsigned w) { return __builtin_bit_cast(float, w << 16); }
__device__ __forceinline__ float bfhi(unsigned w) { return __builtin_bit_cast(float, w & 0xffff0000u); }
__device__ __forceinline__ float bf2f(bf16_t h) { return __builtin_bit_cast(float, (unsigned)h << 16); }
__device__ __forceinline__ float sigmoidf_(float x) { return __builtin_amdgcn_rcpf(1.0f + __builtin_amdgcn_exp2f(-1.4426950408889634f * x)); }
__device__ __forceinline__ float siluf_(float x) { return x * sigmoidf_(x); }
__device__ __forceinline__ float gelu_tanh(float x) { const float z = 0.7978845608028654f * (x + 0.044715f * x * x * x); return x * sigmoidf_(2.0f * z); }
__device__ __forceinline__ float log_sigmoid(float x) { return fminf(x, 0.f) - log1pf(expf(-fabsf(x))); }
__device__ __forceinline__ float wave_sum(float v) {
#pragma unroll
    for (int o = 1; o < 64; o <<= 1) v += __shfl_xor(v, o);
    return v;
}
#define LDS_WAIT() asm volatile("s_waitcnt lgkmcnt(0)" ::: "memory")

template <bool GATE_REMAP = false>
__device__ __forceinline__ void transpose_item(const float* W, int K, int N, bf16_t* WT, int ldw, int koff, LAS float* scr, int item, int lane) {
    const int nblk = N / 32, kb = item / nblk, nb = item % nblk, k0 = 64 * kb, n0 = 32 * nb;
    int r0 = n0; if (GATE_REMAP && n0 >= 4 * DM) { const int g = n0 - 4 * DM, j = g & (DM - 1); r0 = 4 * DM + (j >> 7) * 256 + (g >= DM ? 128 : 0) + (j & 127); }
#pragma unroll 8
    for (int i = 0; i < 32; ++i) { const int kk = 2 * i + (lane >> 5); scr[kk * 33 + (lane & 31)] = W[(size_t)(k0 + kk) * N + n0 + (lane & 31)]; }
    LDS_WAIT();
    const int c = lane & 7;
#pragma unroll
    for (int j = 0; j < 4; ++j) { const int n = (lane >> 3) + 8 * j; const LAS float* s = scr + (8 * c) * 33 + n;
        u32x4 o; o.x = pk2(s[0 * 33], s[1 * 33]); o.y = pk2(s[2 * 33], s[3 * 33]); o.z = pk2(s[4 * 33], s[5 * 33]); o.w = pk2(s[6 * 33], s[7 * 33]);
        *(u32x4*)(WT + (size_t)(r0 + n) * ldw + koff + k0 + 8 * c) = o; }
    LDS_WAIT();
}
__device__ __forceinline__ void rms_row_to_bf16(const float* xrow, const float* g, bf16_t* orow, int lane) {
    const f32x4* xr = (const f32x4*)xrow + lane; const f32x4* gr = (const f32x4*)g + lane;
    f32x4 v[4]; float s = 0.f;
#pragma unroll
    for (int j = 0; j < 4; ++j) { v[j] = xr[64 * j]; s += (v[j].x * v[j].x + v[j].y * v[j].y) + (v[j].z * v[j].z + v[j].w * v[j].w); }
    const float r = 1.0f / sqrtf(wave_sum(s) * (1.f / DM) + EPS);
    u32x2* o8 = (u32x2*)orow + lane;
#pragma unroll
    for (int j = 0; j < 4; ++j) { const f32x4 gv = gr[64 * j]; u32x2 o; o.x = pk2(v[j].x * r * gv.x, v[j].y * r * gv.y); o.y = pk2(v[j].z * r * gv.z, v[j].w * r * gv.w); o8[64 * j] = o; }
}
__device__ void p0_prologue(const Params& P, LAS unsigned char* lds) {
    const int tid = threadIdx.x, lane = tid & 63, wave = tid >> 6;
    LAS float* scr = (LAS float*)(lds + wave * 16384);
    const int gw = blockIdx.x * NWAVES + wave, NGW = gridDim.x * NWAVES;
    unsigned char* ws = P.ws;
    constexpr int I_IN = 16 * 192, I_SQ = 16 * 32, I_UP = 16 * 128, I_DN = 64 * 32, I_PP = 4 * 32;
    constexpr int NIT = I_IN + 4 * I_SQ + I_UP + I_DN + I_PP;
    for (int it = gw; it < NIT; it += NGW) {
        int r = it;
        if (r < I_IN) { transpose_item<true>(P.in[I_W_IN], DM, PROJW, (bf16_t*)(ws + WS_WIN), DM, 0, scr, r, lane); continue; } r -= I_IN;
        if (r < I_SQ) { transpose_item(P.in[I_W_BR_M], DM, DM, (bf16_t*)(ws + WS_WBR), 2 * DM, 0, scr, r, lane); continue; } r -= I_SQ;
        if (r < I_SQ) { transpose_item(P.in[I_W_BR_G], DM, DM, (bf16_t*)(ws + WS_WBR), 2 * DM, DM, scr, r, lane); continue; } r -= I_SQ;
        if (r < I_SQ) { transpose_item(P.in[I_W_OUT], DM, DM, (bf16_t*)(ws + WS_WOUT), DM, 0, scr, r, lane); continue; } r -= I_SQ;
        if (r < I_SQ) { transpose_item(P.in[I_W_PLE_GATE], DM, DM, (bf16_t*)(ws + WS_WPLE), PLEK, PLE, scr, r, lane); continue; } r -= I_SQ;
        if (r < I_UP) { transpose_item(P.in[I_W_UP], DM, DFF, (bf16_t*)(ws + WS_WUP), DM, 0, scr, r, lane); continue; } r -= I_UP;
        if (r < I_DN) { transpose_item(P.in[I_W_DOWN], DFF, DM, (bf16_t*)(ws + WS_WDN), DFF, 0, scr, r, lane); continue; } r -= I_DN;
        transpose_item(P.in[I_W_PLE_PROJ], PLE, DM, (bf16_t*)(ws + WS_WPLE), PLEK, 0, scr, r, lane);
    }
    {
        float* wcx = (float*)(ws + WS_WCX);
        const float* wq = P.in[I_WQ]; const float* wk = P.in[I_WK]; const float* wv = P.in[I_WV]; const float* wif = P.in[I_W_IF];
        for (int i = blockIdx.x * NTHR + tid; i < DM * 8; i += gridDim.x * NTHR) {
            const int c = i >> 3, j = i & 7, blk = c >> 2, d = c & 3; float sc = 0.f, sx = 0.f;
#pragma unroll
            for (int e = 0; e < 4; ++e) {
                sc += wq[blk * 16 + d * 4 + e] * wif[(size_t)(blk * 4 + e) * 8 + j] + wk[blk * 16 + d * 4 + e] * wif[(size_t)(DM + blk * 4 + e) * 8 + j];
                sx += wv[blk * 16 + d * 4 + e] * wif[(size_t)(2 * DM + blk * 4 + e) * 8 + j]; }
            wcx[i] = sc; wcx[DM * 8 + i] = sx;
        }
    }
    { bf16_t* wsp = (bf16_t*)(ws + WS_WSP); const float* w = P.in[I_W_SP];
      for (int i = blockIdx.x * NTHR + tid; i < 8 * 128 * 128; i += gridDim.x * NTHR) { const int t = (i >> 7) & 127, s = i & 127; wsp[i] = (bf16_t)f2bf(s <= t ? w[i] : 0.f); } }
    bf16_t* XN = (bf16_t*)(ws + WS_XN);
    for (int m = gw; m < NTOK; m += NGW) rms_row_to_bf16(P.in[I_X] + (size_t)m * DM, P.in[I_MIX_PRE_G], XN + (size_t)m * DM, lane);
}

namespace pg8 {
constexpr int BM = 256, BK = 64, HALF = 128, HTB = HALF * BK * 2, STAGE_BYTES = 8 * HTB, NXCD = 8, WGM = 8;
__host__ __device__ __forceinline__ int lds_byte(int r, int c) { const int st = (r >> 4) * 2 + (c >> 5), rr = r & 15, cc = c & 31, ob = rr * 64 + cc * 2; return st * 1024 + (ob ^ (((ob >> 9) & 1) << 5)); }
__host__ __device__ __forceinline__ void stage_rc(int b, int& R, int& C) { const int st = b / 1024, sb = b % 1024, swz = sb ^ (((sb >> 9) & 1) << 5); R = (st >> 1) * 16 + swz / 64; C = (st & 1) * 32 + (swz % 64) / 2; }
__host__ __device__ __forceinline__ int perm32(int rho) { const int n = rho >> 4, i = rho & 15; return 8 * (i >> 2) + 4 * n + (i & 3); }
struct Unit { int pm, pn; };
struct Gemm { const bf16_t* A; const bf16_t* Bt; int lda, ldb, M, N, K; };
struct StaticOrder {
    int nM, nN, nwg, G, c;
    __host__ __device__ void init(int M, int N, int G_, int c_) { nM = M / BM; nN = N / BM; nwg = nM * nN; G = G_; c = c_; }
    __host__ __device__ bool next(int i, Unit& u) const {
        const long L = (long)i * G + c; if (L >= nwg) return false;
        int wgid = (int)L; { const int q = nwg / NXCD, r = nwg % NXCD, xcd = wgid % NXCD, off = wgid / NXCD; wgid = (xcd < r ? xcd * (q + 1) : r * (q + 1) + (xcd - r) * q) + off; }
        const int nig = WGM * nN, gid = wgid / nig, fm = gid * WGM, gsz = (nM - fm) < WGM ? (nM - fm) : WGM;
        u.pm = fm + ((wgid % nig) % gsz); u.pn = (wgid % nig) / gsz; return true;
    }
};
template <class F> struct Epi8 {
    static constexpr bool PERM = true; F f;
    __device__ __forceinline__ void operator()(f32x4 (&acc)[2][2][4][2], const Unit& u_, int wr, int wc, int fr, int fq) const {
        Unit u = u_; asm volatile("" : "+s"(u.pm), "+s"(u.pn));
#pragma unroll
        for (int ai = 0; ai < 2; ++ai)
#pragma unroll
            for (int m = 0; m < 4; ++m)
                { f.store16(u.pm * BM + ai * HALF + wr * 64 + m * 16 + fr, u.pn, wc * 32 + 8 * fq, acc[ai][0][m][0], acc[ai][0][m][1], acc[ai][1][m][0], acc[ai][1][m][1]); asm volatile("" ::: "memory"); }
    }
    __device__ __forceinline__ void mid(f32x4 (&acc)[2][2][4][2], const Unit& u_, int wr, int wc, int fr, int fq) const {
        Unit u = u_; asm volatile("" : "+s"(u.pm), "+s"(u.pn));
#pragma unroll
        for (int ai = 0; ai < 2; ++ai)
#pragma unroll
            for (int m = 0; m < 4; ++m)
#pragma unroll
                for (int bj = 0; bj < 2; ++bj) { f.mid8(u.pm * BM + ai * HALF + wr * 64 + m * 16 + fr, u.pn * BM + bj * HALF + wc * 32 + 8 * fq, acc[ai][bj][m][0], acc[ai][bj][m][1]); asm volatile("" ::: "memory"); }
    }
};
template <class F> struct Epi4 {
    static constexpr bool PERM = false; F f;
    __device__ __forceinline__ void operator()(f32x4 (&acc)[2][2][4][2], const Unit& u_, int wr, int wc, int fr, int fq) const {
        Unit u = u_; asm volatile("" : "+s"(u.pm), "+s"(u.pn));
#pragma unroll
        for (int ai = 0; ai < 2; ++ai)
#pragma unroll
            for (int m = 0; m < 4; ++m)
#pragma unroll
                for (int bj = 0; bj < 2; ++bj)
#pragma unroll
                    for (int n = 0; n < 2; ++n) { f.store4(u.pm * BM + ai * HALF + wr * 64 + m * 16 + fr, u.pn * BM + bj * HALF + wc * 32 + 16 * n + 4 * fq, acc[ai][bj][m][n], ((ai * 4 + m) * 2 + bj) * 2 + n); if (n) asm volatile("" ::: "memory"); }
    }
    __device__ __forceinline__ void mid(f32x4 (&acc)[2][2][4][2], const Unit& u_, int wr, int wc, int fr, int fq) const {
        Unit u = u_; asm volatile("" : "+s"(u.pm), "+s"(u.pn));
#pragma unroll
        for (int ai = 0; ai < 2; ++ai)
#pragma unroll
            for (int m = 0; m < 4; ++m)
#pragma unroll
                for (int bj = 0; bj < 2; ++bj)
#pragma unroll
                    for (int n = 0; n < 2; ++n) { f.mid4(u.pm * BM + ai * HALF + wr * 64 + m * 16 + fr, u.pn * BM + bj * HALF + wc * 32 + 16 * n + 4 * fq, acc[ai][bj][m][n], ((ai * 4 + m) * 2 + bj) * 2 + n); if (n) asm volatile("" ::: "memory"); }
    }
};
template <class Epi, int HOOK_T, bool ALIGN_EPI>
__device__ __forceinline__ void gemm_phase(LAS unsigned char* lds, const Gemm g, const StaticOrder& S, const Epi& E) {
    int tid_ = threadIdx.x; asm volatile("" : "+v"(tid_));
    const int tid = tid_, wid = __builtin_amdgcn_readfirstlane(tid >> 6), lane = tid & 63, wr = wid >> 2, wc = wid & 3, fr = lane & 15, fq = lane >> 4;
    const int K = g.K, nt = K / BK;
    unsigned voffA[2], voffB[2];
#pragma unroll
    for (int i = 0; i < 2; ++i) { int R, C; stage_rc(tid * 16 + i * 8192, R, C); const int Rb = Epi::PERM ? ((R & ~31) + perm32(R & 31)) : R;
        voffA[i] = (unsigned)(R * g.lda + C) * 2u; voffB[i] = (unsigned)(Rb * g.ldb + C) * 2u; }
    const size_t kstep = (size_t)(BK * 2);
    const size_t hstepA = (size_t)HALF * g.lda * 2, hstepB = (size_t)HALF * g.ldb * 2;
    const size_t tstepA = 2 * hstepA, tstepB = 2 * hstepB;
    const unsigned ldsw = (unsigned)wid * 1024u;
    const int aoff = lds_byte(wr * 64 + fr, fq * 8), boff = lds_byte(wc * 32 + fr, fq * 8);
#define PG8_SA(b, h) (((b) * 2 + (h)) * HTB)
#define PG8_SB(b, h) ((4 + (b) * 2 + (h)) * HTB)
#define PG8_STAGE(bufoff, gbase, voff) do { _Pragma("unroll") for (int _i = 0; _i < 2; ++_i) \
        __builtin_amdgcn_global_load_lds((const unsigned*)((const char*)(gbase) + (voff)[_i]), (LAS unsigned*)(lds + (bufoff) + ldsw + _i * 8192), 16, 0, 0); } while (0)
#define PG8_LDA(dst, b, h) do { _Pragma("unroll") for (int m = 0; m < 4; ++m) _Pragma("unroll") for (int k = 0; k < 2; ++k) dst[m][k] = *(const LAS bf16x8*)(lds + PG8_SA(b, h) + aoff + m * 2048 + k * 1024); } while (0)
#define PG8_LDB(dst, b, h) do { _Pragma("unroll") for (int n = 0; n < 2; ++n) _Pragma("unroll") for (int k = 0; k < 2; ++k) dst[n][k] = *(const LAS bf16x8*)(lds + PG8_SB(b, h) + boff + n * 2048 + k * 1024); } while (0)
#define PG8_MMA(ai, bj, At, Bt) do { __builtin_amdgcn_s_setprio(1); _Pragma("unroll") for (int m = 0; m < 4; ++m) _Pragma("unroll") for (int n = 0; n < 2; ++n) _Pragma("unroll") for (int k = 0; k < 2; ++k) \
        acc[ai][bj][m][n] = __builtin_amdgcn_mfma_f32_16x16x32_bf16(Bt[n][k], At[m][k], acc[ai][bj][m][n], 0, 0, 0); __builtin_amdgcn_s_setprio(0); } while (0)
#define PG8_WAIT_V(n) asm volatile("s_waitcnt vmcnt(" #n ")" ::: "memory")
#define PG8_WAIT_L(n) asm volatile("s_waitcnt lgkmcnt(" #n ")" ::: "memory")
#define PG8_BAR __builtin_amdgcn_s_barrier()
#define PG8_SCHED __builtin_amdgcn_sched_barrier(0)
    Unit cur, nxt; int ui = 0;
    if (!S.next(0, cur)) return;
    f32x4 acc[2][2][4][2];
#pragma unroll
    for (int a = 0; a < 2; ++a)
#pragma unroll
        for (int b = 0; b < 2; ++b)
#pragma unroll
            for (int m = 0; m < 4; ++m)
#pragma unroll
                for (int n = 0; n < 2; ++n) acc[a][b][m][n] = (f32x4){0.f, 0.f, 0.f, 0.f};
    bf16x8 At[4][2], B0[2][2], B1[2][2];
    const char* cA = (const char*)g.A + (size_t)cur.pm * tstepA; const char* cB = (const char*)g.Bt + (size_t)cur.pn * tstepB;
    PG8_STAGE(PG8_SB(0, 0), cB, voffB); PG8_STAGE(PG8_SB(0, 1), cB + hstepB, voffB); PG8_STAGE(PG8_SA(0, 0), cA, voffA); PG8_STAGE(PG8_SA(0, 1), cA + hstepA, voffA);
    if (wr == 1) PG8_BAR;
    PG8_WAIT_V(2); PG8_BAR;
    PG8_STAGE(PG8_SB(1, 0), cB + kstep, voffB); PG8_STAGE(PG8_SA(1, 0), cA + kstep, voffA); PG8_STAGE(PG8_SB(1, 1), cB + hstepB + kstep, voffB);
    PG8_WAIT_V(6); PG8_BAR;
    for (;;) {
        const bool has_next = S.next(ui + 1, nxt);
        const char* nA = has_next ? (const char*)g.A + (size_t)nxt.pm * tstepA : cA; const char* nB = has_next ? (const char*)g.Bt + (size_t)nxt.pn * tstepB : cB;
#define PG8_KBODY() do { \
            const bool last = (t == nt - 2); \
            const char* a1 = cA + (size_t)(t + 1) * kstep; \
            const char* a2 = last ? nA : cA + (size_t)(t + 2) * kstep; const char* b2 = last ? nB : cB + (size_t)(t + 2) * kstep; \
            const char* a3 = a2 + kstep; const char* b3 = b2 + kstep; \
            PG8_LDB(B0, 0, 0); PG8_LDB(B1, 0, 1); PG8_SCHED; PG8_LDA(At, 0, 0); PG8_STAGE(PG8_SA(1, 1), a1 + hstepA, voffA); \
            PG8_WAIT_V(8); PG8_WAIT_L(0); PG8_BAR; PG8_MMA(0, 0, At, B0); PG8_MMA(0, 1, At, B1); PG8_BAR; PG8_SCHED; \
            PG8_LDA(At, 0, 1); PG8_STAGE(PG8_SB(0, 0), b2, voffB); PG8_STAGE(PG8_SB(0, 1), b2 + hstepB, voffB); PG8_STAGE(PG8_SA(0, 0), a2, voffA); \
            PG8_WAIT_V(8); PG8_WAIT_L(0); PG8_BAR; PG8_MMA(1, 0, At, B0); PG8_MMA(1, 1, At, B1); PG8_BAR; PG8_SCHED; \
            PG8_LDB(B0, 1, 0); PG8_LDB(B1, 1, 1); PG8_SCHED; PG8_LDA(At, 1, 0); PG8_STAGE(PG8_SA(0, 1), a2 + hstepA, voffA); \
            PG8_WAIT_V(8); PG8_WAIT_L(0); PG8_BAR; PG8_MMA(0, 0, At, B0); PG8_MMA(0, 1, At, B1); PG8_BAR; PG8_SCHED; \
            PG8_LDA(At, 1, 1); PG8_STAGE(PG8_SB(1, 0), b3, voffB); PG8_STAGE(PG8_SB(1, 1), b3 + hstepB, voffB); PG8_STAGE(PG8_SA(1, 0), a3, voffA); \
            PG8_WAIT_V(8); PG8_WAIT_L(0); PG8_BAR; PG8_MMA(1, 0, At, B0); PG8_MMA(1, 1, At, B1); PG8_BAR; PG8_SCHED; \
        } while (0)
        int t = 0;
        if constexpr (HOOK_T > 0) {
            for (; t < HOOK_T; t += 2) PG8_KBODY();
            PG8_SCHED; E.mid(acc, cur, wr, wc, fr, fq); PG8_SCHED;
        }
        for (; t < nt; t += 2) PG8_KBODY();
#undef PG8_KBODY
        if constexpr (ALIGN_EPI) { if (wr == 0) PG8_BAR; }
        E(acc, cur, wr, wc, fr, fq);
        if (!has_next) break;
#pragma unroll
        for (int a = 0; a < 2; ++a)
#pragma unroll
            for (int b = 0; b < 2; ++b)
#pragma unroll
                for (int m = 0; m < 4; ++m)
#pragma unroll
                    for (int n = 0; n < 2; ++n) acc[a][b][m][n] = (f32x4){0.f, 0.f, 0.f, 0.f};
        cur = nxt; cA = nA; cB = nB; ++ui;
        if constexpr (ALIGN_EPI) { if (wr == 1) PG8_BAR; }
    }
    PG8_WAIT_V(0);
    if constexpr (!ALIGN_EPI) { if (wr == 0) PG8_BAR; }
    PG8_BAR;
#undef PG8_SA
#undef PG8_SB
#undef PG8_STAGE
#undef PG8_LDA
#undef PG8_LDB
#undef PG8_MMA
#undef PG8_WAIT_V
#undef PG8_WAIT_L
#undef PG8_BAR
#undef PG8_SCHED
}
}
__device__ __forceinline__ void st_bf16x8(bf16_t* p, f32x4 a, f32x4 b) { u32x4 o; o.x = pk2(a.x, a.y); o.y = pk2(a.z, a.w); o.z = pk2(b.x, b.y); o.w = pk2(b.z, b.w); *(u32x4*)p = o; }
__device__ __forceinline__ void ld_bf16x8(const bf16_t* p, f32x4& a, f32x4& b) { const u32x4 w = *(const u32x4*)p; a = (f32x4){bflo(w.x), bfhi(w.x), bflo(w.y), bfhi(w.y)}; b = (f32x4){bflo(w.z), bfhi(w.z), bflo(w.w), bfhi(w.w)}; }
template <class FN> __device__ __forceinline__ f32x4 map4(f32x4 v, FN fn) { return (f32x4){fn(v.x), fn(v.y), fn(v.z), fn(v.w)}; }
struct ProjF {
    bf16_t* proj;
    __device__ __forceinline__ void store16(int row, int pn, int cl, f32x4 a0, f32x4 a1, f32x4 b0, f32x4 b1) const {
        bf16_t* rp = proj + (size_t)row * PROJW;
        if (pn < 16) {
            const int sec = pn >> 2;
            if (sec == 1) { a0 = map4(a0, siluf_); a1 = map4(a1, siluf_); b0 = map4(b0, siluf_); b1 = map4(b1, siluf_); }
            else if (sec >= 2) { a0 = map4(a0, gelu_tanh); a1 = map4(a1, gelu_tanh); b0 = map4(b0, gelu_tanh); b1 = map4(b1, gelu_tanh); }
            st_bf16x8(rp + pn * 256 + cl, a0, a1); st_bf16x8(rp + pn * 256 + 128 + cl, b0, b1);
        } else {
            const int j = (pn - 16) * 128 + cl;
            a0 = map4(a0, sigmoidf_); a1 = map4(a1, sigmoidf_); b0 = map4(b0, sigmoidf_); b1 = map4(b1, sigmoidf_);
            st_bf16x8(rp + 4 * DM + j, a0 / b0, a1 / b1); st_bf16x8(rp + 5 * DM + j, b0, b1);
        }
    }
    __device__ __forceinline__ void mid8(int, int, f32x4&, f32x4&) const {}
};
struct MergeF {
    const bf16_t* proj; bf16_t* merged;
    __device__ __forceinline__ void mid8(int row, int col, f32x4& a, f32x4& b) const {
        f32x4 r0, r1; ld_bf16x8(proj + (size_t)row * PROJW + 4 * DM + col, r0, r1); a = a * r0; b = b * r1;
    }
    __device__ __forceinline__ void store16(int row, int pn, int cl, f32x4 a0, f32x4 a1, f32x4 b0, f32x4 b1) const {
        const int col = pn * 256 + cl; f32x4 g0, g1;
        ld_bf16x8(proj + (size_t)row * PROJW + 5 * DM + col, g0, g1); st_bf16x8(merged + (size_t)row * DM + col, a0 * g0, a1 * g1);
        ld_bf16x8(proj + (size_t)row * PROJW + 5 * DM + col + 128, g0, g1); st_bf16x8(merged + (size_t)row * DM + col + 128, b0 * g0, b1 * g1);
    }
};
struct F32F {
    float* o; int ldc;
    __device__ __forceinline__ void store4(int row, int col, f32x4 v, int) const { *(f32x4*)(o + (size_t)row * ldc + col) = v; }
    __device__ __forceinline__ void mid4(int, int, f32x4&, int) const {}
};
struct Relu2F {
    bf16_t* o; int ldc;
    __device__ __forceinline__ void store16(int row, int pn, int cl, f32x4 a0, f32x4 a1, f32x4 b0, f32x4 b1) const {
        auto r2 = [](float x) { const float r = fmaxf(x, 0.f); return r * r; };
        bf16_t* p = o + (size_t)row * ldc + pn * 256 + cl;
        st_bf16x8(p, map4(a0, r2), map4(a1, r2)); st_bf16x8(p + 128, map4(b0, r2), map4(b1, r2));
    }
    __device__ __forceinline__ void mid8(int, int, f32x4&, f32x4&) const {}
};
struct PleF {
    float* o; f32x4* stash;
    __device__ __forceinline__ void mid4(int, int, f32x4& v, int idx) const { unsigned t = threadIdx.x; asm volatile("" : "+v"(t)); stash[((size_t)blockIdx.x * 32 + idx) * NTHR + t] = v; v = (f32x4){0.f, 0.f, 0.f, 0.f}; }
    __device__ __forceinline__ void store4(int row, int col, f32x4 v, int idx) const {
        unsigned t = threadIdx.x; asm volatile("" : "+v"(t)); const f32x4 p = stash[((size_t)blockIdx.x * 32 + idx) * NTHR + t];
        *(f32x4*)(o + (size_t)row * DM + col) = map4(v, sigmoidf_) * p;
    }
};

__device__ __forceinline__ void ld4(const bf16_t* p, float (&x)[4]) { const u32x2 w = *(const u32x2*)p; x[0] = bflo(w.x); x[1] = bfhi(w.x); x[2] = bflo(w.y); x[3] = bfhi(w.y); }
__device__ __forceinline__ void up4(u32x2 w, float (&x)[4]) { x[0] = bflo(w.x); x[1] = bfhi(w.x); x[2] = bflo(w.y); x[3] = bfhi(w.y); }
__device__ __forceinline__ void st4(bf16_t* p, const float (&x)[4]) { u32x2 o; o.x = pk2(x[0], x[1]); o.y = pk2(x[2], x[3]); *(u32x2*)p = o; }
__device__ void p2_qkv(const Params& P, LAS unsigned char* lds) {
    const int tid = threadIdx.x, lane = tid & 63, wave = tid >> 6, h = wave & 3, half = wave >> 2;
    unsigned char* ws = P.ws;
    const bf16_t* PROJ = (const bf16_t*)(ws + WS_PROJ);
    bf16_t* Q = (bf16_t*)P.out; bf16_t* K = Q + (size_t)NTOK * DM; bf16_t* V = (bf16_t*)(ws + WS_XN);
    float* GATES = (float*)(ws + WS_GATES);
    LAS float* part = (LAS float*)lds;
    const int ch = h * 256 + lane * 4, blk = ch >> 2;
    float cw[4][4], cb[4], wq[4][4], wk[4][4], wv[4][4], wc[4][8], wx[4][8];
#pragma unroll
    for (int j = 0; j < 4; ++j)
#pragma unroll
        for (int d = 0; d < 4; ++d) cw[j][d] = P.in[I_CONV_W][j * DM + ch + d];
#pragma unroll
    for (int d = 0; d < 4; ++d) { cb[d] = P.in[I_CONV_B][ch + d];
#pragma unroll
        for (int e = 0; e < 4; ++e) { wq[d][e] = P.in[I_WQ][blk * 16 + d * 4 + e]; wk[d][e] = P.in[I_WK][blk * 16 + d * 4 + e]; wv[d][e] = P.in[I_WV][blk * 16 + d * 4 + e]; }
#pragma unroll
        for (int j = 0; j < 8; ++j) { wc[d][j] = ((const float*)(ws + WS_WCX))[(ch + d) * 8 + j]; wx[d][j] = ((const float*)(ws + WS_WCX))[DM * 8 + (ch + d) * 8 + j]; } }
    for (int item = blockIdx.x; item < NTOK / 16; item += gridDim.x) {
        const int tb = item * 16 + half * 8;
        u32x2 raw[11];
        const bool seq0 = (tb & (SEQ - 1)) == 0;
#pragma unroll
        for (int i = 0; i < 11; ++i) raw[i] = (i < 3 && seq0) ? (u32x2){0u, 0u} : *(const u32x2*)(PROJ + (size_t)(tb - 3 + i) * PROJW + ch);
        float x0[4], x1[4], x2[4], x3[4];
        up4(raw[0], x0); up4(raw[1], x1); up4(raw[2], x2);
#pragma unroll
        for (int i = 0; i < 8; ++i) {
            const int t = tb + i;
            up4(raw[3 + i], x3);
            float mc[4], q[4], k[4], v[4], gp[8];
#pragma unroll
            for (int d = 0; d < 4; ++d) mc[d] = siluf_(cw[0][d] * x0[d] + cw[1][d] * x1[d] + cw[2][d] * x2[d] + cw[3][d] * x3[d] + cb[d]);
#pragma unroll
            for (int e = 0; e < 4; ++e) { q[e] = mc[0] * wq[0][e] + mc[1] * wq[1][e] + mc[2] * wq[2][e] + mc[3] * wq[3][e];
                k[e] = mc[0] * wk[0][e] + mc[1] * wk[1][e] + mc[2] * wk[2][e] + mc[3] * wk[3][e];
                v[e] = x3[0] * wv[0][e] + x3[1] * wv[1][e] + x3[2] * wv[2][e] + x3[3] * wv[3][e]; }
            st4(Q + (size_t)t * DM + ch, q); st4(K + (size_t)t * DM + ch, k); st4(V + (size_t)t * DM + ch, v);
#pragma unroll
            for (int j = 0; j < 8; ++j) { float s = 0.f;
#pragma unroll
                for (int d = 0; d < 4; ++d) s += mc[d] * wc[d][j] + x3[d] * wx[d][j];
                gp[j] = wave_sum(s); }
            if (lane == 0) {
#pragma unroll
                for (int j = 0; j < 8; ++j) part[((half * 8 + i) * 4 + h) * 8 + j] = gp[j]; }
#pragma unroll
            for (int d = 0; d < 4; ++d) { x0[d] = x1[d]; x1[d] = x2[d]; x2[d] = x3[d]; }
        }
        __syncthreads();
        if (tid < 128) { const int tok = tid >> 3, j = tid & 7;
            const float val = part[(tok * 4 + 0) * 8 + j] + part[(tok * 4 + 1) * 8 + j] + part[(tok * 4 + 2) * 8 + j] + part[(tok * 4 + 3) * 8 + j] + P.in[I_B_IF][j];
            GATES[(size_t)(item * 16 + tok) * 8 + j] = (j < 4) ? val : log_sigmoid(val); }
        __syncthreads();
    }
    bf16_t* PW = (bf16_t*)(ws + WS_PROJ);
    const int gw = blockIdx.x * NWAVES + wave, NGW = gridDim.x * NWAVES;
    for (int m = gw; m < NTOK; m += NGW) {
        bf16_t* row = PW + (size_t)m * PROJW + 3 * DM + lane * 16;
        const u32x4 a = *(const u32x4*)row, b = *(const u32x4*)(row + 8);
        float x[16] = {bflo(a.x), bfhi(a.x), bflo(a.y), bfhi(a.y), bflo(a.z), bfhi(a.z), bflo(a.w), bfhi(a.w), bflo(b.x), bfhi(b.x), bflo(b.y), bfhi(b.y), bflo(b.z), bfhi(b.z), bflo(b.w), bfhi(b.w)};
        float s = 0.f;
#pragma unroll
        for (int i = 0; i < 16; ++i) s += x[i];
        const float mu = wave_sum(s) * (1.f / DM); float s2 = 0.f;
#pragma unroll
        for (int i = 0; i < 16; ++i) { x[i] -= mu; s2 += x[i] * x[i]; }
        const float r = 1.0f / sqrtf(wave_sum(s2) * (1.f / DM) + EPS);
        const float* lw = P.in[I_G_LN_W] + lane * 16; const float* lb = P.in[I_G_LN_B] + lane * 16;
#pragma unroll
        for (int i = 0; i < 16; ++i) x[i] = x[i] * r * lw[i] + lb[i];
        u32x4 oa, ob; oa.x = pk2(x[0], x[1]); oa.y = pk2(x[2], x[3]); oa.z = pk2(x[4], x[5]); oa.w = pk2(x[6], x[7]); ob.x = pk2(x[8], x[9]); ob.y = pk2(x[10], x[11]); ob.z = pk2(x[12], x[13]); ob.w = pk2(x[14], x[15]);
        *(u32x4*)row = oa; *(u32x4*)(row + 8) = ob;
    }
}

constexpr int ML_C = 0, ML_N = 65536, ML_Q = ML_N + 1024, ML_K = ML_Q + 32768, ML_V = ML_K + 32768, ML_P = ML_V + 8192, ML_S = ML_P + 16384, ML_BYTES = ML_S + 2048;
__device__ void p3_mlstm_naive(const Params& P, LAS unsigned char* lds) {
    const int tid = threadIdx.x, lane = tid & 63, wave = tid >> 6;
    unsigned char* ws = P.ws;
    const bf16_t* Q = (const bf16_t*)P.out; const bf16_t* K = Q + (size_t)NTOK * DM; bf16_t* V = (bf16_t*)(ws + WS_XN);
    const float* GATES = (const float*)(ws + WS_GATES);
    LAS float* Cs = (LAS float*)(lds + ML_C); LAS float* ns = (LAS float*)(lds + ML_N);
    LAS unsigned* qs = (LAS unsigned*)(lds + ML_Q); LAS unsigned* ks = (LAS unsigned*)(lds + ML_K);
    LAS bf16_t* vs = (LAS bf16_t*)(lds + ML_V);
    LAS float* Ps = (LAS float*)(lds + ML_P);
    LAS float* sc = (LAS float*)(lds + ML_S);
    for (int item = blockIdx.x; item < 256; item += gridDim.x) {
        const int b = item >> 4, h = (item >> 2) & 3, j = item & 3;
        for (int i = tid; i < 256 * 64; i += NTHR) Cs[i] = 0.f;
        if (tid < 256) ns[tid] = 0.f;
        float m = 0.f;
        __syncthreads();
        for (int c = 0; c < 32; ++c) {
            const size_t t0 = (size_t)b * SEQ + c * 64;
#pragma unroll
            for (int i = 0; i < 4; ++i) { const int p = tid + i * NTHR, r = p >> 5, cc = p & 31;
                *(LAS u32x4*)(qs + r * 128 + cc * 4) = *(const u32x4*)(Q + (t0 + r) * DM + h * 256 + cc * 8);
                *(LAS u32x4*)(ks + r * 128 + cc * 4) = *(const u32x4*)(K + (t0 + r) * DM + h * 256 + cc * 8); }
            { const int r = tid >> 3, cc = tid & 7; *(LAS u32x4*)(vs + r * 64 + cc * 8) = *(const u32x4*)(V + (t0 + r) * DM + h * 256 + j * 64 + cc * 8); }
            if (wave == 0) {
                const float ig = GATES[(t0 + lane) * 8 + h], lf = GATES[(t0 + lane) * 8 + 4 + h];
                float bs = lf;
#pragma unroll
                for (int o = 1; o < 64; o <<= 1) { const float t = __shfl_up(bs, o); if (lane >= o) bs += t; }
                const float u = ig - bs; float gm = u;
#pragma unroll
                for (int o = 1; o < 64; o <<= 1) { const float t = __shfl_up(gm, o); if (lane >= o) gm = fmaxf(gm, t); }
                const float g = fmaxf(gm, m), gL = __shfl(g, 63), bL = __shfl(bs, 63);
                sc[lane] = u; sc[64 + lane] = g; sc[128 + lane] = expf(m - g); sc[192 + lane] = expf(-bs - g); sc[256 + lane] = expf(u - gL);
                if (lane == 0) sc[384] = expf(m - gL);
                m = bL + gL;
            }
            __syncthreads();
            { const int t = tid >> 3, sg = tid & 7; float acc[8];
#pragma unroll
                for (int i = 0; i < 8; ++i) acc[i] = 0.f;
                if (sg * 8 <= t) {
                    for (int d2 = 0; d2 < 128; ++d2) { const unsigned qw = qs[t * 128 + d2]; const float ql = bflo(qw), qh = bfhi(qw);
#pragma unroll
                        for (int i = 0; i < 8; ++i) { const unsigned kw = ks[(sg * 8 + i) * 128 + d2]; acc[i] += ql * bflo(kw) + qh * bfhi(kw); } } }
                const float gt = sc[64 + t];
#pragma unroll
                for (int i = 0; i < 8; ++i) { const int s = sg * 8 + i; Ps[t * 64 + s] = (s <= t) ? acc[i] * 0.0625f * expf(sc[s] - gt) : 0.f; } }
            __syncthreads();
            if (tid < 64) { const int t = tid; float qn = 0.f;
                for (int d2 = 0; d2 < 128; ++d2) { const unsigned qw = qs[t * 128 + d2]; qn += bflo(qw) * ns[2 * d2] + bfhi(qw) * ns[2 * d2 + 1]; }
                float ps = 0.f;
                for (int s = 0; s <= t; ++s) ps += Ps[t * 64 + s];
                sc[320 + t] = sc[128 + t] * qn + ps; }
            __syncthreads();
            { const int t = tid >> 3, eg = tid & 7; float acc[8];
#pragma unroll
                for (int i = 0; i < 8; ++i) acc[i] = 0.f;
                for (int d2 = 0; d2 < 128; ++d2) { const unsigned qw = qs[t * 128 + d2]; const float ql = bflo(qw), qh = bfhi(qw);
#pragma unroll
                    for (int i = 0; i < 8; ++i) acc[i] += ql * Cs[(2 * d2) * 64 + eg * 8 + i] + qh * Cs[(2 * d2 + 1) * 64 + eg * 8 + i]; }
                const float iw = sc[128 + t];
#pragma unroll
                for (int i = 0; i < 8; ++i) acc[i] *= iw;
                for (int s = 0; s <= t; ++s) { const float pv = Ps[t * 64 + s];
#pragma unroll
                    for (int i = 0; i < 8; ++i) acc[i] += pv * bf2f(vs[s * 64 + eg * 8 + i]); }
                const float dn = 1.0f / fmaxf(fabsf(sc[320 + t]), sc[192 + t]);
                u32x4 o; o.x = pk2(acc[0] * dn, acc[1] * dn); o.y = pk2(acc[2] * dn, acc[3] * dn); o.z = pk2(acc[4] * dn, acc[5] * dn); o.w = pk2(acc[6] * dn, acc[7] * dn);
                *(u32x4*)(V + (t0 + t) * DM + h * 256 + j * 64 + eg * 8) = o;
            }
            __syncthreads();
            { const int d = tid >> 1, eh = tid & 1; const float decay = sc[384]; float acc[32];
#pragma unroll
                for (int i = 0; i < 32; ++i) acc[i] = decay * Cs[d * 64 + eh * 32 + i];
                float nacc = decay * ns[d];
                for (int s = 0; s < 64; ++s) { const unsigned kw = ks[s * 128 + (d >> 1)]; const float kv = ((d & 1) ? bfhi(kw) : bflo(kw)) * 0.0625f * sc[256 + s];
                    nacc += kv;
#pragma unroll
                    for (int i = 0; i < 32; ++i) acc[i] += kv * bf2f(vs[s * 64 + eh * 32 + i]); }
#pragma unroll
                for (int i = 0; i < 32; ++i) Cs[d * 64 + eh * 32 + i] = acc[i];
                if (eh == 0) ns[d] = nacc; }
            __syncthreads();
        }
    }
}

__device__ void p3_gmlp_naive(const Params& P, LAS unsigned char* lds) {
    const int tid = threadIdx.x;
    bf16_t* PROJ = (bf16_t*)(P.ws + WS_PROJ);
    LAS bf16_t* vv = (LAS bf16_t*)lds;
    const float* WSP = P.in[I_W_SP]; const float* BSP = P.in[I_B_SP];
    for (int item = blockIdx.x; item < 2048; item += gridDim.x) {
        const int g = item & 7, c = (item >> 3) & 15, b = item >> 7; const size_t t0 = (size_t)b * SEQ + c * 128;
#pragma unroll
        for (int i = 0; i < 4; ++i) { const int p = tid + i * NTHR, r = p >> 4, cc = p & 15; *(LAS u32x4*)(vv + r * 128 + cc * 8) = *(const u32x4*)(PROJ + (t0 + r) * PROJW + 3 * DM + g * 128 + cc * 8); }
        __syncthreads();
        const int t = tid >> 2, dg = tid & 3; float acc[32];
#pragma unroll
        for (int i = 0; i < 32; ++i) acc[i] = 0.f;
        const float* wrow = WSP + ((size_t)g * 128 + t) * 128;
        for (int s = 0; s <= t; ++s) { const float w = wrow[s];
#pragma unroll
            for (int i = 0; i < 32; ++i) acc[i] += w * bf2f(vv[s * 128 + dg * 32 + i]); }
        const float bs = BSP[g * 128 + t];
        bf16_t* gu = PROJ + (t0 + t) * PROJW + 2 * DM + g * 128 + dg * 32;
#pragma unroll
        for (int i = 0; i < 4; ++i) { const u32x4 w = *(const u32x4*)(gu + i * 8); u32x4 o;
            o.x = pk2(bflo(w.x) * (acc[i * 8 + 0] + bs), bfhi(w.x) * (acc[i * 8 + 1] + bs)); o.y = pk2(bflo(w.y) * (acc[i * 8 + 2] + bs), bfhi(w.y) * (acc[i * 8 + 3] + bs));
            o.z = pk2(bflo(w.z) * (acc[i * 8 + 4] + bs), bfhi(w.z) * (acc[i * 8 + 5] + bs)); o.w = pk2(bflo(w.w) * (acc[i * 8 + 6] + bs), bfhi(w.w) * (acc[i * 8 + 7] + bs));
            *(u32x4*)(gu + i * 8) = o; }
        __syncthreads();
    }
}

namespace mlm {
constexpr int QP = 264, VP = 88, PP = 72;
constexpr int QS_OFF = 0, KS_OFF = QS_OFF + 64 * QP * 2, VS_OFF = KS_OFF + 64 * QP * 2, CT_OFF = VS_OFF + 64 * VP * 2, PS_OFF = CT_OFF + 80 * QP * 2, SC_OFF = PS_OFF + 64 * PP * 2, BYTES = SC_OFF + 2048;
typedef short s16x4 __attribute__((ext_vector_type(4)));
typedef float f32x2_t __attribute__((ext_vector_type(2)));
typedef __bf16 bf16x2_t __attribute__((ext_vector_type(2)));
__device__ __forceinline__ unsigned cvtpk(float lo, float hi) { f32x2_t v = {lo, hi}; bf16x2_t b = __builtin_convertvector(v, bf16x2_t); return __builtin_bit_cast(unsigned, b); }
__device__ __forceinline__ s16x4 tr16(LAS unsigned char* p) { return __builtin_bit_cast(s16x4, __builtin_amdgcn_ds_read_tr16_b64_v4i16((LAS s16x4*)p)); }
__device__ __forceinline__ bf16x8 frag_tr(LAS unsigned char* p, int pitch_bytes) {
    const s16x4 lo = tr16(p), hi = tr16(p + 4 * pitch_bytes);
    return (bf16x8){lo.x, lo.y, lo.z, lo.w, hi.x, hi.y, hi.z, hi.w};
}
}
__device__ void p3_mlstm_mfma(const Params& P, LAS unsigned char* lds) {
    using namespace mlm;
    const int tid = threadIdx.x, lane = tid & 63, wave = __builtin_amdgcn_readfirstlane(tid >> 6), fr = lane & 15, fq = lane >> 4, q_ = fr >> 2, p_ = fr & 3;
    const int tau = wave >> 1, par = wave & 1;
    unsigned char* ws = P.ws;
    const bf16_t* Q = (const bf16_t*)P.out; const bf16_t* K = Q + (size_t)NTOK * DM; bf16_t* V = (bf16_t*)(ws + WS_XN);
    const float* GATES = (const float*)(ws + WS_GATES);
    LAS float* sc = (LAS float*)(lds + SC_OFF);
    for (int item = blockIdx.x; item < 256; item += gridDim.x) {
        const int b = item >> 4, h = (item >> 2) & 3, j = item & 3;
        for (int i = tid; i < 80 * QP * 2 / 16; i += NTHR) ((LAS u32x4*)(lds + CT_OFF))[i] = (u32x4){0u, 0u, 0u, 0u};
        if (tid < 64) { LAS bf16_t* r = (LAS bf16_t*)(lds + VS_OFF) + tid * VP + 64; r[0] = 0x3F80;
#pragma unroll
            for (int i = 1; i < 24; ++i) r[i] = 0; }
        f32x4 cacc[2][5];
#pragma unroll
        for (int a = 0; a < 2; ++a)
#pragma unroll
            for (int e = 0; e < 5; ++e) cacc[a][e] = (f32x4){0.f, 0.f, 0.f, 0.f};
        float m = 0.f;
        u32x4 pq[4], pk[4], pv; float pig = 0.f, plf = 0.f;
        const bf16_t* qb = Q + (size_t)b * SEQ * DM + h * 256; const bf16_t* kb = K + (size_t)b * SEQ * DM + h * 256; bf16_t* vb = V + (size_t)b * SEQ * DM + h * 256 + j * 64;
#define ML_LOAD(c_) do { const size_t r0_ = (size_t)(c_) * 64; \
            _Pragma("unroll") for (int i = 0; i < 4; ++i) { const int p = tid + i * NTHR, r = p >> 5, cc = p & 31; pq[i] = *(const u32x4*)(qb + (r0_ + r) * DM + cc * 8); pk[i] = *(const u32x4*)(kb + (r0_ + r) * DM + cc * 8); } \
            pv = *(const u32x4*)(vb + (r0_ + (tid >> 3)) * DM + (tid & 7) * 8); \
            if (wave == 0) { pig = GATES[((size_t)b * SEQ + r0_ + lane) * 8 + h]; plf = GATES[((size_t)b * SEQ + r0_ + lane) * 8 + 4 + h]; } } while (0)
        ML_LOAD(0);
        __syncthreads();
        for (int c = 0; c < 32; ++c) {
#pragma unroll
            for (int i = 0; i < 4; ++i) { const int p = tid + i * NTHR, r = p >> 5, cc = p & 31; *(LAS u32x4*)(lds + QS_OFF + r * QP * 2 + cc * 16) = pq[i]; *(LAS u32x4*)(lds + KS_OFF + r * QP * 2 + cc * 16) = pk[i]; }
            *(LAS u32x4*)(lds + VS_OFF + (tid >> 3) * VP * 2 + (tid & 7) * 16) = pv;
            if (wave == 0) {
                float bs = plf;
#pragma unroll
                for (int o = 1; o < 64; o <<= 1) { const float t = __shfl_up(bs, o); if (lane >= o) bs += t; }
                const float u = pig - bs; float gm = u;
#pragma unroll
                for (int o = 1; o < 64; o <<= 1) { const float t = __shfl_up(gm, o); if (lane >= o) gm = fmaxf(gm, t); }
                const float g = fmaxf(gm, m), gL = __shfl(g, 63), bL = __shfl(bs, 63);
                sc[lane] = u; sc[64 + lane] = g; sc[128 + lane] = expf(m - g); sc[192 + lane] = expf(-bs - g); sc[256 + lane] = expf(u - gL) * 0.0625f;
                if (lane == 0) sc[320] = expf(m - gL);
                m = bL + gL;
            }
            __syncthreads();
            if (c + 1 < 32) ML_LOAD(c + 1);
            bf16x8 qf[8];
#pragma unroll
            for (int kap = 0; kap < 8; ++kap) qf[kap] = *(const LAS bf16x8*)(lds + QS_OFF + ((16 * tau + fr) * QP + 32 * kap + 8 * fq) * 2);
            const float gt = sc[64 + 16 * tau + fr];
#pragma unroll
            for (int si = 0; si < 2; ++si) {
                const int sig = 2 * par + si; f32x4 acc = (f32x4){0.f, 0.f, 0.f, 0.f};
                if (sig <= tau) {
#pragma unroll
                    for (int kap = 0; kap < 8; ++kap) acc = __builtin_amdgcn_mfma_f32_16x16x32_bf16(*(const LAS bf16x8*)(lds + KS_OFF + ((16 * sig + fr) * QP + 32 * kap + 8 * fq) * 2), qf[kap], acc, 0, 0, 0);
                }
                const f32x4 us = *(const LAS f32x4*)(sc + 16 * sig + 4 * fq);
                const int t = 16 * tau + fr, s0 = 16 * sig + 4 * fq;
                const float w0 = (s0 + 0 <= t) ? acc.x * 0.0625f * __expf(us.x - gt) : 0.f, w1 = (s0 + 1 <= t) ? acc.y * 0.0625f * __expf(us.y - gt) : 0.f;
                const float w2 = (s0 + 2 <= t) ? acc.z * 0.0625f * __expf(us.z - gt) : 0.f, w3 = (s0 + 3 <= t) ? acc.w * 0.0625f * __expf(us.w - gt) : 0.f;
                u32x2 o; o.x = cvtpk(w0, w1); o.y = cvtpk(w2, w3);
                *(LAS u32x2*)(lds + PS_OFF + (t * PP + s0) * 2) = o;
            }
            f32x4 nacc[3];
#pragma unroll
            for (int ei = 0; ei < 3; ++ei) {
                const int eps = (ei == 2) ? 4 : 2 * par + ei; f32x4 acc = (f32x4){0.f, 0.f, 0.f, 0.f};
#pragma unroll
                for (int kap = 0; kap < 8; ++kap) acc = __builtin_amdgcn_mfma_f32_16x16x32_bf16(*(const LAS bf16x8*)(lds + CT_OFF + ((16 * eps + fr) * QP + 32 * kap + 8 * fq) * 2), qf[kap], acc, 0, 0, 0);
                nacc[ei] = acc * sc[128 + 16 * tau + fr];
            }
            __syncthreads();
            {
                bf16x8 pf[2];
#pragma unroll
                for (int kp = 0; kp < 2; ++kp) pf[kp] = *(const LAS bf16x8*)(lds + PS_OFF + ((16 * tau + fr) * PP + 32 * kp + 8 * fq) * 2);
#pragma unroll
                for (int ei = 0; ei < 3; ++ei) {
                    const int eps = (ei == 2) ? 4 : 2 * par + ei;
#pragma unroll
                    for (int kp = 0; kp < 2; ++kp) nacc[ei] = __builtin_amdgcn_mfma_f32_16x16x32_bf16(frag_tr(lds + VS_OFF + ((32 * kp + 8 * fq + q_) * VP + 16 * eps + 4 * p_) * 2, VP * 2), pf[kp], nacc[ei], 0, 0, 0);
                }
                const float den = __shfl(nacc[2].x, fr);
                const float rinv = 1.0f / fmaxf(fabsf(den), sc[192 + 16 * tau + fr]);
                bf16_t* hrow = vb + ((size_t)c * 64 + 16 * tau + fr) * DM;
#pragma unroll
                for (int ei = 0; ei < 2; ++ei) { const int eps = 2 * par + ei; u32x2 o; o.x = cvtpk(nacc[ei].x * rinv, nacc[ei].y * rinv); o.y = cvtpk(nacc[ei].z * rinv, nacc[ei].w * rinv);
                    *(u32x2*)(hrow + 16 * eps + 4 * fq) = o; }
            }
            {
                const float decay = sc[320];
                bf16x8 kw[2][2];
#pragma unroll
                for (int dl = 0; dl < 2; ++dl)
#pragma unroll
                    for (int kp = 0; kp < 2; ++kp) {
                        const bf16x8 f = frag_tr(lds + KS_OFF + ((32 * kp + 8 * fq + q_) * QP + 16 * (2 * wave + dl) + 4 * p_) * 2, QP * 2);
                        const u32x4 fw = __builtin_bit_cast(u32x4, f);
                        const f32x4 wa = *(const LAS f32x4*)(sc + 256 + 32 * kp + 8 * fq), wb = *(const LAS f32x4*)(sc + 256 + 32 * kp + 8 * fq + 4);
                        u32x4 o; o.x = cvtpk(bflo(fw.x) * wa.x, bfhi(fw.x) * wa.y); o.y = cvtpk(bflo(fw.y) * wa.z, bfhi(fw.y) * wa.w); o.z = cvtpk(bflo(fw.z) * wb.x, bfhi(fw.z) * wb.y); o.w = cvtpk(bflo(fw.w) * wb.z, bfhi(fw.w) * wb.w);
                        kw[dl][kp] = __builtin_bit_cast(bf16x8, o);
                    }
#pragma unroll
                for (int eps = 0; eps < 5; ++eps) {
                    bf16x8 vf[2];
#pragma unroll
                    for (int kp = 0; kp < 2; ++kp) vf[kp] = frag_tr(lds + VS_OFF + ((32 * kp + 8 * fq + q_) * VP + 16 * eps + 4 * p_) * 2, VP * 2);
#pragma unroll
                    for (int dl = 0; dl < 2; ++dl) {
                        f32x4 a = cacc[dl][eps] * decay;
                        a = __builtin_amdgcn_mfma_f32_16x16x32_bf16(kw[dl][0], vf[0], a, 0, 0, 0);
                        a = __builtin_amdgcn_mfma_f32_16x16x32_bf16(kw[dl][1], vf[1], a, 0, 0, 0);
                        cacc[dl][eps] = a;
                        u32x2 o; o.x = cvtpk(a.x, a.y); o.y = cvtpk(a.z, a.w);
                        *(LAS u32x2*)(lds + CT_OFF + ((16 * eps + fr) * QP + 16 * (2 * wave + dl) + 4 * fq) * 2) = o;
                    }
                }
            }
            __syncthreads();
        }
#undef ML_LOAD
    }
}

namespace gmm { constexpr int VVP = 136, VV_OFF = 0, WS_OFF = 128 * VVP * 2, BYTES = 2 * 128 * VVP * 2; }
__device__ void p3_gmlp_mfma(const Params& P, LAS unsigned char* lds) {
    using namespace gmm;
    const int tid = threadIdx.x, lane = tid & 63, wave = __builtin_amdgcn_readfirstlane(tid >> 6), fr = lane & 15, fq = lane >> 4, q_ = fr >> 2, p_ = fr & 3;
    bf16_t* PROJ = (bf16_t*)(P.ws + WS_PROJ); const bf16_t* WSPb = (const bf16_t*)(P.ws + WS_WSP); const float* BSP = P.in[I_B_SP];
    int g_staged = -1;
    u32x4 pre[4];
#define GM_LOAD(it_) do { const int g_ = (it_) & 7, c_ = ((it_) >> 3) & 15, b_ = (it_) >> 7; const size_t t0_ = (size_t)b_ * SEQ + c_ * 128; \
        _Pragma("unroll") for (int i = 0; i < 4; ++i) { const int p = tid + i * NTHR, r = p >> 4, cc = p & 15; pre[i] = *(const u32x4*)(PROJ + (t0_ + r) * PROJW + 3 * DM + g_ * 128 + cc * 8); } } while (0)
    if ((int)blockIdx.x < 2048) GM_LOAD(blockIdx.x);
    for (int item = blockIdx.x; item < 2048; item += gridDim.x) {
        const int g = item & 7, c = (item >> 3) & 15, b = item >> 7; const size_t t0 = (size_t)b * SEQ + c * 128;
#pragma unroll
        for (int i = 0; i < 4; ++i) { const int p = tid + i * NTHR, r = p >> 4, cc = p & 15; *(LAS u32x4*)(lds + VV_OFF + (r * VVP + cc * 8) * 2) = pre[i]; }
        if (g != g_staged) {
#pragma unroll
            for (int i = 0; i < 4; ++i) { const int p = tid + i * NTHR, r = p >> 4, cc = p & 15; *(LAS u32x4*)(lds + WS_OFF + (r * VVP + cc * 8) * 2) = *(const u32x4*)(WSPb + ((size_t)g * 128 + r) * 128 + cc * 8); }
            g_staged = g;
        }
        __syncthreads();
        if (item + (int)gridDim.x < 2048) GM_LOAD(item + gridDim.x);
        bf16x8 af[4];
#pragma unroll
        for (int kap = 0; kap < 4; ++kap) af[kap] = mlm::frag_tr(lds + VV_OFF + ((32 * kap + 8 * fq + q_) * VVP + 16 * wave + 4 * p_) * 2, VVP * 2);
#pragma unroll
        for (int th = 0; th < 8; ++th) {
            f32x4 acc = (f32x4){0.f, 0.f, 0.f, 0.f};
#pragma unroll
            for (int kap = 0; kap <= (th >> 1); ++kap) acc = __builtin_amdgcn_mfma_f32_16x16x32_bf16(af[kap], *(const LAS bf16x8*)(lds + WS_OFF + ((16 * th + fr) * VVP + 32 * kap + 8 * fq) * 2), acc, 0, 0, 0);
            const int t = 16 * th + fr; const float bs = BSP[g * 128 + t];
            bf16_t* gu = PROJ + (t0 + t) * PROJW + 2 * DM + g * 128 + 16 * wave + 4 * fq;
            const u32x2 w = *(const u32x2*)gu; u32x2 o;
            o.x = mlm::cvtpk(bflo(w.x) * (acc.x + bs), bfhi(w.x) * (acc.y + bs)); o.y = mlm::cvtpk(bflo(w.y) * (acc.z + bs), bfhi(w.y) * (acc.w + bs));
            *(u32x2*)gu = o;
        }
        __syncthreads();
    }
#undef GM_LOAD
}

__device__ void p4_ym(const Params& P, LAS unsigned char*) {
    const int tid = threadIdx.x, lane = tid & 63, wave = tid >> 6, h = wave & 3, half = wave >> 2;
    bf16_t* PROJ = (bf16_t*)(P.ws + WS_PROJ); const bf16_t* HM = (const bf16_t*)(P.ws + WS_XN);
    const int ch = h * 256 + lane * 4;
    float cw[4][4], cb[4], ng[4], sk[4];
#pragma unroll
    for (int j = 0; j < 4; ++j)
#pragma unroll
        for (int d = 0; d < 4; ++d) cw[j][d] = P.in[I_CONV_W][j * DM + ch + d];
#pragma unroll
    for (int d = 0; d < 4; ++d) { cb[d] = P.in[I_CONV_B][ch + d]; ng[d] = P.in[I_M_NORM_G][ch + d]; sk[d] = P.in[I_M_SKIP][ch + d]; }
    for (int item = blockIdx.x; item < NTOK / 16; item += gridDim.x) {
        const int tb = item * 16 + half * 8;
        u32x2 raw[11], rh[8], rz[8];
        const bool seq0 = (tb & (SEQ - 1)) == 0;
#pragma unroll
        for (int i = 0; i < 11; ++i) raw[i] = (i < 3 && seq0) ? (u32x2){0u, 0u} : *(const u32x2*)(PROJ + (size_t)(tb - 3 + i) * PROJW + ch);
#pragma unroll
        for (int i = 0; i < 8; ++i) { rh[i] = *(const u32x2*)(HM + (size_t)(tb + i) * DM + ch); rz[i] = *(const u32x2*)(PROJ + (size_t)(tb + i) * PROJW + DM + ch); }
        float x0[4], x1[4], x2[4], x3[4];
        up4(raw[0], x0); up4(raw[1], x1); up4(raw[2], x2);
#pragma unroll
        for (int i = 0; i < 8; ++i) {
            const int t = tb + i;
            up4(raw[3 + i], x3);
            float hm[4], sz[4], y[4];
            up4(rh[i], hm); up4(rz[i], sz);
            const float mu = wave_sum(hm[0] + hm[1] + hm[2] + hm[3]) * (1.f / 256.f);
            float s2 = 0.f;
#pragma unroll
            for (int d = 0; d < 4; ++d) { hm[d] -= mu; s2 += hm[d] * hm[d]; }
            const float r = 1.0f / sqrtf(wave_sum(s2) * (1.f / 256.f) + EPS);
#pragma unroll
            for (int d = 0; d < 4; ++d) { const float mc = siluf_(cw[0][d] * x0[d] + cw[1][d] * x1[d] + cw[2][d] * x2[d] + cw[3][d] * x3[d] + cb[d]);
                y[d] = (hm[d] * r * ng[d] + sk[d] * mc) * sz[d]; }
            st4(PROJ + (size_t)t * PROJW + DM + ch, y);
#pragma unroll
            for (int d = 0; d < 4; ++d) { x0[d] = x1[d]; x1[d] = x2[d]; x2[d] = x3[d]; }
        }
    }
}

__device__ void norm_pass(const float* xi, const float* y, const float* g1, float* xo, const float* g2, bf16_t* hn, int ldh, int hoff, const float* pin) {
    const int tid = threadIdx.x, lane = tid & 63, wave = tid >> 6;
    const int gw = blockIdx.x * NWAVES + wave, NGW = gridDim.x * NWAVES;
    for (int m = gw; m < NTOK; m += NGW) {
        const f32x4* yr = (const f32x4*)(y + (size_t)m * DM) + lane; const f32x4* xr = (const f32x4*)(xi + (size_t)m * DM) + lane; f32x4* orow = (f32x4*)(xo + (size_t)m * DM) + lane;
        f32x4 v[4]; float s = 0.f;
#pragma unroll
        for (int j = 0; j < 4; ++j) { v[j] = yr[64 * j]; s += (v[j].x * v[j].x + v[j].y * v[j].y) + (v[j].z * v[j].z + v[j].w * v[j].w); }
        const float r = 1.0f / sqrtf(wave_sum(s) * (1.f / DM) + EPS); float s2 = 0.f;
#pragma unroll
        for (int j = 0; j < 4; ++j) { const f32x4 gv = ((const f32x4*)g1 + lane)[64 * j]; v[j] = xr[64 * j] + v[j] * r * gv; orow[64 * j] = v[j];
            s2 += (v[j].x * v[j].x + v[j].y * v[j].y) + (v[j].z * v[j].z + v[j].w * v[j].w); }
        if (hn) {
            const float r2 = 1.0f / sqrtf(wave_sum(s2) * (1.f / DM) + EPS);
            u32x2* o8 = (u32x2*)(hn + (size_t)m * ldh + hoff) + lane;
#pragma unroll
            for (int j = 0; j < 4; ++j) { const f32x4 gv = ((const f32x4*)g2 + lane)[64 * j]; u32x2 o; o.x = pk2(v[j].x * r2 * gv.x, v[j].y * r2 * gv.y); o.y = pk2(v[j].z * r2 * gv.z, v[j].w * r2 * gv.w); o8[64 * j] = o; }
            if (pin) { const f32x4 pv = ((const f32x4*)(pin + (size_t)m * PLE))[lane]; u32x2 o; o.x = pk2(pv.x, pv.y); o.y = pk2(pv.z, pv.w); ((u32x2*)(hn + (size_t)m * ldh))[lane] = o; }
        }
    }
}

#define XB_TMO      128
#define XB_XCNT(j)  (256  + 64 * (j))
#define XB_XSUB(j)  (1280 + 64 * (j))
#define XB_XGEN(j)  (2304 + 64 * (j))
#define XB_TOP      3328
#define XB_TOPGEN   3392
#define XCD_BAR_WORDS 3456
#define XB_SPIN_CAP (1u << 20)
__device__ __forceinline__ unsigned xb_ld(unsigned* p)              { return __hip_atomic_load(p, __ATOMIC_RELAXED, __HIP_MEMORY_SCOPE_AGENT); }
__device__ __forceinline__ unsigned xb_add(unsigned* p, unsigned v) { return __hip_atomic_fetch_add(p, v, __ATOMIC_RELAXED, __HIP_MEMORY_SCOPE_AGENT); }
__device__ __forceinline__ unsigned xb_xcc_id() { return (unsigned)__builtin_amdgcn_s_getreg((3 << 11) | 20) & 0xFu; }
#define XB_SPIN(cond, bar) do { unsigned _sp = 0; while (cond) { __builtin_amdgcn_s_sleep(1); \
    if ((++_sp & 255u) == 0u) { if (xb_ld(&(bar)[XB_TMO])) break; if (_sp > XB_SPIN_CAP) { atomicAdd(&(bar)[XB_TMO], 1u); break; } } } } while (0)
struct XcdBarrier { unsigned* bar; unsigned x; volatile LAS unsigned* st; };
__device__ __forceinline__ XcdBarrier xcd_barrier_post(unsigned* bar, volatile LAS unsigned* st) {
    XcdBarrier b; b.bar = bar; b.x = xb_xcc_id(); b.st = st;
    if (threadIdx.x == 0) (void)xb_add(&bar[XB_XCNT(b.x)], 1u);
    return b;
}
__device__ __forceinline__ void xcd_barrier_complete(unsigned* bar, unsigned x, unsigned& nloc, unsigned& nx) {
    const unsigned G = gridDim.x * gridDim.y * gridDim.z;
    unsigned sum, cnt, mine, sp = 0u;
    for (;;) {
        sum = 0u; cnt = 0u; mine = 0u;
#pragma unroll
        for (unsigned j = 0; j < 16; ++j) { const unsigned c = xb_ld(&bar[XB_XCNT(j)]); sum += c; cnt += (c > 0u) ? 1u : 0u; mine = (j == x) ? c : mine; }
        if (sum == G) break;
        __builtin_amdgcn_s_sleep(1);
        if ((++sp & 255u) == 0u) { if (xb_ld(&bar[XB_TMO])) break; if (sp > XB_SPIN_CAP) { atomicAdd(&bar[XB_TMO], 1u); break; } }
    }
    nloc = mine > 0u ? mine : 1u; nx = cnt > 0u ? cnt : 1u;
}
__device__ __forceinline__ void xcd_barrier(const XcdBarrier& b) {
    asm volatile("s_waitcnt vmcnt(0)" ::: "memory");
    __syncthreads();
    if (threadIdx.x == 0) {
        unsigned* bar = b.bar;
        __builtin_amdgcn_s_waitcnt(0);
        unsigned nloc = b.st[0], nx = b.st[1];
        if (nloc == 0u) { xcd_barrier_complete(bar, b.x, nloc, nx); b.st[0] = nloc; b.st[1] = nx; }
        const unsigned old = xb_add(&bar[XB_XSUB(b.x)], 1u);
        const unsigned gen = old / nloc;
        if (old + 1u == (gen + 1u) * nloc) {
            __builtin_amdgcn_fence(__ATOMIC_RELEASE, "agent");
            asm volatile("s_waitcnt vmcnt(0)" ::: "memory");
            const unsigned og = xb_add(&bar[XB_TOP], 1u);
            const unsigned tg = og / nx;
            if (og + 1u == (tg + 1u) * nx) xb_add(&bar[XB_TOPGEN], 1u);
            else XB_SPIN(xb_ld(&bar[XB_TOPGEN]) == tg, bar);
            __builtin_amdgcn_fence(__ATOMIC_ACQUIRE, "agent");
            xb_add(&bar[XB_XGEN(b.x)], 1u);
            asm volatile("s_waitcnt vmcnt(0)" ::: "memory");
        } else {
            XB_SPIN(xb_ld(&bar[XB_XGEN(b.x)]) == gen, bar);
            __builtin_amdgcn_fence(__ATOMIC_ACQUIRE, "agent");
            asm volatile("s_waitcnt vmcnt(0)" ::: "memory");
        }
    }
    __syncthreads();
}

#ifndef MEGA
#define MEGA 1
#endif
namespace cg = cooperative_groups;
constexpr int NPHASE = 13;
constexpr int LDS_BYTES = 160 * 1024 - 1024;
constexpr int MISC_OFF = LDS_BYTES - 256;
constexpr int CW_BAR = 4096;
constexpr size_t CTL_ZERO_BYTES = 64 * 1024;
#ifndef USE_CG_SYNC
#define USE_CG_SYNC 0
#endif
static_assert(ML_BYTES <= LDS_BYTES && pg8::STAGE_BYTES <= LDS_BYTES && mlm::BYTES <= MISC_OFF && ML_BYTES <= MISC_OFF && (CW_BAR + XCD_BAR_WORDS) * 4 <= (int)CTL_ZERO_BYTES, "lds");

template <int LO, int HI> __global__ void __launch_bounds__(NTHR, 2) fwd_kernel(Params P) {
    extern __shared__ __attribute__((aligned(16))) unsigned char lds_raw[];
    LAS unsigned char* lds = (LAS unsigned char*)lds_raw;
    unsigned char* ws = P.ws;
    bf16_t* PROJ = (bf16_t*)(ws + WS_PROJ); bf16_t* XN = (bf16_t*)(ws + WS_XN); bf16_t* HB = (bf16_t*)(ws + WS_HB); float* Y = (float*)(ws + WS_Y);
    const int G = gridDim.x, bid = blockIdx.x;
#define IN(k) (LO <= (k) && (k) < HI)
#if USE_CG_SYNC
#define SEAM(k) do { if (IN(k) && IN((k) + 1)) cg::this_grid().sync(); } while (0)
#else
    if (HI - LO > 1) { volatile LAS unsigned* misc = (volatile LAS unsigned*)(lds + MISC_OFF); if (threadIdx.x < 2) misc[threadIdx.x] = 0u; __syncthreads(); (void)xcd_barrier_post((unsigned*)(P.ws + WS_CTL) + CW_BAR, misc); }
#define SEAM(k) do { if (IN(k) && IN((k) + 1)) { XcdBarrier xb_; xb_.bar = (unsigned*)(P.ws + WS_CTL) + CW_BAR; xb_.x = xb_xcc_id(); xb_.st = (volatile LAS unsigned*)((LAS unsigned char*)lds_raw + MISC_OFF); xcd_barrier(xb_); } } while (0)
#endif
    if (IN(0)) p0_prologue(P, lds);
    SEAM(0);
    if (IN(1)) { pg8::Gemm g{XN, (const bf16_t*)(ws + WS_WIN), DM, DM, NTOK, PROJW, DM}; pg8::StaticOrder S; S.init(NTOK, PROJW, G, bid);
        pg8::Epi8<ProjF> E{ProjF{PROJ}}; pg8::gemm_phase<pg8::Epi8<ProjF>, -1, true>(lds, g, S, E); }
    SEAM(1);
    if (IN(2)) p2_qkv(P, lds);
    SEAM(2);
    if (IN(3)) { p3_mlstm_mfma(P, lds); __syncthreads(); p3_gmlp_mfma(P, lds); }
    SEAM(3);
    if (IN(4)) p4_ym(P, lds);
    SEAM(4);
    if (IN(5)) { pg8::Gemm g{PROJ + DM, (const bf16_t*)(ws + WS_WBR), PROJW, 2 * DM, NTOK, DM, 2 * DM}; pg8::StaticOrder S; S.init(NTOK, DM, G, bid);
        pg8::Epi8<MergeF> E{MergeF{PROJ, XN}}; pg8::gemm_phase<pg8::Epi8<MergeF>, 16, true>(lds, g, S, E); }
    SEAM(5);
    if (IN(6)) { pg8::Gemm g{XN, (const bf16_t*)(ws + WS_WOUT), DM, DM, NTOK, DM, DM}; pg8::StaticOrder S; S.init(NTOK, DM, G, bid);
        pg8::Epi4<F32F> E{F32F{Y, DM}}; pg8::gemm_phase<pg8::Epi4<F32F>, -1, true>(lds, g, S, E); }
    SEAM(6);
    if (IN(7)) norm_pass(P.in[I_X], Y, P.in[I_MIX_POST_G], P.out, P.in[I_MLP_PRE_G], XN, DM, 0, nullptr);
    SEAM(7);
    if (IN(8)) { pg8::Gemm g{XN, (const bf16_t*)(ws + WS_WUP), DM, DM, NTOK, DFF, DM}; pg8::StaticOrder S; S.init(NTOK, DFF, G, bid);
        pg8::Epi8<Relu2F> E{Relu2F{HB, DFF}}; pg8::gemm_phase<pg8::Epi8<Relu2F>, -1, true>(lds, g, S, E); }
    SEAM(8);
    if (IN(9)) { pg8::Gemm g{HB, (const bf16_t*)(ws + WS_WDN), DFF, DFF, NTOK, DM, DFF}; pg8::StaticOrder S; S.init(NTOK, DM, G, bid);
        pg8::Epi4<F32F> E{F32F{Y, DM}}; pg8::gemm_phase<pg8::Epi4<F32F>, -1, true>(lds, g, S, E); }
    SEAM(9);
    if (IN(10)) norm_pass(P.out, Y, P.in[I_MLP_POST_G], P.out, P.in[I_PLE_PRE_G], HB, PLEK, PLE, P.in[I_P]);
    SEAM(10);
    if (IN(11)) { pg8::Gemm g{HB, (const bf16_t*)(ws + WS_WPLE), PLEK, PLEK, NTOK, DM, PLEK}; pg8::StaticOrder S; S.init(NTOK, DM, G, bid);
        pg8::Epi4<PleF> E{PleF{Y, (f32x4*)(ws + WS_XN)}}; pg8::gemm_phase<pg8::Epi4<PleF>, 4, true>(lds, g, S, E); }
    SEAM(11);
    if (IN(12)) norm_pass(P.out, Y, P.in[I_PLE_POST_G], P.out, nullptr, nullptr, 0, 0, nullptr);
#undef IN
#undef SEAM
}

template <int LO, int HI> static void launch_range(const Params& P, int grid, hipStream_t stream, bool coop) {
    static bool attr = false;
    if (!attr) { (void)hipFuncSetAttribute((const void*)fwd_kernel<LO, HI>, hipFuncAttributeMaxDynamicSharedMemorySize, LDS_BYTES); attr = true; }
    if (coop) {
        Params p = P; void* args[] = {&p};
        const hipError_t e = hipLaunchCooperativeKernel((const void*)fwd_kernel<LO, HI>, dim3(grid), dim3(NTHR), args, LDS_BYTES, stream);
        if (e != hipSuccess) fprintf(stderr, "cooperative launch failed: %s (grid %d)\n", hipGetErrorString(e), grid);
    } else hipLaunchKernelGGL((fwd_kernel<LO, HI>), dim3(grid), dim3(NTHR), LDS_BYTES, stream, P);
}
template <int I> static void launch_each(const Params& P, int grid, hipStream_t stream) {
    if constexpr (I < NPHASE) { launch_range<I, I + 1>(P, grid, stream, false); launch_each<I + 1>(P, grid, stream); }
}

extern "C" void kernel_launch(void* const* d_in, const int* in_sizes, int n_in, void* d_out, int out_size, void* d_ws, size_t ws_size, hipStream_t stream) {
    if (n_in != 29 || out_size != NTOK * DM || ws_size < WS_END) { fprintf(stderr, "kernel_launch: unexpected shapes (n_in %d out %d ws %zu)\n", n_in, out_size, ws_size); return; }
    Params P{};
    for (int i = 0; i < 29; ++i) P.in[i] = (const float*)d_in[i];
    P.out = (float*)d_out; P.ws = (unsigned char*)d_ws;
#if MEGA
    static int grid = 0;
    if (!grid) {
        int dev = 0, cus = 0, per_cu = 0;
        (void)hipGetDevice(&dev); (void)hipDeviceGetAttribute(&cus, hipDeviceAttributeMultiprocessorCount, dev);
        (void)hipFuncSetAttribute((const void*)fwd_kernel<0, NPHASE>, hipFuncAttributeMaxDynamicSharedMemorySize, LDS_BYTES);
        (void)hipOccupancyMaxActiveBlocksPerMultiprocessor(&per_cu, (const void*)fwd_kernel<0, NPHASE>, NTHR, LDS_BYTES);
        if (per_cu < 1) per_cu = 1;
        grid = cus;
        if (grid > cus * per_cu) grid = cus * per_cu;
    }
    (void)hipMemsetAsync((char*)d_ws + WS_CTL, 0, CTL_ZERO_BYTES, stream);
    launch_range<0, NPHASE>(P, grid, stream, true);
#else
    launch_each<0>(P, 256, stream);
#endif
}
```

```cpp
#include <hip/hip_runtime.h>
#include <hip/hip_cooperative_groups.h>
#include <cstdio>
#include <cstdint>
#include <cmath>

#define LAS __attribute__((address_space(3)))
typedef unsigned short bf16_t;
typedef short bf16x8 __attribute__((ext_vector_type(8)));
typedef float f32x4 __attribute__((ext_vector_type(4)));
typedef unsigned u32x4 __attribute__((ext_vector_type(4)));
typedef unsigned u32x2 __attribute__((ext_vector_type(2)));

constexpr int NTOK = 32768, DM = 1024, SEQ = 2048, PROJW = 6144, DFF = 4096, PLE = 256, PLEK = PLE + DM;
constexpr float EPS = 1e-6f;
constexpr int NWAVES = 8, NTHR = 512;
constexpr size_t MiB = 1u << 20;
constexpr size_t WS_CTL = 0;
constexpr size_t WS_WIN = 1 * MiB;
constexpr size_t WS_WBR = 13 * MiB;
constexpr size_t WS_WOUT = 17 * MiB;
constexpr size_t WS_WUP = 19 * MiB;
constexpr size_t WS_WDN = 27 * MiB;
constexpr size_t WS_WPLE = 35 * MiB;
constexpr size_t WS_WCX = 38 * MiB;
constexpr size_t WS_WSP = 38 * MiB + 256 * 1024;
constexpr size_t WS_GATES = 39 * MiB;
constexpr size_t WS_XN = 40 * MiB;
constexpr size_t WS_PROJ = 104 * MiB;
constexpr size_t WS_HB = WS_PROJ;
constexpr size_t WS_Y = WS_PROJ + 256 * MiB;
constexpr size_t WS_END = 488 * MiB;

struct Params {
    const float* in[29];
    float* out;
    unsigned char* ws;
};
enum { I_X = 0, I_P, I_MIX_PRE_G, I_W_IN, I_CONV_W, I_CONV_B, I_WQ, I_WK, I_WV, I_W_IF, I_B_IF, I_M_NORM_G, I_M_SKIP, I_G_LN_W, I_G_LN_B, I_W_SP, I_B_SP,
       I_W_BR_M, I_W_BR_G, I_W_OUT, I_MIX_POST_G, I_MLP_PRE_G, I_W_UP, I_W_DOWN, I_MLP_POST_G, I_PLE_PRE_G, I_W_PLE_GATE, I_W_PLE_PROJ, I_PLE_POST_G };

__device__ __forceinline__ unsigned f2bf(float f) { unsigned u = __builtin_bit_cast(unsigned, f); return (u + 0x7fffu + ((u >> 16) & 1u)) >> 16; }
typedef float f32x2_t_ __attribute__((ext_vector_type(2)));
typedef __bf16 bf16x2_t_ __attribute__((ext_vector_type(2)));
__device__ __forceinline__ unsigned pk2(float lo, float hi) { f32x2_t_ v = {lo, hi}; bf16x2_t_ b = __builtin_convertvector(v, bf16x2_t_); return __builtin_bit_cast(unsigned, b); }
__device__ __forceinline__ float bflo(unsigned w) { return __builtin_bit_cast(float, w << 16); }
__device__ __forceinline__ float bfhi(unsigned w) { return __builtin_bit_cast(float, w & 0xffff0000u); }
__device__ __forceinline__ float bf2f(bf16_t h) { return __builtin_bit_cast(float, (unsigned)h << 16); }
__device__ __forceinline__ float sigmoidf_(float x) { return __builtin_amdgcn_rcpf(1.0f + __builtin_amdgcn_exp2f(-1.4426950408889634f * x)); }
__device__ __forceinline__ float siluf_(float x) { return x * sigmoidf_(x); }
__device__ __forceinline__ float gelu_tanh(float x) { const float z = 0.7978845608028654f * (x + 0.044715f * x * x * x); return x * sigmoidf_(2.0f * z); }
__device__ __forceinline__ float log_sigmoid(float x) { return fminf(x, 0.f) - log1pf(expf(-fabsf(x))); }
__device__ __forceinline__ float wave_sum(float v) {
#pragma unroll
    for (int o = 1; o < 64; o <<= 1) v += __shfl_xor(v, o);
    return v;
}
#define LDS_WAIT() asm volatile("s_waitcnt lgkmcnt(0)" ::: "memory")

template <bool GATE_REMAP = false>
__device__ __forceinline__ void transpose_item(const float* W, int K, int N, bf16_t* WT, int ldw, int koff, LAS float* scr, int item, int lane) {
    const int nblk = N / 32, kb = item / nblk, nb = item % nblk, k0 = 64 * kb, n0 = 32 * nb;
    int r0 = n0; if (GATE_REMAP && n0 >= 4 * DM) { const int g = n0 - 4 * DM, j = g & (DM - 1); r0 = 4 * DM + (j >> 7) * 256 + (g >= DM ? 128 : 0) + (j & 127); }
#pragma unroll 8
    for (int i = 0; i < 32; ++i) { const int kk = 2 * i + (lane >> 5); scr[kk * 33 + (lane & 31)] = W[(size_t)(k0 + kk) * N + n0 + (lane & 31)]; }
    LDS_WAIT();
    const int c = lane & 7;
#pragma unroll
    for (int j = 0; j < 4; ++j) { const int n = (lane >> 3) + 8 * j; const LAS float* s = scr + (8 * c) * 33 + n;
        u32x4 o; o.x = pk2(s[0 * 33], s[1 * 33]); o.y = pk2(s[2 * 33], s[3 * 33]); o.z = pk2(s[4 * 33], s[5 * 33]); o.w = pk2(s[6 * 33], s[7 * 33]);
        *(u32x4*)(WT + (size_t)(r0 + n) * ldw + koff + k0 + 8 * c) = o; }
    LDS_WAIT();
}
__device__ __forceinline__ void rms_row_to_bf16(const float* xrow, const float* g, bf16_t* orow, int lane) {
    const f32x4* xr = (const f32x4*)xrow + lane; const f32x4* gr = (const f32x4*)g + lane;
    f32x4 v[4]; float s = 0.f;
#pragma unroll
    for (int j = 0; j < 4; ++j) { v[j] = xr[64 * j]; s += (v[j].x * v[j].x + v[j].y * v[j].y) + (v[j].z * v[j].z + v[j].w * v[j].w); }
    const float r = 1.0f / sqrtf(wave_sum(s) * (1.f / DM) + EPS);
    u32x2* o8 = (u32x2*)orow + lane;
#pragma unroll
    for (int j = 0; j < 4; ++j) { const f32x4 gv = gr[64 * j]; u32x2 o; o.x = pk2(v[j].x * r * gv.x, v[j].y * r * gv.y); o.y = pk2(v[j].z * r * gv.z, v[j].w * r * gv.w); o8[64 * j] = o; }
}
__device__ void p0_prologue(const Params& P, LAS unsigned char* lds) {
    const int tid = threadIdx.x, lane = tid & 63, wave = tid >> 6;
    LAS float* scr = (LAS float*)(lds + wave * 16384);
    const int gw = blockIdx.x * NWAVES + wave, NGW = gridDim.x * NWAVES;
    unsigned char* ws = P.ws;
    constexpr int I_IN = 16 * 192, I_SQ = 16 * 32, I_UP = 16 * 128, I_DN = 64 * 32, I_PP = 4 * 32;
    constexpr int NIT = I_IN + 4 * I_SQ + I_UP + I_DN + I_PP;
    for (int it = gw; it < NIT; it += NGW) {
        int r = it;
        if (r < I_IN) { transpose_item<true>(P.in[I_W_IN], DM, PROJW, (bf16_t*)(ws + WS_WIN), DM, 0, scr, r, lane); continue; } r -= I_IN;
        if (r < I_SQ) { transpose_item(P.in[I_W_BR_M], DM, DM, (bf16_t*)(ws + WS_WBR), 2 * DM, 0, scr, r, lane); continue; } r -= I_SQ;
        if (r < I_SQ) { transpose_item(P.in[I_W_BR_G], DM, DM, (bf16_t*)(ws + WS_WBR), 2 * DM, DM, scr, r, lane); continue; } r -= I_SQ;
        if (r < I_SQ) { transpose_item(P.in[I_W_OUT], DM, DM, (bf16_t*)(ws + WS_WOUT), DM, 0, scr, r, lane); continue; } r -= I_SQ;
        if (r < I_SQ) { transpose_item(P.in[I_W_PLE_GATE], DM, DM, (bf16_t*)(ws + WS_WPLE), PLEK, PLE, scr, r, lane); continue; } r -= I_SQ;
        if (r < I_UP) { transpose_item(P.in[I_W_UP], DM, DFF, (bf16_t*)(ws + WS_WUP), DM, 0, scr, r, lane); continue; } r -= I_UP;
        if (r < I_DN) { transpose_item(P.in[I_W_DOWN], DFF, DM, (bf16_t*)(ws + WS_WDN), DFF, 0, scr, r, lane); continue; } r -= I_DN;
        transpose_item(P.in[I_W_PLE_PROJ], PLE, DM, (bf16_t*)(ws + WS_WPLE), PLEK, 0, scr, r, lane);
    }
    {
        float* wcx = (float*)(ws + WS_WCX);
        const float* wq = P.in[I_WQ]; const float* wk = P.in[I_WK]; const float* wv = P.in[I_WV]; const float* wif = P.in[I_W_IF];
        for (int i = blockIdx.x * NTHR + tid; i < DM * 8; i += gridDim.x * NTHR) {
            const int c = i >> 3, j = i & 7, blk = c >> 2, d = c & 3; float sc = 0.f, sx = 0.f;
#pragma unroll
            for (int e = 0; e < 4; ++e) {
                sc += wq[blk * 16 + d * 4 + e] * wif[(size_t)(blk * 4 + e) * 8 + j] + wk[blk * 16 + d * 4 + e] * wif[(size_t)(DM + blk * 4 + e) * 8 + j];
                sx += wv[blk * 16 + d * 4 + e] * wif[(size_t)(2 * DM + blk * 4 + e) * 8 + j]; }
            wcx[i] = sc; wcx[DM * 8 + i] = sx;
        }
    }
    { bf16_t* wsp = (bf16_t*)(ws + WS_WSP); const float* w = P.in[I_W_SP];
      for (int i = blockIdx.x * NTHR + tid; i < 8 * 128 * 128; i += gridDim.x * NTHR) { const int t = (i >> 7) & 127, s = i & 127; wsp[i] = (bf16_t)f2bf(s <= t ? w[i] : 0.f); } }
    bf16_t* XN = (bf16_t*)(ws + WS_XN);
    for (int m = gw; m < NTOK; m += NGW) rms_row_to_bf16(P.in[I_X] + (size_t)m * DM, P.in[I_MIX_PRE_G], XN + (size_t)m * DM, lane);
}

namespace pg8 {
constexpr int BM = 256, BK = 64, HALF = 128, HTB = HALF * BK * 2, STAGE_BYTES = 8 * HTB, NXCD = 8, WGM = 8;
__host__ __device__ __forceinline__ int lds_byte(int r, int c) { const int st = (r >> 4) * 2 + (c >> 5), rr = r & 15, cc = c & 31, ob = rr * 64 + cc * 2; return st * 1024 + (ob ^ (((ob >> 9) & 1) << 5)); }
__host__ __device__ __forceinline__ void stage_rc(int b, int& R, int& C) { const int st = b / 1024, sb = b % 1024, swz = sb ^ (((sb >> 9) & 1) << 5); R = (st >> 1) * 16 + swz / 64; C = (st & 1) * 32 + (swz % 64) / 2; }
__host__ __device__ __forceinline__ int perm32(int rho) { const int n = rho >> 4, i = rho & 15; return 8 * (i >> 2) + 4 * n + (i & 3); }
struct Unit { int pm, pn; };
struct Gemm { const bf16_t* A; const bf16_t* Bt; int lda, ldb, M, N, K; };
struct StaticOrder {
    int nM, nN, nwg, G, c;
    __host__ __device__ void init(int M, int N, int G_, int c_) { nM = M / BM; nN = N / BM; nwg = nM * nN; G = G_; c = c_; }
    __host__ __device__ bool next(int i, Unit& u) const {
        const long L = (long)i * G + c; if (L >= nwg) return false;
        int wgid = (int)L; { const int q = nwg / NXCD, r = nwg % NXCD, xcd = wgid % NXCD, off = wgid / NXCD; wgid = (xcd < r ? xcd * (q + 1) : r * (q + 1) + (xcd - r) * q) + off; }
        const int nig = WGM * nN, gid = wgid / nig, fm = gid * WGM, gsz = (nM - fm) < WGM ? (nM - fm) : WGM;
        u.pm = fm + ((wgid % nig) % gsz); u.pn = (wgid % nig) / gsz; return true;
    }
};
template <class F> struct Epi8 {
    static constexpr bool PERM = true; F f;
    __device__ __forceinline__ void operator()(f32x4 (&acc)[2][2][4][2], const Unit& u_, int wr, int wc, int fr, int fq) const {
        Unit u = u_; asm volatile("" : "+s"(u.pm), "+s"(u.pn));
#pragma unroll
        for (int ai = 0; ai < 2; ++ai)
#pragma unroll
            for (int m = 0; m < 4; ++m)
                { f.store16(u.pm * BM + ai * HALF + wr * 64 + m * 16 + fr, u.pn, wc * 32 + 8 * fq, acc[ai][0][m][0], acc[ai][0][m][1], acc[ai][1][m][0], acc[ai][1][m][1], ai * 4 + m); asm volatile("" ::: "memory"); }
    }
    __device__ __forceinline__ void mid(f32x4 (&acc)[2][2][4][2], const Unit& u_, int wr, int wc, int fr, int fq) const {
        Unit u = u_; asm volatile("" : "+s"(u.pm), "+s"(u.pn));
#pragma unroll
        for (int ai = 0; ai < 2; ++ai)
#pragma unroll
            for (int m = 0; m < 4; ++m)
#pragma unroll
                for (int bj = 0; bj < 2; ++bj) { f.mid8(u.pm * BM + ai * HALF + wr * 64 + m * 16 + fr, u.pn * BM + bj * HALF + wc * 32 + 8 * fq, acc[ai][bj][m][0], acc[ai][bj][m][1], (ai * 4 + m) * 2 + bj); asm volatile("" ::: "memory"); }
    }
};
template <class F> struct Epi4 {
    static constexpr bool PERM = false; F f;
    __device__ __forceinline__ void operator()(f32x4 (&acc)[2][2][4][2], const Unit& u_, int wr, int wc, int fr, int fq) const {
        Unit u = u_; asm volatile("" : "+s"(u.pm), "+s"(u.pn));
#pragma unroll
        for (int ai = 0; ai < 2; ++ai)
#pragma unroll
            for (int m = 0; m < 4; ++m)
#pragma unroll
                for (int bj = 0; bj < 2; ++bj)
#pragma unroll
                    for (int n = 0; n < 2; ++n) { f.store4(u.pm * BM + ai * HALF + wr * 64 + m * 16 + fr, u.pn * BM + bj * HALF + wc * 32 + 16 * n + 4 * fq, acc[ai][bj][m][n], ((ai * 4 + m) * 2 + bj) * 2 + n); if (n) asm volatile("" ::: "memory"); }
    }
    __device__ __forceinline__ void mid(f32x4 (&acc)[2][2][4][2], const Unit& u_, int wr, int wc, int fr, int fq) const {
        Unit u = u_; asm volatile("" : "+s"(u.pm), "+s"(u.pn));
#pragma unroll
        for (int ai = 0; ai < 2; ++ai)
#pragma unroll
            for (int m = 0; m < 4; ++m)
#pragma unroll
                for (int bj = 0; bj < 2; ++bj)
#pragma unroll
                    for (int n = 0; n < 2; ++n) { f.mid4(u.pm * BM + ai * HALF + wr * 64 + m * 16 + fr, u.pn * BM + bj * HALF + wc * 32 + 16 * n + 4 * fq, acc[ai][bj][m][n], ((ai * 4 + m) * 2 + bj) * 2 + n); if (n) asm volatile("" ::: "memory"); }
    }
};
template <class Epi, int HOOK_T, bool ALIGN_EPI>
__device__ __forceinline__ void gemm_phase(LAS unsigned char* lds, const Gemm g, const StaticOrder& S, const Epi& E) {
    int tid_ = threadIdx.x; asm volatile("" : "+v"(tid_));
    const int tid = tid_, wid = __builtin_amdgcn_readfirstlane(tid >> 6), lane = tid & 63, wr = wid >> 2, wc = wid & 3, fr = lane & 15, fq = lane >> 4;
    const int K = g.K, nt = K / BK;
    unsigned voffA[2], voffB[2];
#pragma unroll
    for (int i = 0; i < 2; ++i) { int R, C; stage_rc(tid * 16 + i * 8192, R, C); const int Rb = Epi::PERM ? ((R & ~31) + perm32(R & 31)) : R;
        voffA[i] = (unsigned)(R * g.lda + C) * 2u; voffB[i] = (unsigned)(Rb * g.ldb + C) * 2u; }
    const size_t kstep = (size_t)(BK * 2);
    const size_t hstepA = (size_t)HALF * g.lda * 2, hstepB = (size_t)HALF * g.ldb * 2;
    const size_t tstepA = 2 * hstepA, tstepB = 2 * hstepB;
    const unsigned ldsw = (unsigned)wid * 1024u;
    const int aoff = lds_byte(wr * 64 + fr, fq * 8), boff = lds_byte(wc * 32 + fr, fq * 8);
#define PG8_SA(b, h) (((b) * 2 + (h)) * HTB)
#define PG8_SB(b, h) ((4 + (b) * 2 + (h)) * HTB)
#define PG8_STAGE(bufoff, gbase, voff) do { _Pragma("unroll") for (int _i = 0; _i < 2; ++_i) \
        __builtin_amdgcn_global_load_lds((const unsigned*)((const char*)(gbase) + (voff)[_i]), (LAS unsigned*)(lds + (bufoff) + ldsw + _i * 8192), 16, 0, 0); } while (0)
#define PG8_LDA(dst, b, h) do { _Pragma("unroll") for (int m = 0; m < 4; ++m) _Pragma("unroll") for (int k = 0; k < 2; ++k) dst[m][k] = *(const LAS bf16x8*)(lds + PG8_SA(b, h) + aoff + m * 2048 + k * 1024); } while (0)
#define PG8_LDB(dst, b, h) do { _Pragma("unroll") for (int n = 0; n < 2; ++n) _Pragma("unroll") for (int k = 0; k < 2; ++k) dst[n][k] = *(const LAS bf16x8*)(lds + PG8_SB(b, h) + boff + n * 2048 + k * 1024); } while (0)
#define PG8_MMA(ai, bj, At, Bt) do { __builtin_amdgcn_s_setprio(1); _Pragma("unroll") for (int m = 0; m < 4; ++m) _Pragma("unroll") for (int n = 0; n < 2; ++n) _Pragma("unroll") for (int k = 0; k < 2; ++k) \
        acc[ai][bj][m][n] = __builtin_amdgcn_mfma_f32_16x16x32_bf16(Bt[n][k], At[m][k], acc[ai][bj][m][n], 0, 0, 0); __builtin_amdgcn_s_setprio(0); } while (0)
#define PG8_WAIT_V(n) asm volatile("s_waitcnt vmcnt(" #n ")" ::: "memory")
#define PG8_WAIT_L(n) asm volatile("s_waitcnt lgkmcnt(" #n ")" ::: "memory")
#define PG8_BAR __builtin_amdgcn_s_barrier()
#define PG8_SCHED __builtin_amdgcn_sched_barrier(0)
    Unit cur, nxt; int ui = 0;
    if (!S.next(0, cur)) return;
    f32x4 acc[2][2][4][2];
#pragma unroll
    for (int a = 0; a < 2; ++a)
#pragma unroll
        for (int b = 0; b < 2; ++b)
#pragma unroll
            for (int m = 0; m < 4; ++m)
#pragma unroll
                for (int n = 0; n < 2; ++n) acc[a][b][m][n] = (f32x4){0.f, 0.f, 0.f, 0.f};
    bf16x8 At[4][2], B0[2][2], B1[2][2];
    const char* cA = (const char*)g.A + (size_t)cur.pm * tstepA; const char* cB = (const char*)g.Bt + (size_t)cur.pn * tstepB;
    PG8_STAGE(PG8_SB(0, 0), cB, voffB); PG8_STAGE(PG8_SB(0, 1), cB + hstepB, voffB); PG8_STAGE(PG8_SA(0, 0), cA, voffA); PG8_STAGE(PG8_SA(0, 1), cA + hstepA, voffA);
    if (wr == 1) PG8_BAR;
    PG8_WAIT_V(2); PG8_BAR;
    PG8_STAGE(PG8_SB(1, 0), cB + kstep, voffB); PG8_STAGE(PG8_SA(1, 0), cA + kstep, voffA); PG8_STAGE(PG8_SB(1, 1), cB + hstepB + kstep, voffB);
    PG8_WAIT_V(6); PG8_BAR;
    for (;;) {
        const bool has_next = S.next(ui + 1, nxt);
        const char* nA = has_next ? (const char*)g.A + (size_t)nxt.pm * tstepA : cA; const char* nB = has_next ? (const char*)g.Bt + (size_t)nxt.pn * tstepB : cB;
#define PG8_KBODY() do { \
            const bool last = (t == nt - 2); \
            const char* a1 = cA + (size_t)(t + 1) * kstep; \
            const char* a2 = last ? nA : cA + (size_t)(t + 2) * kstep; const char* b2 = last ? nB : cB + (size_t)(t + 2) * kstep; \
            const char* a3 = a2 + kstep; const char* b3 = b2 + kstep; \
            PG8_LDB(B0, 0, 0); PG8_LDB(B1, 0, 1); PG8_SCHED; PG8_LDA(At, 0, 0); PG8_STAGE(PG8_SA(1, 1), a1 + hstepA, voffA); \
            PG8_WAIT_V(8); PG8_WAIT_L(0); PG8_BAR; PG8_MMA(0, 0, At, B0); PG8_MMA(0, 1, At, B1); PG8_BAR; PG8_SCHED; \
            PG8_LDA(At, 0, 1); PG8_STAGE(PG8_SB(0, 0), b2, voffB); PG8_STAGE(PG8_SB(0, 1), b2 + hstepB, voffB); PG8_STAGE(PG8_SA(0, 0), a2, voffA); \
            PG8_WAIT_V(8); PG8_WAIT_L(0); PG8_BAR; PG8_MMA(1, 0, At, B0); PG8_MMA(1, 1, At, B1); PG8_BAR; PG8_SCHED; \
            PG8_LDB(B0, 1, 0); PG8_LDB(B1, 1, 1); PG8_SCHED; PG8_LDA(At, 1, 0); PG8_STAGE(PG8_SA(0, 1), a2 + hstepA, voffA); \
            PG8_WAIT_V(8); PG8_WAIT_L(0); PG8_BAR; PG8_MMA(0, 0, At, B0); PG8_MMA(0, 1, At, B1); PG8_BAR; PG8_SCHED; \
            PG8_LDA(At, 1, 1); PG8_STAGE(PG8_SB(1, 0), b3, voffB); PG8_STAGE(PG8_SB(1, 1), b3 + hstepB, voffB); PG8_STAGE(PG8_SA(1, 0), a3, voffA); \
            PG8_WAIT_V(8); PG8_WAIT_L(0); PG8_BAR; PG8_MMA(1, 0, At, B0); PG8_MMA(1, 1, At, B1); PG8_BAR; PG8_SCHED; \
        } while (0)
        int t = 0;
        if constexpr (HOOK_T > 0) {
            for (; t < HOOK_T; t += 2) PG8_KBODY();
            PG8_SCHED; E.mid(acc, cur, wr, wc, fr, fq); PG8_SCHED;
        }
        for (; t < nt; t += 2) PG8_KBODY();
#undef PG8_KBODY
        if constexpr (ALIGN_EPI) { if (wr == 0) PG8_BAR; }
        E(acc, cur, wr, wc, fr, fq);
        if (!has_next) break;
#pragma unroll
        for (int a = 0; a < 2; ++a)
#pragma unroll
            for (int b = 0; b < 2; ++b)
#pragma unroll
                for (int m = 0; m < 4; ++m)
#pragma unroll
                    for (int n = 0; n < 2; ++n) acc[a][b][m][n] = (f32x4){0.f, 0.f, 0.f, 0.f};
        cur = nxt; cA = nA; cB = nB; ++ui;
        if constexpr (ALIGN_EPI) { if (wr == 1) PG8_BAR; }
    }
    PG8_WAIT_V(0);
    if constexpr (!ALIGN_EPI) { if (wr == 0) PG8_BAR; }
    PG8_BAR;
#undef PG8_SA
#undef PG8_SB
#undef PG8_STAGE
#undef PG8_LDA
#undef PG8_LDB
#undef PG8_MMA
#undef PG8_WAIT_V
#undef PG8_WAIT_L
#undef PG8_BAR
#undef PG8_SCHED
}
}
__device__ __forceinline__ void st_bf16x8(bf16_t* p, f32x4 a, f32x4 b) { u32x4 o; o.x = pk2(a.x, a.y); o.y = pk2(a.z, a.w); o.z = pk2(b.x, b.y); o.w = pk2(b.z, b.w); *(u32x4*)p = o; }
__device__ __forceinline__ void ld_bf16x8(const bf16_t* p, f32x4& a, f32x4& b) { const u32x4 w = *(const u32x4*)p; a = (f32x4){bflo(w.x), bfhi(w.x), bflo(w.y), bfhi(w.y)}; b = (f32x4){bflo(w.z), bfhi(w.z), bflo(w.w), bfhi(w.w)}; }
template <class FN> __device__ __forceinline__ f32x4 map4(f32x4 v, FN fn) { return (f32x4){fn(v.x), fn(v.y), fn(v.z), fn(v.w)}; }
struct ProjF {
    bf16_t* proj;
    __device__ __forceinline__ void store16(int row, int pn, int cl, f32x4 a0, f32x4 a1, f32x4 b0, f32x4 b1, int) const {
        bf16_t* rp = proj + (size_t)row * PROJW;
        if (pn < 16) {
            const int sec = pn >> 2;
            if (sec == 1) { a0 = map4(a0, siluf_); a1 = map4(a1, siluf_); b0 = map4(b0, siluf_); b1 = map4(b1, siluf_); }
            else if (sec >= 2) { a0 = map4(a0, gelu_tanh); a1 = map4(a1, gelu_tanh); b0 = map4(b0, gelu_tanh); b1 = map4(b1, gelu_tanh); }
            st_bf16x8(rp + pn * 256 + cl, a0, a1); st_bf16x8(rp + pn * 256 + 128 + cl, b0, b1);
        } else {
            const int j = (pn - 16) * 128 + cl;
            a0 = map4(a0, sigmoidf_); a1 = map4(a1, sigmoidf_); b0 = map4(b0, sigmoidf_); b1 = map4(b1, sigmoidf_);
            st_bf16x8(rp + 4 * DM + j, a0 / b0, a1 / b1); st_bf16x8(rp + 5 * DM + j, b0, b1);
        }
    }
    __device__ __forceinline__ void mid8(int, int, f32x4&, f32x4&, int) const {}
};
struct MergeF {
    const bf16_t* proj; bf16_t* merged;
    __device__ __forceinline__ void mid8(int row, int col, f32x4& a, f32x4& b, int) const {
        f32x4 r0, r1; ld_bf16x8(proj + (size_t)row * PROJW + 4 * DM + col, r0, r1); a = a * r0; b = b * r1;
    }
    __device__ __forceinline__ void store16(int row, int pn, int cl, f32x4 a0, f32x4 a1, f32x4 b0, f32x4 b1, int) const {
        const int col = pn * 256 + cl; f32x4 g0, g1;
        ld_bf16x8(proj + (size_t)row * PROJW + 5 * DM + col, g0, g1); st_bf16x8(merged + (size_t)row * DM + col, a0 * g0, a1 * g1);
        ld_bf16x8(proj + (size_t)row * PROJW + 5 * DM + col + 128, g0, g1); st_bf16x8(merged + (size_t)row * DM + col + 128, b0 * g0, b1 * g1);
    }
};
struct Bf16F {
    bf16_t* o; int ldc;
    __device__ __forceinline__ void store16(int row, int pn, int cl, f32x4 a0, f32x4 a1, f32x4 b0, f32x4 b1, int) const {
        bf16_t* p = o + (size_t)row * ldc + pn * 256 + cl; st_bf16x8(p, a0, a1); st_bf16x8(p + 128, b0, b1);
    }
    __device__ __forceinline__ void mid8(int, int, f32x4&, f32x4&, int) const {}
};
struct Relu2F {
    bf16_t* o; int ldc;
    __device__ __forceinline__ void store16(int row, int pn, int cl, f32x4 a0, f32x4 a1, f32x4 b0, f32x4 b1, int) const {
        auto r2 = [](float x) { const float r = fmaxf(x, 0.f); return r * r; };
        bf16_t* p = o + (size_t)row * ldc + pn * 256 + cl;
        st_bf16x8(p, map4(a0, r2), map4(a1, r2)); st_bf16x8(p + 128, map4(b0, r2), map4(b1, r2));
    }
    __device__ __forceinline__ void mid8(int, int, f32x4&, f32x4&, int) const {}
};
struct PleF {
    bf16_t* o; f32x4* stash;
    __device__ __forceinline__ void mid8(int, int, f32x4& a, f32x4& b, int idx2) const {
        unsigned t = threadIdx.x; asm volatile("" : "+v"(t));
        f32x4* s = stash + ((size_t)blockIdx.x * 32 + idx2 * 2) * NTHR + t; s[0] = a; s[NTHR] = b; a = (f32x4){0.f, 0.f, 0.f, 0.f}; b = (f32x4){0.f, 0.f, 0.f, 0.f};
    }
    __device__ __forceinline__ void store16(int row, int pn, int cl, f32x4 a0, f32x4 a1, f32x4 b0, f32x4 b1, int idx) const {
        unsigned t = threadIdx.x; asm volatile("" : "+v"(t));
        const f32x4* s = stash + ((size_t)blockIdx.x * 32 + idx * 4) * NTHR + t;
        bf16_t* p = o + (size_t)row * DM + pn * 256 + cl;
        st_bf16x8(p, map4(a0, sigmoidf_) * s[0], map4(a1, sigmoidf_) * s[NTHR]); st_bf16x8(p + 128, map4(b0, sigmoidf_) * s[2 * NTHR], map4(b1, sigmoidf_) * s[3 * NTHR]);
    }
};

__device__ __forceinline__ void ld4(const bf16_t* p, float (&x)[4]) { const u32x2 w = *(const u32x2*)p; x[0] = bflo(w.x); x[1] = bfhi(w.x); x[2] = bflo(w.y); x[3] = bfhi(w.y); }
__device__ __forceinline__ void up4(u32x2 w, float (&x)[4]) { x[0] = bflo(w.x); x[1] = bfhi(w.x); x[2] = bflo(w.y); x[3] = bfhi(w.y); }
__device__ __forceinline__ void st4(bf16_t* p, const float (&x)[4]) { u32x2 o; o.x = pk2(x[0], x[1]); o.y = pk2(x[2], x[3]); *(u32x2*)p = o; }
__device__ void p2_qkv(const Params& P, LAS unsigned char* lds) {
    const int tid = threadIdx.x, lane = tid & 63, wave = tid >> 6, h = wave & 3, half = wave >> 2;
    unsigned char* ws = P.ws;
    const bf16_t* PROJ = (const bf16_t*)(ws + WS_PROJ);
    bf16_t* Q = (bf16_t*)P.out; bf16_t* K = Q + (size_t)NTOK * DM; bf16_t* V = (bf16_t*)(ws + WS_XN);
    float* GATES = (float*)(ws + WS_GATES);
    LAS float* part = (LAS float*)lds;
    const int ch = h * 256 + lane * 4, blk = ch >> 2;
    float cw[4][4], cb[4], wq[4][4], wk[4][4], wv[4][4], wc[4][8], wx[4][8];
#pragma unroll
    for (int j = 0; j < 4; ++j)
#pragma unroll
        for (int d = 0; d < 4; ++d) cw[j][d] = P.in[I_CONV_W][j * DM + ch + d];
#pragma unroll
    for (int d = 0; d < 4; ++d) { cb[d] = P.in[I_CONV_B][ch + d];
#pragma unroll
        for (int e = 0; e < 4; ++e) { wq[d][e] = P.in[I_WQ][blk * 16 + d * 4 + e]; wk[d][e] = P.in[I_WK][blk * 16 + d * 4 + e]; wv[d][e] = P.in[I_WV][blk * 16 + d * 4 + e]; }
#pragma unroll
        for (int j = 0; j < 8; ++j) { wc[d][j] = ((const float*)(ws + WS_WCX))[(ch + d) * 8 + j]; wx[d][j] = ((const float*)(ws + WS_WCX))[DM * 8 + (ch + d) * 8 + j]; } }
    for (int item = blockIdx.x; item < NTOK / 16; item += gridDim.x) {
        const int tb = item * 16 + half * 8;
        u32x2 raw[11];
        const bool seq0 = (tb & (SEQ - 1)) == 0;
#pragma unroll
        for (int i = 0; i < 11; ++i) raw[i] = (i < 3 && seq0) ? (u32x2){0u, 0u} : *(const u32x2*)(PROJ + (size_t)(tb - 3 + i) * PROJW + ch);
        float x0[4], x1[4], x2[4], x3[4];
        up4(raw[0], x0); up4(raw[1], x1); up4(raw[2], x2);
#pragma unroll
        for (int i = 0; i < 8; ++i) {
            const int t = tb + i;
            up4(raw[3 + i], x3);
            float mc[4], q[4], k[4], v[4], gp[8];
#pragma unroll
            for (int d = 0; d < 4; ++d) mc[d] = siluf_(cw[0][d] * x0[d] + cw[1][d] * x1[d] + cw[2][d] * x2[d] + cw[3][d] * x3[d] + cb[d]);
#pragma unroll
            for (int e = 0; e < 4; ++e) { q[e] = mc[0] * wq[0][e] + mc[1] * wq[1][e] + mc[2] * wq[2][e] + mc[3] * wq[3][e];
                k[e] = mc[0] * wk[0][e] + mc[1] * wk[1][e] + mc[2] * wk[2][e] + mc[3] * wk[3][e];
                v[e] = x3[0] * wv[0][e] + x3[1] * wv[1][e] + x3[2] * wv[2][e] + x3[3] * wv[3][e]; }
            st4(Q + (size_t)t * DM + ch, q); st4(K + (size_t)t * DM + ch, k); st4(V + (size_t)t * DM + ch, v);
#pragma unroll
            for (int j = 0; j < 8; ++j) { float s = 0.f;
#pragma unroll
                for (int d = 0; d < 4; ++d) s += mc[d] * wc[d][j] + x3[d] * wx[d][j];
                gp[j] = wave_sum(s); }
            if (lane == 0) {
#pragma unroll
                for (int j = 0; j < 8; ++j) part[((half * 8 + i) * 4 + h) * 8 + j] = gp[j]; }
#pragma unroll
            for (int d = 0; d < 4; ++d) { x0[d] = x1[d]; x1[d] = x2[d]; x2[d] = x3[d]; }
        }
        __syncthreads();
        if (tid < 128) { const int tok = tid >> 3, j = tid & 7;
            const float val = part[(tok * 4 + 0) * 8 + j] + part[(tok * 4 + 1) * 8 + j] + part[(tok * 4 + 2) * 8 + j] + part[(tok * 4 + 3) * 8 + j] + P.in[I_B_IF][j];
            GATES[(size_t)(item * 16 + tok) * 8 + j] = (j < 4) ? val : log_sigmoid(val); }
        __syncthreads();
    }
    bf16_t* PW = (bf16_t*)(ws + WS_PROJ);
    const int gw = blockIdx.x * NWAVES + wave, NGW = gridDim.x * NWAVES;
    for (int m = gw; m < NTOK; m += NGW) {
        bf16_t* row = PW + (size_t)m * PROJW + 3 * DM + lane * 16;
        const u32x4 a = *(const u32x4*)row, b = *(const u32x4*)(row + 8);
        float x[16] = {bflo(a.x), bfhi(a.x), bflo(a.y), bfhi(a.y), bflo(a.z), bfhi(a.z), bflo(a.w), bfhi(a.w), bflo(b.x), bfhi(b.x), bflo(b.y), bfhi(b.y), bflo(b.z), bfhi(b.z), bflo(b.w), bfhi(b.w)};
        float s = 0.f;
#pragma unroll
        for (int i = 0; i < 16; ++i) s += x[i];
        const float mu = wave_sum(s) * (1.f / DM); float s2 = 0.f;
#pragma unroll
        for (int i = 0; i < 16; ++i) { x[i] -= mu; s2 += x[i] * x[i]; }
        const float r = 1.0f / sqrtf(wave_sum(s2) * (1.f / DM) + EPS);
        const float* lw = P.in[I_G_LN_W] + lane * 16; const float* lb = P.in[I_G_LN_B] + lane * 16;
#pragma unroll
        for (int i = 0; i < 16; ++i) x[i] = x[i] * r * lw[i] + lb[i];
        u32x4 oa, ob; oa.x = pk2(x[0], x[1]); oa.y = pk2(x[2], x[3]); oa.z = pk2(x[4], x[5]); oa.w = pk2(x[6], x[7]); ob.x = pk2(x[8], x[9]); ob.y = pk2(x[10], x[11]); ob.z = pk2(x[12], x[13]); ob.w = pk2(x[14], x[15]);
        *(u32x4*)row = oa; *(u32x4*)(row + 8) = ob;
    }
}

constexpr int ML_C = 0, ML_N = 65536, ML_Q = ML_N + 1024, ML_K = ML_Q + 32768, ML_V = ML_K + 32768, ML_P = ML_V + 8192, ML_S = ML_P + 16384, ML_BYTES = ML_S + 2048;
__device__ void p3_mlstm_naive(const Params& P, LAS unsigned char* lds) {
    const int tid = threadIdx.x, lane = tid & 63, wave = tid >> 6;
    unsigned char* ws = P.ws;
    const bf16_t* Q = (const bf16_t*)P.out; const bf16_t* K = Q + (size_t)NTOK * DM; bf16_t* V = (bf16_t*)(ws + WS_XN);
    const float* GATES = (const float*)(ws + WS_GATES);
    LAS float* Cs = (LAS float*)(lds + ML_C); LAS float* ns = (LAS float*)(lds + ML_N);
    LAS unsigned* qs = (LAS unsigned*)(lds + ML_Q); LAS unsigned* ks = (LAS unsigned*)(lds + ML_K);
    LAS bf16_t* vs = (LAS bf16_t*)(lds + ML_V);
    LAS float* Ps = (LAS float*)(lds + ML_P);
    LAS float* sc = (LAS float*)(lds + ML_S);
    for (int item = blockIdx.x; item < 256; item += gridDim.x) {
        const int b = item >> 4, h = (item >> 2) & 3, j = item & 3;
        for (int i = tid; i < 256 * 64; i += NTHR) Cs[i] = 0.f;
        if (tid < 256) ns[tid] = 0.f;
        float m = 0.f;
        __syncthreads();
        for (int c = 0; c < 32; ++c) {
            const size_t t0 = (size_t)b * SEQ + c * 64;
#pragma unroll
            for (int i = 0; i < 4; ++i) { const int p = tid + i * NTHR, r = p >> 5, cc = p & 31;
                *(LAS u32x4*)(qs + r * 128 + cc * 4) = *(const u32x4*)(Q + (t0 + r) * DM + h * 256 + cc * 8);
                *(LAS u32x4*)(ks + r * 128 + cc * 4) = *(const u32x4*)(K + (t0 + r) * DM + h * 256 + cc * 8); }
            { const int r = tid >> 3, cc = tid & 7; *(LAS u32x4*)(vs + r * 64 + cc * 8) = *(const u32x4*)(V + (t0 + r) * DM + h * 256 + j * 64 + cc * 8); }
            if (wave == 0) {
                const float ig = GATES[(t0 + lane) * 8 + h], lf = GATES[(t0 + lane) * 8 + 4 + h];
                float bs = lf;
#pragma unroll
                for (int o = 1; o < 64; o <<= 1) { const float t = __shfl_up(bs, o); if (lane >= o) bs += t; }
                const float u = ig - bs; float gm = u;
#pragma unroll
                for (int o = 1; o < 64; o <<= 1) { const float t = __shfl_up(gm, o); if (lane >= o) gm = fmaxf(gm, t); }
                const float g = fmaxf(gm, m), gL = __shfl(g, 63), bL = __shfl(bs, 63);
                sc[lane] = u; sc[64 + lane] = g; sc[128 + lane] = expf(m - g); sc[192 + lane] = expf(-bs - g); sc[256 + lane] = expf(u - gL);
                if (lane == 0) sc[384] = expf(m - gL);
                m = bL + gL;
            }
            __syncthreads();
            { const int t = tid >> 3, sg = tid & 7; float acc[8];
#pragma unroll
                for (int i = 0; i < 8; ++i) acc[i] = 0.f;
                if (sg * 8 <= t) {
                    for (int d2 = 0; d2 < 128; ++d2) { const unsigned qw = qs[t * 128 + d2]; const float ql = bflo(qw), qh = bfhi(qw);
#pragma unroll
                        for (int i = 0; i < 8; ++i) { const unsigned kw = ks[(sg * 8 + i) * 128 + d2]; acc[i] += ql * bflo(kw) + qh * bfhi(kw); } } }
                const float gt = sc[64 + t];
#pragma unroll
                for (int i = 0; i < 8; ++i) { const int s = sg * 8 + i; Ps[t * 64 + s] = (s <= t) ? acc[i] * 0.0625f * expf(sc[s] - gt) : 0.f; } }
            __syncthreads();
            if (tid < 64) { const int t = tid; float qn = 0.f;
                for (int d2 = 0; d2 < 128; ++d2) { const unsigned qw = qs[t * 128 + d2]; qn += bflo(qw) * ns[2 * d2] + bfhi(qw) * ns[2 * d2 + 1]; }
                float ps = 0.f;
                for (int s = 0; s <= t; ++s) ps += Ps[t * 64 + s];
                sc[320 + t] = sc[128 + t] * qn + ps; }
            __syncthreads();
            { const int t = tid >> 3, eg = tid & 7; float acc[8];
#pragma unroll
                for (int i = 0; i < 8; ++i) acc[i] = 0.f;
                for (int d2 = 0; d2 < 128; ++d2) { const unsigned qw = qs[t * 128 + d2]; const float ql = bflo(qw), qh = bfhi(qw);
#pragma unroll
                    for (int i = 0; i < 8; ++i) acc[i] += ql * Cs[(2 * d2) * 64 + eg * 8 + i] + qh * Cs[(2 * d2 + 1) * 64 + eg * 8 + i]; }
                const float iw = sc[128 + t];
#pragma unroll
                for (int i = 0; i < 8; ++i) acc[i] *= iw;
                for (int s = 0; s <= t; ++s) { const float pv = Ps[t * 64 + s];
#pragma unroll
                    for (int i = 0; i < 8; ++i) acc[i] += pv * bf2f(vs[s * 64 + eg * 8 + i]); }
                const float dn = 1.0f / fmaxf(fabsf(sc[320 + t]), sc[192 + t]);
                u32x4 o; o.x = pk2(acc[0] * dn, acc[1] * dn); o.y = pk2(acc[2] * dn, acc[3] * dn); o.z = pk2(acc[4] * dn, acc[5] * dn); o.w = pk2(acc[6] * dn, acc[7] * dn);
                *(u32x4*)(V + (t0 + t) * DM + h * 256 + j * 64 + eg * 8) = o;
            }
            __syncthreads();
            { const int d = tid >> 1, eh = tid & 1; const float decay = sc[384]; float acc[32];
#pragma unroll
                for (int i = 0; i < 32; ++i) acc[i] = decay * Cs[d * 64 + eh * 32 + i];
                float nacc = decay * ns[d];
                for (int s = 0; s < 64; ++s) { const unsigned kw = ks[s * 128 + (d >> 1)]; const float kv = ((d & 1) ? bfhi(kw) : bflo(kw)) * 0.0625f * sc[256 + s];
                    nacc += kv;
#pragma unroll
                    for (int i = 0; i < 32; ++i) acc[i] += kv * bf2f(vs[s * 64 + eh * 32 + i]); }
#pragma unroll
                for (int i = 0; i < 32; ++i) Cs[d * 64 + eh * 32 + i] = acc[i];
                if (eh == 0) ns[d] = nacc; }
            __syncthreads();
        }
    }
}

__device__ void p3_gmlp_naive(const Params& P, LAS unsigned char* lds) {
    const int tid = threadIdx.x;
    bf16_t* PROJ = (bf16_t*)(P.ws + WS_PROJ);
    LAS bf16_t* vv = (LAS bf16_t*)lds;
    const float* WSP = P.in[I_W_SP]; const float* BSP = P.in[I_B_SP];
    for (int item = blockIdx.x; item < 2048; item += gridDim.x) {
        const int g = item & 7, c = (item >> 3) & 15, b = item >> 7; const size_t t0 = (size_t)b * SEQ + c * 128;
#pragma unroll
        for (int i = 0; i < 4; ++i) { const int p = tid + i * NTHR, r = p >> 4, cc = p & 15; *(LAS u32x4*)(vv + r * 128 + cc * 8) = *(const u32x4*)(PROJ + (t0 + r) * PROJW + 3 * DM + g * 128 + cc * 8); }
        __syncthreads();
        const int t = tid >> 2, dg = tid & 3; float acc[32];
#pragma unroll
        for (int i = 0; i < 32; ++i) acc[i] = 0.f;
        const float* wrow = WSP + ((size_t)g * 128 + t) * 128;
        for (int s = 0; s <= t; ++s) { const float w = wrow[s];
#pragma unroll
            for (int i = 0; i < 32; ++i) acc[i] += w * bf2f(vv[s * 128 + dg * 32 + i]); }
        const float bs = BSP[g * 128 + t];
        bf16_t* gu = PROJ + (t0 + t) * PROJW + 2 * DM + g * 128 + dg * 32;
#pragma unroll
        for (int i = 0; i < 4; ++i) { const u32x4 w = *(const u32x4*)(gu + i * 8); u32x4 o;
            o.x = pk2(bflo(w.x) * (acc[i * 8 + 0] + bs), bfhi(w.x) * (acc[i * 8 + 1] + bs)); o.y = pk2(bflo(w.y) * (acc[i * 8 + 2] + bs), bfhi(w.y) * (acc[i * 8 + 3] + bs));
            o.z = pk2(bflo(w.z) * (acc[i * 8 + 4] + bs), bfhi(w.z) * (acc[i * 8 + 5] + bs)); o.w = pk2(bflo(w.w) * (acc[i * 8 + 6] + bs), bfhi(w.w) * (acc[i * 8 + 7] + bs));
            *(u32x4*)(gu + i * 8) = o; }
        __syncthreads();
    }
}

namespace mlm {
constexpr int QP = 264, VP = 88, PP = 72;
constexpr int QS_OFF = 0, KS_OFF = QS_OFF + 64 * QP * 2, VS_OFF = KS_OFF + 64 * QP * 2, CT_OFF = VS_OFF + 64 * VP * 2, PS_OFF = CT_OFF + 80 * QP * 2, SC_OFF = PS_OFF + 64 * PP * 2, BYTES = SC_OFF + 2048;
typedef short s16x4 __attribute__((ext_vector_type(4)));
typedef float f32x2_t __attribute__((ext_vector_type(2)));
typedef __bf16 bf16x2_t __attribute__((ext_vector_type(2)));
__device__ __forceinline__ unsigned cvtpk(float lo, float hi) { f32x2_t v = {lo, hi}; bf16x2_t b = __builtin_convertvector(v, bf16x2_t); return __builtin_bit_cast(unsigned, b); }
__device__ __forceinline__ s16x4 tr16(LAS unsigned char* p) { return __builtin_bit_cast(s16x4, __builtin_amdgcn_ds_read_tr16_b64_v4i16((LAS s16x4*)p)); }
__device__ __forceinline__ bf16x8 frag_tr(LAS unsigned char* p, int pitch_bytes) {
    const s16x4 lo = tr16(p), hi = tr16(p + 4 * pitch_bytes);
    return (bf16x8){lo.x, lo.y, lo.z, lo.w, hi.x, hi.y, hi.z, hi.w};
}
}
__device__ void p3_mlstm_mfma(const Params& P, LAS unsigned char* lds) {
    using namespace mlm;
    const int tid = threadIdx.x, lane = tid & 63, wave = __builtin_amdgcn_readfirstlane(tid >> 6), fr = lane & 15, fq = lane >> 4, q_ = fr >> 2, p_ = fr & 3;
    const int tau = wave >> 1, par = wave & 1;
    unsigned char* ws = P.ws;
    const bf16_t* Q = (const bf16_t*)P.out; const bf16_t* K = Q + (size_t)NTOK * DM; bf16_t* V = (bf16_t*)(ws + WS_XN);
    const float* GATES = (const float*)(ws + WS_GATES);
    LAS float* sc = (LAS float*)(lds + SC_OFF);
    for (int item = blockIdx.x; item < 256; item += gridDim.x) {
        const int b = item >> 4, h = (item >> 2) & 3, j = item & 3;
        for (int i = tid; i < 80 * QP * 2 / 16; i += NTHR) ((LAS u32x4*)(lds + CT_OFF))[i] = (u32x4){0u, 0u, 0u, 0u};
        if (tid < 64) { LAS bf16_t* r = (LAS bf16_t*)(lds + VS_OFF) + tid * VP + 64; r[0] = 0x3F80;
#pragma unroll
            for (int i = 1; i < 24; ++i) r[i] = 0; }
        f32x4 cacc[2][5];
#pragma unroll
        for (int a = 0; a < 2; ++a)
#pragma unroll
            for (int e = 0; e < 5; ++e) cacc[a][e] = (f32x4){0.f, 0.f, 0.f, 0.f};
        float m = 0.f;
        u32x4 pq[4], pk[4], pv; float pig = 0.f, plf = 0.f;
        const bf16_t* qb = Q + (size_t)b * SEQ * DM + h * 256; const bf16_t* kb = K + (size_t)b * SEQ * DM + h * 256; bf16_t* vb = V + (size_t)b * SEQ * DM + h * 256 + j * 64;
#define ML_LOAD(c_) do { const size_t r0_ = (size_t)(c_) * 64; \
            _Pragma("unroll") for (int i = 0; i < 4; ++i) { const int p = tid + i * NTHR, r = p >> 5, cc = p & 31; pq[i] = *(const u32x4*)(qb + (r0_ + r) * DM + cc * 8); pk[i] = *(const u32x4*)(kb + (r0_ + r) * DM + cc * 8); } \
            pv = *(const u32x4*)(vb + (r0_ + (tid >> 3)) * DM + (tid & 7) * 8); \
            if (wave == 0) { pig = GATES[((size_t)b * SEQ + r0_ + lane) * 8 + h]; plf = GATES[((size_t)b * SEQ + r0_ + lane) * 8 + 4 + h]; } } while (0)
        ML_LOAD(0);
        __syncthreads();
        for (int c = 0; c < 32; ++c) {
#pragma unroll
            for (int i = 0; i < 4; ++i) { const int p = tid + i * NTHR, r = p >> 5, cc = p & 31; *(LAS u32x4*)(lds + QS_OFF + r * QP * 2 + cc * 16) = pq[i]; *(LAS u32x4*)(lds + KS_OFF + r * QP * 2 + cc * 16) = pk[i]; }
            *(LAS u32x4*)(lds + VS_OFF + (tid >> 3) * VP * 2 + (tid & 7) * 16) = pv;
            if (wave == 0) {
                float bs = plf;
#pragma unroll
                for (int o = 1; o < 64; o <<= 1) { const float t = __shfl_up(bs, o); if (lane >= o) bs += t; }
                const float u = pig - bs; float gm = u;
#pragma unroll
                for (int o = 1; o < 64; o <<= 1) { const float t = __shfl_up(gm, o); if (lane >= o) gm = fmaxf(gm, t); }
                const float g = fmaxf(gm, m), gL = __shfl(g, 63), bL = __shfl(bs, 63);
                sc[lane] = u; sc[64 + lane] = g; sc[128 + lane] = expf(m - g); sc[192 + lane] = expf(-bs - g); sc[256 + lane] = expf(u - gL) * 0.0625f;
                if (lane == 0) sc[320] = expf(m - gL);
                m = bL + gL;
            }
            __syncthreads();
            if (c + 1 < 32) ML_LOAD(c + 1);
            bf16x8 qf[8];
#pragma unroll
            for (int kap = 0; kap < 8; ++kap) qf[kap] = *(const LAS bf16x8*)(lds + QS_OFF + ((16 * tau + fr) * QP + 32 * kap + 8 * fq) * 2);
            const float gt = sc[64 + 16 * tau + fr];
#pragma unroll
            for (int si = 0; si < 2; ++si) {
                const int sig = 2 * par + si; f32x4 acc = (f32x4){0.f, 0.f, 0.f, 0.f};
                if (sig <= tau) {
#pragma unroll
                    for (int kap = 0; kap < 8; ++kap) acc = __builtin_amdgcn_mfma_f32_16x16x32_bf16(*(const LAS bf16x8*)(lds + KS_OFF + ((16 * sig + fr) * QP + 32 * kap + 8 * fq) * 2), qf[kap], acc, 0, 0, 0);
                }
                const f32x4 us = *(const LAS f32x4*)(sc + 16 * sig + 4 * fq);
                const int t = 16 * tau + fr, s0 = 16 * sig + 4 * fq;
                const float w0 = (s0 + 0 <= t) ? acc.x * 0.0625f * __expf(us.x - gt) : 0.f, w1 = (s0 + 1 <= t) ? acc.y * 0.0625f * __expf(us.y - gt) : 0.f;
                const float w2 = (s0 + 2 <= t) ? acc.z * 0.0625f * __expf(us.z - gt) : 0.f, w3 = (s0 + 3 <= t) ? acc.w * 0.0625f * __expf(us.w - gt) : 0.f;
                u32x2 o; o.x = cvtpk(w0, w1); o.y = cvtpk(w2, w3);
                *(LAS u32x2*)(lds + PS_OFF + (t * PP + s0) * 2) = o;
            }
            f32x4 nacc[3];
#pragma unroll
            for (int ei = 0; ei < 3; ++ei) {
                const int eps = (ei == 2) ? 4 : 2 * par + ei; f32x4 acc = (f32x4){0.f, 0.f, 0.f, 0.f};
#pragma unroll
                for (int kap = 0; kap < 8; ++kap) acc = __builtin_amdgcn_mfma_f32_16x16x32_bf16(*(const LAS bf16x8*)(lds + CT_OFF + ((16 * eps + fr) * QP + 32 * kap + 8 * fq) * 2), qf[kap], acc, 0, 0, 0);
                nacc[ei] = acc * sc[128 + 16 * tau + fr];
            }
            __syncthreads();
            {
                bf16x8 pf[2];
#pragma unroll
                for (int kp = 0; kp < 2; ++kp) pf[kp] = *(const LAS bf16x8*)(lds + PS_OFF + ((16 * tau + fr) * PP + 32 * kp + 8 * fq) * 2);
#pragma unroll
                for (int ei = 0; ei < 3; ++ei) {
                    const int eps = (ei == 2) ? 4 : 2 * par + ei;
#pragma unroll
                    for (int kp = 0; kp < 2; ++kp) nacc[ei] = __builtin_amdgcn_mfma_f32_16x16x32_bf16(frag_tr(lds + VS_OFF + ((32 * kp + 8 * fq + q_) * VP + 16 * eps + 4 * p_) * 2, VP * 2), pf[kp], nacc[ei], 0, 0, 0);
                }
                const float den = __shfl(nacc[2].x, fr);
                const float rinv = 1.0f / fmaxf(fabsf(den), sc[192 + 16 * tau + fr]);
                bf16_t* hrow = vb + ((size_t)c * 64 + 16 * tau + fr) * DM;
#pragma unroll
                for (int ei = 0; ei < 2; ++ei) { const int eps = 2 * par + ei; u32x2 o; o.x = cvtpk(nacc[ei].x * rinv, nacc[ei].y * rinv); o.y = cvtpk(nacc[ei].z * rinv, nacc[ei].w * rinv);
                    *(u32x2*)(hrow + 16 * eps + 4 * fq) = o; }
            }
            {
                const float decay = sc[320];
                bf16x8 kw[2][2];
#pragma unroll
                for (int dl = 0; dl < 2; ++dl)
#pragma unroll
                    for (int kp = 0; kp < 2; ++kp) {
                        const bf16x8 f = frag_tr(lds + KS_OFF + ((32 * kp + 8 * fq + q_) * QP + 16 * (2 * wave + dl) + 4 * p_) * 2, QP * 2);
                        const u32x4 fw = __builtin_bit_cast(u32x4, f);
                        const f32x4 wa = *(const LAS f32x4*)(sc + 256 + 32 * kp + 8 * fq), wb = *(const LAS f32x4*)(sc + 256 + 32 * kp + 8 * fq + 4);
                        u32x4 o; o.x = cvtpk(bflo(fw.x) * wa.x, bfhi(fw.x) * wa.y); o.y = cvtpk(bflo(fw.y) * wa.z, bfhi(fw.y) * wa.w); o.z = cvtpk(bflo(fw.z) * wb.x, bfhi(fw.z) * wb.y); o.w = cvtpk(bflo(fw.w) * wb.z, bfhi(fw.w) * wb.w);
                        kw[dl][kp] = __builtin_bit_cast(bf16x8, o);
                    }
#pragma unroll
                for (int eps = 0; eps < 5; ++eps) {
                    bf16x8 vf[2];
#pragma unroll
                    for (int kp = 0; kp < 2; ++kp) vf[kp] = frag_tr(lds + VS_OFF + ((32 * kp + 8 * fq + q_) * VP + 16 * eps + 4 * p_) * 2, VP * 2);
#pragma unroll
                    for (int dl = 0; dl < 2; ++dl) {
                        f32x4 a = cacc[dl][eps] * decay;
                        a = __builtin_amdgcn_mfma_f32_16x16x32_bf16(kw[dl][0], vf[0], a, 0, 0, 0);
                        a = __builtin_amdgcn_mfma_f32_16x16x32_bf16(kw[dl][1], vf[1], a, 0, 0, 0);
                        cacc[dl][eps] = a;
                        u32x2 o; o.x = cvtpk(a.x, a.y); o.y = cvtpk(a.z, a.w);
                        *(LAS u32x2*)(lds + CT_OFF + ((16 * eps + fr) * QP + 16 * (2 * wave + dl) + 4 * fq) * 2) = o;
                    }
                }
            }
            __syncthreads();
        }
#undef ML_LOAD
    }
}

namespace gmm { constexpr int VVP = 136, VV_OFF = 0, WS_OFF = 128 * VVP * 2, BYTES = 2 * 128 * VVP * 2; }
__device__ void p3_gmlp_mfma(const Params& P, LAS unsigned char* lds) {
    using namespace gmm;
    const int tid = threadIdx.x, lane = tid & 63, wave = __builtin_amdgcn_readfirstlane(tid >> 6), fr = lane & 15, fq = lane >> 4, q_ = fr >> 2, p_ = fr & 3;
    bf16_t* PROJ = (bf16_t*)(P.ws + WS_PROJ); const bf16_t* WSPb = (const bf16_t*)(P.ws + WS_WSP); const float* BSP = P.in[I_B_SP];
    int g_staged = -1;
    u32x4 pre[4];
#define GM_LOAD(it_) do { const int g_ = (it_) & 7, c_ = ((it_) >> 3) & 15, b_ = (it_) >> 7; const size_t t0_ = (size_t)b_ * SEQ + c_ * 128; \
        _Pragma("unroll") for (int i = 0; i < 4; ++i) { const int p = tid + i * NTHR, r = p >> 4, cc = p & 15; pre[i] = *(const u32x4*)(PROJ + (t0_ + r) * PROJW + 3 * DM + g_ * 128 + cc * 8); } } while (0)
    if ((int)blockIdx.x < 2048) GM_LOAD(blockIdx.x);
    for (int item = blockIdx.x; item < 2048; item += gridDim.x) {
        const int g = item & 7, c = (item >> 3) & 15, b = item >> 7; const size_t t0 = (size_t)b * SEQ + c * 128;
#pragma unroll
        for (int i = 0; i < 4; ++i) { const int p = tid + i * NTHR, r = p >> 4, cc = p & 15; *(LAS u32x4*)(lds + VV_OFF + (r * VVP + cc * 8) * 2) = pre[i]; }
        if (g != g_staged) {
#pragma unroll
            for (int i = 0; i < 4; ++i) { const int p = tid + i * NTHR, r = p >> 4, cc = p & 15; *(LAS u32x4*)(lds + WS_OFF + (r * VVP + cc * 8) * 2) = *(const u32x4*)(WSPb + ((size_t)g * 128 + r) * 128 + cc * 8); }
            g_staged = g;
        }
        __syncthreads();
        if (item + (int)gridDim.x < 2048) GM_LOAD(item + gridDim.x);
        bf16x8 af[4];
#pragma unroll
        for (int kap = 0; kap < 4; ++kap) af[kap] = mlm::frag_tr(lds + VV_OFF + ((32 * kap + 8 * fq + q_) * VVP + 16 * wave + 4 * p_) * 2, VVP * 2);
#pragma unroll
        for (int th = 0; th < 8; ++th) {
            f32x4 acc = (f32x4){0.f, 0.f, 0.f, 0.f};
#pragma unroll
            for (int kap = 0; kap <= (th >> 1); ++kap) acc = __builtin_amdgcn_mfma_f32_16x16x32_bf16(af[kap], *(const LAS bf16x8*)(lds + WS_OFF + ((16 * th + fr) * VVP + 32 * kap + 8 * fq) * 2), acc, 0, 0, 0);
            const int t = 16 * th + fr; const float bs = BSP[g * 128 + t];
            bf16_t* gu = PROJ + (t0 + t) * PROJW + 2 * DM + g * 128 + 16 * wave + 4 * fq;
            const u32x2 w = *(const u32x2*)gu; u32x2 o;
            o.x = mlm::cvtpk(bflo(w.x) * (acc.x + bs), bfhi(w.x) * (acc.y + bs)); o.y = mlm::cvtpk(bflo(w.y) * (acc.z + bs), bfhi(w.y) * (acc.w + bs));
            *(u32x2*)gu = o;
        }
        __syncthreads();
    }
#undef GM_LOAD
}

__device__ void p4_ym(const Params& P, LAS unsigned char*) {
    const int tid = threadIdx.x, lane = tid & 63, wave = tid >> 6, h = wave & 3, half = wave >> 2;
    bf16_t* PROJ = (bf16_t*)(P.ws + WS_PROJ); const bf16_t* HM = (const bf16_t*)(P.ws + WS_XN);
    const int ch = h * 256 + lane * 4;
    float cw[4][4], cb[4], ng[4], sk[4];
#pragma unroll
    for (int j = 0; j < 4; ++j)
#pragma unroll
        for (int d = 0; d < 4; ++d) cw[j][d] = P.in[I_CONV_W][j * DM + ch + d];
#pragma unroll
    for (int d = 0; d < 4; ++d) { cb[d] = P.in[I_CONV_B][ch + d]; ng[d] = P.in[I_M_NORM_G][ch + d]; sk[d] = P.in[I_M_SKIP][ch + d]; }
    for (int item = blockIdx.x; item < NTOK / 16; item += gridDim.x) {
        const int tb = item * 16 + half * 8;
        u32x2 raw[11], rh[8], rz[8];
        const bool seq0 = (tb & (SEQ - 1)) == 0;
#pragma unroll
        for (int i = 0; i < 11; ++i) raw[i] = (i < 3 && seq0) ? (u32x2){0u, 0u} : *(const u32x2*)(PROJ + (size_t)(tb - 3 + i) * PROJW + ch);
#pragma unroll
        for (int i = 0; i < 8; ++i) { rh[i] = *(const u32x2*)(HM + (size_t)(tb + i) * DM + ch); rz[i] = *(const u32x2*)(PROJ + (size_t)(tb + i) * PROJW + DM + ch); }
        float x0[4], x1[4], x2[4], x3[4];
        up4(raw[0], x0); up4(raw[1], x1); up4(raw[2], x2);
#pragma unroll
        for (int i = 0; i < 8; ++i) {
            const int t = tb + i;
            up4(raw[3 + i], x3);
            float hm[4], sz[4], y[4];
            up4(rh[i], hm); up4(rz[i], sz);
            const float mu = wave_sum(hm[0] + hm[1] + hm[2] + hm[3]) * (1.f / 256.f);
            float s2 = 0.f;
#pragma unroll
            for (int d = 0; d < 4; ++d) { hm[d] -= mu; s2 += hm[d] * hm[d]; }
            const float r = 1.0f / sqrtf(wave_sum(s2) * (1.f / 256.f) + EPS);
#pragma unroll
            for (int d = 0; d < 4; ++d) { const float mc = siluf_(cw[0][d] * x0[d] + cw[1][d] * x1[d] + cw[2][d] * x2[d] + cw[3][d] * x3[d] + cb[d]);
                y[d] = (hm[d] * r * ng[d] + sk[d] * mc) * sz[d]; }
            st4(PROJ + (size_t)t * PROJW + DM + ch, y);
#pragma unroll
            for (int d = 0; d < 4; ++d) { x0[d] = x1[d]; x1[d] = x2[d]; x2[d] = x3[d]; }
        }
    }
}

__device__ void norm_pass(const float* xi, const bf16_t* y, const float* g1, float* xo, const float* g2, bf16_t* hn, int ldh, int hoff, const float* pin) {
    const int tid = threadIdx.x, lane = tid & 63, wave = tid >> 6;
    const int gw = blockIdx.x * NWAVES + wave, NGW = gridDim.x * NWAVES;
    for (int m = gw; m < NTOK; m += NGW) {
        const u32x2* yr = (const u32x2*)(y + (size_t)m * DM) + lane; const f32x4* xr = (const f32x4*)(xi + (size_t)m * DM) + lane; f32x4* orow = (f32x4*)(xo + (size_t)m * DM) + lane;
        f32x4 v[4]; float s = 0.f;
#pragma unroll
        for (int j = 0; j < 4; ++j) { const u32x2 w = yr[64 * j]; v[j] = (f32x4){bflo(w.x), bfhi(w.x), bflo(w.y), bfhi(w.y)}; s += (v[j].x * v[j].x + v[j].y * v[j].y) + (v[j].z * v[j].z + v[j].w * v[j].w); }
        const float r = 1.0f / sqrtf(wave_sum(s) * (1.f / DM) + EPS); float s2 = 0.f;
#pragma unroll
        for (int j = 0; j < 4; ++j) { const f32x4 gv = ((const f32x4*)g1 + lane)[64 * j]; v[j] = xr[64 * j] + v[j] * r * gv; orow[64 * j] = v[j];
            s2 += (v[j].x * v[j].x + v[j].y * v[j].y) + (v[j].z * v[j].z + v[j].w * v[j].w); }
        if (hn) {
            const float r2 = 1.0f / sqrtf(wave_sum(s2) * (1.f / DM) + EPS);
            u32x2* o8 = (u32x2*)(hn + (size_t)m * ldh + hoff) + lane;
#pragma unroll
            for (int j = 0; j < 4; ++j) { const f32x4 gv = ((const f32x4*)g2 + lane)[64 * j]; u32x2 o; o.x = pk2(v[j].x * r2 * gv.x, v[j].y * r2 * gv.y); o.y = pk2(v[j].z * r2 * gv.z, v[j].w * r2 * gv.w); o8[64 * j] = o; }
            if (pin) { const f32x4 pv = ((const f32x4*)(pin + (size_t)m * PLE))[lane]; u32x2 o; o.x = pk2(pv.x, pv.y); o.y = pk2(pv.z, pv.w); ((u32x2*)(hn + (size_t)m * ldh))[lane] = o; }
        }
    }
}

#define XB_TMO      128
#define XB_XCNT(j)  (256  + 64 * (j))
#define XB_XSUB(j)  (1280 + 64 * (j))
#define XB_XGEN(j)  (2304 + 64 * (j))
#define XB_TOP      3328
#define XB_TOPGEN   3392
#define XCD_BAR_WORDS 3456
#define XB_SPIN_CAP (1u << 20)
__device__ __forceinline__ unsigned xb_ld(unsigned* p)              { return __hip_atomic_load(p, __ATOMIC_RELAXED, __HIP_MEMORY_SCOPE_AGENT); }
__device__ __forceinline__ unsigned xb_add(unsigned* p, unsigned v) { return __hip_atomic_fetch_add(p, v, __ATOMIC_RELAXED, __HIP_MEMORY_SCOPE_AGENT); }
__device__ __forceinline__ unsigned xb_xcc_id() { return (unsigned)__builtin_amdgcn_s_getreg((3 << 11) | 20) & 0xFu; }
#define XB_SPIN(cond, bar) do { unsigned _sp = 0; while (cond) { __builtin_amdgcn_s_sleep(1); \
    if ((++_sp & 255u) == 0u) { if (xb_ld(&(bar)[XB_TMO])) break; if (_sp > XB_SPIN_CAP) { atomicAdd(&(bar)[XB_TMO], 1u); break; } } } } while (0)
struct XcdBarrier { unsigned* bar; unsigned x; volatile LAS unsigned* st; };
__device__ __forceinline__ XcdBarrier xcd_barrier_post(unsigned* bar, volatile LAS unsigned* st) {
    XcdBarrier b; b.bar = bar; b.x = xb_xcc_id(); b.st = st;
    if (threadIdx.x == 0) (void)xb_add(&bar[XB_XCNT(b.x)], 1u);
    return b;
}
__device__ __forceinline__ void xcd_barrier_complete(unsigned* bar, unsigned x, unsigned& nloc, unsigned& nx) {
    const unsigned G = gridDim.x * gridDim.y * gridDim.z;
    unsigned sum, cnt, mine, sp = 0u;
    for (;;) {
        sum = 0u; cnt = 0u; mine = 0u;
#pragma unroll
        for (unsigned j = 0; j < 16; ++j) { const unsigned c = xb_ld(&bar[XB_XCNT(j)]); sum += c; cnt += (c > 0u) ? 1u : 0u; mine = (j == x) ? c : mine; }
        if (sum == G) break;
        __builtin_amdgcn_s_sleep(1);
        if ((++sp & 255u) == 0u) { if (xb_ld(&bar[XB_TMO])) break; if (sp > XB_SPIN_CAP) { atomicAdd(&bar[XB_TMO], 1u); break; } }
    }
    nloc = mine > 0u ? mine : 1u; nx = cnt > 0u ? cnt : 1u;
}
__device__ __forceinline__ void xcd_barrier(const XcdBarrier& b) {
    asm volatile("s_waitcnt vmcnt(0)" ::: "memory");
    __syncthreads();
    if (threadIdx.x == 0) {
        unsigned* bar = b.bar;
        __builtin_amdgcn_s_waitcnt(0);
        unsigned nloc = b.st[0], nx = b.st[1];
        if (nloc == 0u) { xcd_barrier_complete(bar, b.x, nloc, nx); b.st[0] = nloc; b.st[1] = nx; }
        const unsigned old = xb_add(&bar[XB_XSUB(b.x)], 1u);
        const unsigned gen = old / nloc;
        if (old + 1u == (gen + 1u) * nloc) {
            __builtin_amdgcn_fence(__ATOMIC_RELEASE, "agent");
            asm volatile("s_waitcnt vmcnt(0)" ::: "memory");
            const unsigned og = xb_add(&bar[XB_TOP], 1u);
            const unsigned tg = og / nx;
            if (og + 1u == (tg + 1u) * nx) xb_add(&bar[XB_TOPGEN], 1u);
            else XB_SPIN(xb_ld(&bar[XB_TOPGEN]) == tg, bar);
            __builtin_amdgcn_fence(__ATOMIC_ACQUIRE, "agent");
            xb_add(&bar[XB_XGEN(b.x)], 1u);
            asm volatile("s_waitcnt vmcnt(0)" ::: "memory");
        } else {
            XB_SPIN(xb_ld(&bar[XB_XGEN(b.x)]) == gen, bar);
            __builtin_amdgcn_fence(__ATOMIC_ACQUIRE, "agent");
            asm volatile("s_waitcnt vmcnt(0)" ::: "memory");
        }
    }
    __syncthreads();
}

#ifndef MEGA
#define MEGA 1
#endif
namespace cg = cooperative_groups;
constexpr int NPHASE = 13;
constexpr int LDS_BYTES = 160 * 1024 - 1024;
constexpr int MISC_OFF = LDS_BYTES - 256;
constexpr int CW_BAR = 4096;
constexpr size_t CTL_ZERO_BYTES = 64 * 1024;
#ifndef USE_CG_SYNC
#define USE_CG_SYNC 0
#endif
static_assert(ML_BYTES <= LDS_BYTES && pg8::STAGE_BYTES <= LDS_BYTES && mlm::BYTES <= MISC_OFF && ML_BYTES <= MISC_OFF && (CW_BAR + XCD_BAR_WORDS) * 4 <= (int)CTL_ZERO_BYTES, "lds");

template <int LO, int HI> __global__ void __launch_bounds__(NTHR, 2) fwd_kernel(Params P) {
    extern __shared__ __attribute__((aligned(16))) unsigned char lds_raw[];
    LAS unsigned char* lds = (LAS unsigned char*)lds_raw;
    unsigned char* ws = P.ws;
    bf16_t* PROJ = (bf16_t*)(ws + WS_PROJ); bf16_t* XN = (bf16_t*)(ws + WS_XN); bf16_t* HB = (bf16_t*)(ws + WS_HB); bf16_t* Y = (bf16_t*)(ws + WS_Y);
    const int G = gridDim.x, bid = blockIdx.x;
#define IN(k) (LO <= (k) && (k) < HI)
#if USE_CG_SYNC
#define SEAM(k) do { if (IN(k) && IN((k) + 1)) cg::this_grid().sync(); } while (0)
#else
    if (HI - LO > 1) { volatile LAS unsigned* misc = (volatile LAS unsigned*)(lds + MISC_OFF); if (threadIdx.x < 2) misc[threadIdx.x] = 0u; __syncthreads(); (void)xcd_barrier_post((unsigned*)(P.ws + WS_CTL) + CW_BAR, misc); }
#define SEAM(k) do { if (IN(k) && IN((k) + 1)) { XcdBarrier xb_; xb_.bar = (unsigned*)(P.ws + WS_CTL) + CW_BAR; xb_.x = xb_xcc_id(); xb_.st = (volatile LAS unsigned*)((LAS unsigned char*)lds_raw + MISC_OFF); xcd_barrier(xb_); } } while (0)
#endif
    if (IN(0)) p0_prologue(P, lds);
    SEAM(0);
    if (IN(1)) { pg8::Gemm g{XN, (const bf16_t*)(ws + WS_WIN), DM, DM, NTOK, PROJW, DM}; pg8::StaticOrder S; S.init(NTOK, PROJW, G, bid);
        pg8::Epi8<ProjF> E{ProjF{PROJ}}; pg8::gemm_phase<pg8::Epi8<ProjF>, -1, true>(lds, g, S, E); }
    SEAM(1);
    if (IN(2)) p2_qkv(P, lds);
    SEAM(2);
    if (IN(3)) { p3_mlstm_mfma(P, lds); __syncthreads(); p3_gmlp_mfma(P, lds); }
    SEAM(3);
    if (IN(4)) p4_ym(P, lds);
    SEAM(4);
    if (IN(5)) { pg8::Gemm g{PROJ + DM, (const bf16_t*)(ws + WS_WBR), PROJW, 2 * DM, NTOK, DM, 2 * DM}; pg8::StaticOrder S; S.init(NTOK, DM, G, bid);
        pg8::Epi8<MergeF> E{MergeF{PROJ, XN}}; pg8::gemm_phase<pg8::Epi8<MergeF>, 16, true>(lds, g, S, E); }
    SEAM(5);
    if (IN(6)) { pg8::Gemm g{XN, (const bf16_t*)(ws + WS_WOUT), DM, DM, NTOK, DM, DM}; pg8::StaticOrder S; S.init(NTOK, DM, G, bid);
        pg8::Epi8<Bf16F> E{Bf16F{Y, DM}}; pg8::gemm_phase<pg8::Epi8<Bf16F>, -1, true>(lds, g, S, E); }
    SEAM(6);
    if (IN(7)) norm_pass(P.in[I_X], Y, P.in[I_MIX_POST_G], P.out, P.in[I_MLP_PRE_G], XN, DM, 0, nullptr);
    SEAM(7);
    if (IN(8)) { pg8::Gemm g{XN, (const bf16_t*)(ws + WS_WUP), DM, DM, NTOK, DFF, DM}; pg8::StaticOrder S; S.init(NTOK, DFF, G, bid);
        pg8::Epi8<Relu2F> E{Relu2F{HB, DFF}}; pg8::gemm_phase<pg8::Epi8<Relu2F>, -1, true>(lds, g, S, E); }
    SEAM(8);
    if (IN(9)) { pg8::Gemm g{HB, (const bf16_t*)(ws + WS_WDN), DFF, DFF, NTOK, DM, DFF}; pg8::StaticOrder S; S.init(NTOK, DM, G, bid);
        pg8::Epi8<Bf16F> E{Bf16F{Y, DM}}; pg8::gemm_phase<pg8::Epi8<Bf16F>, -1, true>(lds, g, S, E); }
    SEAM(9);
    if (IN(10)) norm_pass(P.out, Y, P.in[I_MLP_POST_G], P.out, P.in[I_PLE_PRE_G], HB, PLEK, PLE, P.in[I_P]);
    SEAM(10);
    if (IN(11)) { pg8::Gemm g{HB, (const bf16_t*)(ws + WS_WPLE), PLEK, PLEK, NTOK, DM, PLEK}; pg8::StaticOrder S; S.init(NTOK, DM, G, bid);
        pg8::Epi8<PleF> E{PleF{Y, (f32x4*)(ws + WS_XN)}}; pg8::gemm_phase<pg8::Epi8<PleF>, 4, true>(lds, g, S, E); }
    SEAM(11);
    if (IN(12)) norm_pass(P.out, Y, P.in[I_PLE_POST_G], P.out, nullptr, nullptr, 0, 0, nullptr);
#undef IN
#undef SEAM
}

template <int LO, int HI> static void launch_range(const Params& P, int grid, hipStream_t stream, bool coop) {
    static bool attr = false;
    if (!attr) { (void)hipFuncSetAttribute((const void*)fwd_kernel<LO, HI>, hipFuncAttributeMaxDynamicSharedMemorySize, LDS_BYTES); attr = true; }
    if (coop) {
        Params p = P; void* args[] = {&p};
        const hipError_t e = hipLaunchCooperativeKernel((const void*)fwd_kernel<LO, HI>, dim3(grid), dim3(NTHR), args, LDS_BYTES, stream);
        if (e != hipSuccess) fprintf(stderr, "cooperative launch failed: %s (grid %d)\n", hipGetErrorString(e), grid);
    } else hipLaunchKernelGGL((fwd_kernel<LO, HI>), dim3(grid), dim3(NTHR), LDS_BYTES, stream, P);
}
template <int I> static void launch_each(const Params& P, int grid, hipStream_t stream) {
    if constexpr (I < NPHASE) { launch_range<I, I + 1>(P, grid, stream, false); launch_each<I + 1>(P, grid, stream); }
}

extern "C" void kernel_launch(void* const* d_in, const int* in_sizes, int n_in, void* d_out, int out_size, void* d_ws, size_t ws_size, hipStream_t stream) {
    if (n_in != 29 || out_size != NTOK * DM || ws_size < WS_END) { fprintf(stderr, "kernel_launch: unexpected shapes (n_in %d out %d ws %zu)\n", n_in, out_size, ws_size); return; }
    Params P{};
    for (int i = 0; i < 29; ++i) P.in[i] = (const float*)d_in[i];
    P.out = (float*)d_out; P.ws = (unsigned char*)d_ws;
#if MEGA
    static int grid = 0;
    if (!grid) {
        int dev = 0, cus = 0, per_cu = 0;
        (void)hipGetDevice(&dev); (void)hipDeviceGetAttribute(&cus, hipDeviceAttributeMultiprocessorCount, dev);
        (void)hipFuncSetAttribute((const void*)fwd_kernel<0, NPHASE>, hipFuncAttributeMaxDynamicSharedMemorySize, LDS_BYTES);
        (void)hipOccupancyMaxActiveBlocksPerMultiprocessor(&per_cu, (const void*)fwd_kernel<0, NPHASE>, NTHR, LDS_BYTES);
        if (per_cu < 1) per_cu = 1;
        grid = cus;
        if (grid > cus * per_cu) grid = cus * per_cu;
    }
    (void)hipMemsetAsync((char*)d_ws + WS_CTL, 0, CTL_ZERO_BYTES, stream);
    launch_range<0, NPHASE>(P, grid, stream, true);
#else
    launch_each<0>(P, 256, stream);
#endif
}
```

```cpp
#include <hip/hip_runtime.h>
#include <hip/hip_cooperative_groups.h>
#include <cstdio>
#include <cstdint>
#include <cmath>

#define LAS __attribute__((address_space(3)))
typedef unsigned short bf16_t;
typedef short bf16x8 __attribute__((ext_vector_type(8)));
typedef float f32x4 __attribute__((ext_vector_type(4)));
typedef unsigned u32x4 __attribute__((ext_vector_type(4)));
typedef unsigned u32x2 __attribute__((ext_vector_type(2)));

constexpr int NTOK = 32768, DM = 1024, SEQ = 2048, PROJW = 6144, DFF = 4096, PLE = 256, PLEK = PLE + DM;
constexpr float EPS = 1e-6f;
constexpr int NWAVES = 8, NTHR = 512;
constexpr size_t MiB = 1u << 20;
constexpr size_t WS_CTL = 0;
constexpr size_t WS_WIN = 1 * MiB;
constexpr size_t WS_WBR = 13 * MiB;
constexpr size_t WS_WOUT = 17 * MiB;
constexpr size_t WS_WUP = 19 * MiB;
constexpr size_t WS_WDN = 27 * MiB;
constexpr size_t WS_WPLE = 35 * MiB;
constexpr size_t WS_WCX = 38 * MiB;
constexpr size_t WS_WSP = 38 * MiB + 256 * 1024;
constexpr size_t WS_GATES = 39 * MiB;
constexpr size_t WS_XN = 40 * MiB;
constexpr size_t WS_PROJ = 104 * MiB;
constexpr size_t WS_HB = WS_PROJ;
constexpr size_t WS_Y = WS_PROJ + 256 * MiB;
constexpr size_t WS_END = 488 * MiB;

struct Params {
    const float* in[29];
    float* out;
    unsigned char* ws;
};
enum { I_X = 0, I_P, I_MIX_PRE_G, I_W_IN, I_CONV_W, I_CONV_B, I_WQ, I_WK, I_WV, I_W_IF, I_B_IF, I_M_NORM_G, I_M_SKIP, I_G_LN_W, I_G_LN_B, I_W_SP, I_B_SP,
       I_W_BR_M, I_W_BR_G, I_W_OUT, I_MIX_POST_G, I_MLP_PRE_G, I_W_UP, I_W_DOWN, I_MLP_POST_G, I_PLE_PRE_G, I_W_PLE_GATE, I_W_PLE_PROJ, I_PLE_POST_G };

__device__ __forceinline__ unsigned f2bf(float f) { unsigned u = __builtin_bit_cast(unsigned, f); return (u + 0x7fffu + ((u >> 16) & 1u)) >> 16; }
typedef float f32x2_t_ __attribute__((ext_vector_type(2)));
typedef __bf16 bf16x2_t_ __attribute__((ext_vector_type(2)));
__device__ __forceinline__ unsigned pk2(float lo, float hi) { f32x2_t_ v = {lo, hi}; bf16x2_t_ b = __builtin_convertvector(v, bf16x2_t_); return __builtin_bit_cast(unsigned, b); }
__device__ __forceinline__ float bflo(unsigned w) { return __builtin_bit_cast(float, w << 16); }
__device__ __forceinline__ float bfhi(unsigned w) { return __builtin_bit_cast(float, w & 0xffff0000u); }
__device__ __forceinline__ float bf2f(bf16_t h) { return __builtin_bit_cast(float, (unsigned)h << 16); }
__device__ __forceinline__ float sigmoidf_(float x) { return __builtin_amdgcn_rcpf(1.0f + __builtin_amdgcn_exp2f(-1.4426950408889634f * x)); }
__device__ __forceinline__ float siluf_(float x) { return x * sigmoidf_(x); }
__device__ __forceinline__ float gelu_tanh(float x) { const float z = 0.7978845608028654f * (x + 0.044715f * x * x * x); return x * sigmoidf_(2.0f * z); }
__device__ __forceinline__ float log_sigmoid(float x) { return fminf(x, 0.f) - log1pf(expf(-fabsf(x))); }
__device__ __forceinline__ float wave_sum(float v) {
#pragma unroll
    for (int o = 1; o < 64; o <<= 1) v += __shfl_xor(v, o);
    return v;
}
#define LDS_WAIT() asm volatile("s_waitcnt lgkmcnt(0)" ::: "memory")

template <bool GATE_REMAP = false>
__device__ __forceinline__ void transpose_item(const float* W, int K, int N, bf16_t* WT, int ldw, int koff, LAS float* scr, int item, int lane) {
    const int nblk = N / 32, kb = item / nblk, nb = item % nblk, k0 = 64 * kb, n0 = 32 * nb;
    int r0 = n0; if (GATE_REMAP && n0 >= 4 * DM) { const int g = n0 - 4 * DM, j = g & (DM - 1); r0 = 4 * DM + (j >> 7) * 256 + (g >= DM ? 128 : 0) + (j & 127); }
#pragma unroll 8
    for (int i = 0; i < 32; ++i) { const int kk = 2 * i + (lane >> 5); scr[kk * 33 + (lane & 31)] = W[(size_t)(k0 + kk) * N + n0 + (lane & 31)]; }
    LDS_WAIT();
    const int c = lane & 7;
#pragma unroll
    for (int j = 0; j < 4; ++j) { const int n = (lane >> 3) + 8 * j; const LAS float* s = scr + (8 * c) * 33 + n;
        u32x4 o; o.x = pk2(s[0 * 33], s[1 * 33]); o.y = pk2(s[2 * 33], s[3 * 33]); o.z = pk2(s[4 * 33], s[5 * 33]); o.w = pk2(s[6 * 33], s[7 * 33]);
        *(u32x4*)(WT + (size_t)(r0 + n) * ldw + koff + k0 + 8 * c) = o; }
    LDS_WAIT();
}
__device__ __forceinline__ void rms_row_to_bf16(const float* xrow, const float* g, bf16_t* orow, int lane) {
    const f32x4* xr = (const f32x4*)xrow + lane; const f32x4* gr = (const f32x4*)g + lane;
    f32x4 v[4]; float s = 0.f;
#pragma unroll
    for (int j = 0; j < 4; ++j) { v[j] = xr[64 * j]; s += (v[j].x * v[j].x + v[j].y * v[j].y) + (v[j].z * v[j].z + v[j].w * v[j].w); }
    const float r = 1.0f / sqrtf(wave_sum(s) * (1.f / DM) + EPS);
    u32x2* o8 = (u32x2*)orow + lane;
#pragma unroll
    for (int j = 0; j < 4; ++j) { const f32x4 gv = gr[64 * j]; u32x2 o; o.x = pk2(v[j].x * r * gv.x, v[j].y * r * gv.y); o.y = pk2(v[j].z * r * gv.z, v[j].w * r * gv.w); o8[64 * j] = o; }
}
__device__ void p0_prologue(const Params& P, LAS unsigned char* lds) {
    const int tid = threadIdx.x, lane = tid & 63, wave = tid >> 6;
    LAS float* scr = (LAS float*)(lds + wave * 16384);
    const int gw = blockIdx.x * NWAVES + wave, NGW = gridDim.x * NWAVES;
    unsigned char* ws = P.ws;
    constexpr int I_IN = 16 * 192, I_SQ = 16 * 32, I_UP = 16 * 128, I_DN = 64 * 32, I_PP = 4 * 32;
    constexpr int NIT = I_IN + 4 * I_SQ + I_UP + I_DN + I_PP;
    for (int it = gw; it < NIT; it += NGW) {
        int r = it;
        if (r < I_IN) { transpose_item<true>(P.in[I_W_IN], DM, PROJW, (bf16_t*)(ws + WS_WIN), DM, 0, scr, r, lane); continue; } r -= I_IN;
        if (r < I_SQ) { transpose_item(P.in[I_W_BR_M], DM, DM, (bf16_t*)(ws + WS_WBR), 2 * DM, 0, scr, r, lane); continue; } r -= I_SQ;
        if (r < I_SQ) { transpose_item(P.in[I_W_BR_G], DM, DM, (bf16_t*)(ws + WS_WBR), 2 * DM, DM, scr, r, lane); continue; } r -= I_SQ;
        if (r < I_SQ) { transpose_item(P.in[I_W_OUT], DM, DM, (bf16_t*)(ws + WS_WOUT), DM, 0, scr, r, lane); continue; } r -= I_SQ;
        if (r < I_SQ) { transpose_item(P.in[I_W_PLE_GATE], DM, DM, (bf16_t*)(ws + WS_WPLE), PLEK, PLE, scr, r, lane); continue; } r -= I_SQ;
        if (r < I_UP) { transpose_item(P.in[I_W_UP], DM, DFF, (bf16_t*)(ws + WS_WUP), DM, 0, scr, r, lane); continue; } r -= I_UP;
        if (r < I_DN) { transpose_item(P.in[I_W_DOWN], DFF, DM, (bf16_t*)(ws + WS_WDN), DFF, 0, scr, r, lane); continue; } r -= I_DN;
        transpose_item(P.in[I_W_PLE_PROJ], PLE, DM, (bf16_t*)(ws + WS_WPLE), PLEK, 0, scr, r, lane);
    }
    {
        float* wcx = (float*)(ws + WS_WCX);
        const float* wq = P.in[I_WQ]; const float* wk = P.in[I_WK]; const float* wv = P.in[I_WV]; const float* wif = P.in[I_W_IF];
        for (int i = blockIdx.x * NTHR + tid; i < DM * 8; i += gridDim.x * NTHR) {
            const int c = i >> 3, j = i & 7, blk = c >> 2, d = c & 3; float sc = 0.f, sx = 0.f;
#pragma unroll
            for (int e = 0; e < 4; ++e) {
                sc += wq[blk * 16 + d * 4 + e] * wif[(size_t)(blk * 4 + e) * 8 + j] + wk[blk * 16 + d * 4 + e] * wif[(size_t)(DM + blk * 4 + e) * 8 + j];
                sx += wv[blk * 16 + d * 4 + e] * wif[(size_t)(2 * DM + blk * 4 + e) * 8 + j]; }
            wcx[i] = sc; wcx[DM * 8 + i] = sx;
        }
    }
    { bf16_t* wsp = (bf16_t*)(ws + WS_WSP); const float* w = P.in[I_W_SP];
      for (int i = blockIdx.x * NTHR + tid; i < 8 * 128 * 128; i += gridDim.x * NTHR) { const int t = (i >> 7) & 127, s = i & 127; wsp[i] = (bf16_t)f2bf(s <= t ? w[i] : 0.f); } }
    bf16_t* XN = (bf16_t*)(ws + WS_XN);
    for (int m = gw; m < NTOK; m += NGW) rms_row_to_bf16(P.in[I_X] + (size_t)m * DM, P.in[I_MIX_PRE_G], XN + (size_t)m * DM, lane);
}

namespace pg8 {
constexpr int BM = 256, BK = 64, HALF = 128, HTB = HALF * BK * 2, STAGE_BYTES = 8 * HTB, NXCD = 8, WGM = 8;
__host__ __device__ __forceinline__ int lds_byte(int r, int c) { const int st = (r >> 4) * 2 + (c >> 5), rr = r & 15, cc = c & 31, ob = rr * 64 + cc * 2; return st * 1024 + (ob ^ (((ob >> 9) & 1) << 5)); }
__host__ __device__ __forceinline__ void stage_rc(int b, int& R, int& C) { const int st = b / 1024, sb = b % 1024, swz = sb ^ (((sb >> 9) & 1) << 5); R = (st >> 1) * 16 + swz / 64; C = (st & 1) * 32 + (swz % 64) / 2; }
__host__ __device__ __forceinline__ int perm32(int rho) { const int n = rho >> 4, i = rho & 15; return 8 * (i >> 2) + 4 * n + (i & 3); }
struct Unit { int pm, pn; };
struct Gemm { const bf16_t* A; const bf16_t* Bt; int lda, ldb, M, N, K; };
struct StaticOrder {
    int nM, nN, nwg, G, c;
    __host__ __device__ void init(int M, int N, int G_, int c_) { nM = M / BM; nN = N / BM; nwg = nM * nN; G = G_; c = c_; }
    __host__ __device__ bool next(int i, Unit& u) const {
        const long L = (long)i * G + c; if (L >= nwg) return false;
        int wgid = (int)L; { const int q = nwg / NXCD, r = nwg % NXCD, xcd = wgid % NXCD, off = wgid / NXCD; wgid = (xcd < r ? xcd * (q + 1) : r * (q + 1) + (xcd - r) * q) + off; }
        const int nig = WGM * nN, gid = wgid / nig, fm = gid * WGM, gsz = (nM - fm) < WGM ? (nM - fm) : WGM;
        u.pm = fm + ((wgid % nig) % gsz); u.pn = (wgid % nig) / gsz; return true;
    }
};
template <class F> struct Epi8 {
    static constexpr bool PERM = true; F f;
    __device__ __forceinline__ void operator()(f32x4 (&acc)[2][2][4][2], const Unit& u_, int wr, int wc, int fr, int fq) const {
        Unit u = u_; asm volatile("" : "+s"(u.pm), "+s"(u.pn));
#pragma unroll
        for (int ai = 0; ai < 2; ++ai)
#pragma unroll
            for (int m = 0; m < 4; ++m)
                { f.store16(u.pm * BM + ai * HALF + wr * 64 + m * 16 + fr, u.pn, wc * 32 + 8 * fq, acc[ai][0][m][0], acc[ai][0][m][1], acc[ai][1][m][0], acc[ai][1][m][1], ai * 4 + m); asm volatile("" ::: "memory"); }
    }
    __device__ __forceinline__ void mid(f32x4 (&acc)[2][2][4][2], const Unit& u_, int wr, int wc, int fr, int fq) const {
        Unit u = u_; asm volatile("" : "+s"(u.pm), "+s"(u.pn));
#pragma unroll
        for (int ai = 0; ai < 2; ++ai)
#pragma unroll
            for (int m = 0; m < 4; ++m)
#pragma unroll
                for (int bj = 0; bj < 2; ++bj) { f.mid8(u.pm * BM + ai * HALF + wr * 64 + m * 16 + fr, u.pn * BM + bj * HALF + wc * 32 + 8 * fq, acc[ai][bj][m][0], acc[ai][bj][m][1], (ai * 4 + m) * 2 + bj); asm volatile("" ::: "memory"); }
    }
};
template <class F> struct Epi4 {
    static constexpr bool PERM = false; F f;
    __device__ __forceinline__ void operator()(f32x4 (&acc)[2][2][4][2], const Unit& u_, int wr, int wc, int fr, int fq) const {
        Unit u = u_; asm volatile("" : "+s"(u.pm), "+s"(u.pn));
#pragma unroll
        for (int ai = 0; ai < 2; ++ai)
#pragma unroll
            for (int m = 0; m < 4; ++m)
#pragma unroll
                for (int bj = 0; bj < 2; ++bj)
#pragma unroll
                    for (int n = 0; n < 2; ++n) { f.store4(u.pm * BM + ai * HALF + wr * 64 + m * 16 + fr, u.pn * BM + bj * HALF + wc * 32 + 16 * n + 4 * fq, acc[ai][bj][m][n], ((ai * 4 + m) * 2 + bj) * 2 + n); if (n) asm volatile("" ::: "memory"); }
    }
    __device__ __forceinline__ void mid(f32x4 (&acc)[2][2][4][2], const Unit& u_, int wr, int wc, int fr, int fq) const {
        Unit u = u_; asm volatile("" : "+s"(u.pm), "+s"(u.pn));
#pragma unroll
        for (int ai = 0; ai < 2; ++ai)
#pragma unroll
            for (int m = 0; m < 4; ++m)
#pragma unroll
                for (int bj = 0; bj < 2; ++bj)
#pragma unroll
                    for (int n = 0; n < 2; ++n) { f.mid4(u.pm * BM + ai * HALF + wr * 64 + m * 16 + fr, u.pn * BM + bj * HALF + wc * 32 + 16 * n + 4 * fq, acc[ai][bj][m][n], ((ai * 4 + m) * 2 + bj) * 2 + n); if (n) asm volatile("" ::: "memory"); }
    }
};
template <class Epi, int HOOK_T, bool ALIGN_EPI>
__device__ __forceinline__ void gemm_phase(LAS unsigned char* lds, const Gemm g, const StaticOrder& S, const Epi& E) {
    int tid_ = threadIdx.x; asm volatile("" : "+v"(tid_));
    const int tid = tid_, wid = __builtin_amdgcn_readfirstlane(tid >> 6), lane = tid & 63, wr = wid >> 2, wc = wid & 3, fr = lane & 15, fq = lane >> 4;
    const int K = g.K, nt = K / BK;
    unsigned voffA[2], voffB[2];
#pragma unroll
    for (int i = 0; i < 2; ++i) { int R, C; stage_rc(tid * 16 + i * 8192, R, C); const int Rb = Epi::PERM ? ((R & ~31) + perm32(R & 31)) : R;
        voffA[i] = (unsigned)(R * g.lda + C) * 2u; voffB[i] = (unsigned)(Rb * g.ldb + C) * 2u; }
    const size_t kstep = (size_t)(BK * 2);
    const size_t hstepA = (size_t)HALF * g.lda * 2, hstepB = (size_t)HALF * g.ldb * 2;
    const size_t tstepA = 2 * hstepA, tstepB = 2 * hstepB;
    const unsigned ldsw = (unsigned)wid * 1024u;
    const int aoff = lds_byte(wr * 64 + fr, fq * 8), boff = lds_byte(wc * 32 + fr, fq * 8);
#define PG8_SA(b, h) (((b) * 2 + (h)) * HTB)
#define PG8_SB(b, h) ((4 + (b) * 2 + (h)) * HTB)
#define PG8_STAGE(bufoff, gbase, voff) do { _Pragma("unroll") for (int _i = 0; _i < 2; ++_i) \
        __builtin_amdgcn_global_load_lds((const unsigned*)((const char*)(gbase) + (voff)[_i]), (LAS unsigned*)(lds + (bufoff) + ldsw + _i * 8192), 16, 0, 0); } while (0)
#define PG8_LDA(dst, b, h) do { _Pragma("unroll") for (int m = 0; m < 4; ++m) _Pragma("unroll") for (int k = 0; k < 2; ++k) dst[m][k] = *(const LAS bf16x8*)(lds + PG8_SA(b, h) + aoff + m * 2048 + k * 1024); } while (0)
#define PG8_LDB(dst, b, h) do { _Pragma("unroll") for (int n = 0; n < 2; ++n) _Pragma("unroll") for (int k = 0; k < 2; ++k) dst[n][k] = *(const LAS bf16x8*)(lds + PG8_SB(b, h) + boff + n * 2048 + k * 1024); } while (0)
#define PG8_MMA(ai, bj, At, Bt) do { __builtin_amdgcn_s_setprio(1); _Pragma("unroll") for (int m = 0; m < 4; ++m) _Pragma("unroll") for (int n = 0; n < 2; ++n) _Pragma("unroll") for (int k = 0; k < 2; ++k) \
        acc[ai][bj][m][n] = __builtin_amdgcn_mfma_f32_16x16x32_bf16(Bt[n][k], At[m][k], acc[ai][bj][m][n], 0, 0, 0); __builtin_amdgcn_s_setprio(0); } while (0)
#define PG8_WAIT_V(n) asm volatile("s_waitcnt vmcnt(" #n ")" ::: "memory")
#define PG8_WAIT_L(n) asm volatile("s_waitcnt lgkmcnt(" #n ")" ::: "memory")
#define PG8_BAR __builtin_amdgcn_s_barrier()
#define PG8_SCHED __builtin_amdgcn_sched_barrier(0)
    Unit cur, nxt; int ui = 0;
    if (!S.next(0, cur)) return;
    f32x4 acc[2][2][4][2];
#pragma unroll
    for (int a = 0; a < 2; ++a)
#pragma unroll
        for (int b = 0; b < 2; ++b)
#pragma unroll
            for (int m = 0; m < 4; ++m)
#pragma unroll
                for (int n = 0; n < 2; ++n) acc[a][b][m][n] = (f32x4){0.f, 0.f, 0.f, 0.f};
    bf16x8 At[4][2], B0[2][2], B1[2][2];
    const char* cA = (const char*)g.A + (size_t)cur.pm * tstepA; const char* cB = (const char*)g.Bt + (size_t)cur.pn * tstepB;
    PG8_STAGE(PG8_SB(0, 0), cB, voffB); PG8_STAGE(PG8_SB(0, 1), cB + hstepB, voffB); PG8_STAGE(PG8_SA(0, 0), cA, voffA); PG8_STAGE(PG8_SA(0, 1), cA + hstepA, voffA);
    if (wr == 1) PG8_BAR;
    PG8_WAIT_V(2); PG8_BAR;
    PG8_STAGE(PG8_SB(1, 0), cB + kstep, voffB); PG8_STAGE(PG8_SA(1, 0), cA + kstep, voffA); PG8_STAGE(PG8_SB(1, 1), cB + hstepB + kstep, voffB);
    PG8_WAIT_V(6); PG8_BAR;
    for (;;) {
        const bool has_next = S.next(ui + 1, nxt);
        const char* nA = has_next ? (const char*)g.A + (size_t)nxt.pm * tstepA : cA; const char* nB = has_next ? (const char*)g.Bt + (size_t)nxt.pn * tstepB : cB;
#define PG8_KBODY() do { \
            const bool last = (t == nt - 2); \
            const char* a1 = cA + (size_t)(t + 1) * kstep; \
            const char* a2 = last ? nA : cA + (size_t)(t + 2) * kstep; const char* b2 = last ? nB : cB + (size_t)(t + 2) * kstep; \
            const char* a3 = a2 + kstep; const char* b3 = b2 + kstep; \
            PG8_LDB(B0, 0, 0); PG8_LDB(B1, 0, 1); PG8_SCHED; PG8_LDA(At, 0, 0); PG8_STAGE(PG8_SA(1, 1), a1 + hstepA, voffA); \
            PG8_WAIT_V(8); PG8_WAIT_L(0); PG8_BAR; PG8_MMA(0, 0, At, B0); PG8_MMA(0, 1, At, B1); PG8_BAR; PG8_SCHED; \
            PG8_LDA(At, 0, 1); PG8_STAGE(PG8_SB(0, 0), b2, voffB); PG8_STAGE(PG8_SB(0, 1), b2 + hstepB, voffB); PG8_STAGE(PG8_SA(0, 0), a2, voffA); \
            PG8_WAIT_V(8); PG8_WAIT_L(0); PG8_BAR; PG8_MMA(1, 0, At, B0); PG8_MMA(1, 1, At, B1); PG8_BAR; PG8_SCHED; \
            PG8_LDB(B0, 1, 0); PG8_LDB(B1, 1, 1); PG8_SCHED; PG8_LDA(At, 1, 0); PG8_STAGE(PG8_SA(0, 1), a2 + hstepA, voffA); \
            PG8_WAIT_V(8); PG8_WAIT_L(0); PG8_BAR; PG8_MMA(0, 0, At, B0); PG8_MMA(0, 1, At, B1); PG8_BAR; PG8_SCHED; \
            PG8_LDA(At, 1, 1); PG8_STAGE(PG8_SB(1, 0), b3, voffB); PG8_STAGE(PG8_SB(1, 1), b3 + hstepB, voffB); PG8_STAGE(PG8_SA(1, 0), a3, voffA); \
            PG8_WAIT_V(8); PG8_WAIT_L(0); PG8_BAR; PG8_MMA(1, 0, At, B0); PG8_MMA(1, 1, At, B1); PG8_BAR; PG8_SCHED; \
        } while (0)
        int t = 0;
        if constexpr (HOOK_T > 0) {
            for (; t < HOOK_T; t += 2) PG8_KBODY();
            PG8_SCHED; E.mid(acc, cur, wr, wc, fr, fq); PG8_SCHED;
        }
        for (; t < nt; t += 2) PG8_KBODY();
#undef PG8_KBODY
        if constexpr (ALIGN_EPI) { if (wr == 0) PG8_BAR; }
        E(acc, cur, wr, wc, fr, fq);
        if (!has_next) break;
#pragma unroll
        for (int a = 0; a < 2; ++a)
#pragma unroll
            for (int b = 0; b < 2; ++b)
#pragma unroll
                for (int m = 0; m < 4; ++m)
#pragma unroll
                    for (int n = 0; n < 2; ++n) acc[a][b][m][n] = (f32x4){0.f, 0.f, 0.f, 0.f};
        cur = nxt; cA = nA; cB = nB; ++ui;
        if constexpr (ALIGN_EPI) { if (wr == 1) PG8_BAR; }
    }
    PG8_WAIT_V(0);
    if constexpr (!ALIGN_EPI) { if (wr == 0) PG8_BAR; }
    PG8_BAR;
#undef PG8_SA
#undef PG8_SB
#undef PG8_STAGE
#undef PG8_LDA
#undef PG8_LDB
#undef PG8_MMA
#undef PG8_WAIT_V
#undef PG8_WAIT_L
#undef PG8_BAR
#undef PG8_SCHED
}
}
__device__ __forceinline__ void st_bf16x8(bf16_t* p, f32x4 a, f32x4 b) { u32x4 o; o.x = pk2(a.x, a.y); o.y = pk2(a.z, a.w); o.z = pk2(b.x, b.y); o.w = pk2(b.z, b.w); *(u32x4*)p = o; }
__device__ __forceinline__ void ld_bf16x8(const bf16_t* p, f32x4& a, f32x4& b) { const u32x4 w = *(const u32x4*)p; a = (f32x4){bflo(w.x), bfhi(w.x), bflo(w.y), bfhi(w.y)}; b = (f32x4){bflo(w.z), bfhi(w.z), bflo(w.w), bfhi(w.w)}; }
template <class FN> __device__ __forceinline__ f32x4 map4(f32x4 v, FN fn) { return (f32x4){fn(v.x), fn(v.y), fn(v.z), fn(v.w)}; }
struct ProjF {
    bf16_t* proj;
    __device__ __forceinline__ void store16(int row, int pn, int cl, f32x4 a0, f32x4 a1, f32x4 b0, f32x4 b1, int) const {
        bf16_t* rp = proj + (size_t)row * PROJW;
        if (pn < 16) {
            const int sec = pn >> 2;
            if (sec == 1) { a0 = map4(a0, siluf_); a1 = map4(a1, siluf_); b0 = map4(b0, siluf_); b1 = map4(b1, siluf_); }
            else if (sec >= 2) { a0 = map4(a0, gelu_tanh); a1 = map4(a1, gelu_tanh); b0 = map4(b0, gelu_tanh); b1 = map4(b1, gelu_tanh); }
            st_bf16x8(rp + pn * 256 + cl, a0, a1); st_bf16x8(rp + pn * 256 + 128 + cl, b0, b1);
        } else {
            const int j = (pn - 16) * 128 + cl;
            a0 = map4(a0, sigmoidf_); a1 = map4(a1, sigmoidf_); b0 = map4(b0, sigmoidf_); b1 = map4(b1, sigmoidf_);
            st_bf16x8(rp + 4 * DM + j, a0 / b0, a1 / b1); st_bf16x8(rp + 5 * DM + j, b0, b1);
        }
    }
    __device__ __forceinline__ void mid8(int, int, f32x4&, f32x4&, int) const {}
};
struct MergeF {
    const bf16_t* proj; bf16_t* merged;
    __device__ __forceinline__ void mid8(int row, int col, f32x4& a, f32x4& b, int) const {
        f32x4 r0, r1; ld_bf16x8(proj + (size_t)row * PROJW + 4 * DM + col, r0, r1); a = a * r0; b = b * r1;
    }
    __device__ __forceinline__ void store16(int row, int pn, int cl, f32x4 a0, f32x4 a1, f32x4 b0, f32x4 b1, int) const {
        const int col = pn * 256 + cl; f32x4 g0, g1;
        ld_bf16x8(proj + (size_t)row * PROJW + 5 * DM + col, g0, g1); st_bf16x8(merged + (size_t)row * DM + col, a0 * g0, a1 * g1);
        ld_bf16x8(proj + (size_t)row * PROJW + 5 * DM + col + 128, g0, g1); st_bf16x8(merged + (size_t)row * DM + col + 128, b0 * g0, b1 * g1);
    }
};
struct Bf16F {
    bf16_t* o; int ldc;
    __device__ __forceinline__ void store16(int row, int pn, int cl, f32x4 a0, f32x4 a1, f32x4 b0, f32x4 b1, int) const {
        bf16_t* p = o + (size_t)row * ldc + pn * 256 + cl; st_bf16x8(p, a0, a1); st_bf16x8(p + 128, b0, b1);
    }
    __device__ __forceinline__ void mid8(int, int, f32x4&, f32x4&, int) const {}
};
struct Relu2F {
    bf16_t* o; int ldc;
    __device__ __forceinline__ void store16(int row, int pn, int cl, f32x4 a0, f32x4 a1, f32x4 b0, f32x4 b1, int) const {
        auto r2 = [](float x) { const float r = fmaxf(x, 0.f); return r * r; };
        bf16_t* p = o + (size_t)row * ldc + pn * 256 + cl;
        st_bf16x8(p, map4(a0, r2), map4(a1, r2)); st_bf16x8(p + 128, map4(b0, r2), map4(b1, r2));
    }
    __device__ __forceinline__ void mid8(int, int, f32x4&, f32x4&, int) const {}
};
struct PleF {
    bf16_t* o; f32x4* stash;
    __device__ __forceinline__ void mid8(int, int, f32x4& a, f32x4& b, int idx2) const {
        unsigned t = threadIdx.x; asm volatile("" : "+v"(t));
        f32x4* s = stash + ((size_t)blockIdx.x * 32 + idx2 * 2) * NTHR + t; s[0] = a; s[NTHR] = b; a = (f32x4){0.f, 0.f, 0.f, 0.f}; b = (f32x4){0.f, 0.f, 0.f, 0.f};
    }
    __device__ __forceinline__ void store16(int row, int pn, int cl, f32x4 a0, f32x4 a1, f32x4 b0, f32x4 b1, int idx) const {
        unsigned t = threadIdx.x; asm volatile("" : "+v"(t));
        const f32x4* s = stash + ((size_t)blockIdx.x * 32 + idx * 4) * NTHR + t;
        bf16_t* p = o + (size_t)row * DM + pn * 256 + cl;
        st_bf16x8(p, map4(a0, sigmoidf_) * s[0], map4(a1, sigmoidf_) * s[NTHR]); st_bf16x8(p + 128, map4(b0, sigmoidf_) * s[2 * NTHR], map4(b1, sigmoidf_) * s[3 * NTHR]);
    }
};

__device__ __forceinline__ void ld4(const bf16_t* p, float (&x)[4]) { const u32x2 w = *(const u32x2*)p; x[0] = bflo(w.x); x[1] = bfhi(w.x); x[2] = bflo(w.y); x[3] = bfhi(w.y); }
__device__ __forceinline__ void up4(u32x2 w, float (&x)[4]) { x[0] = bflo(w.x); x[1] = bfhi(w.x); x[2] = bflo(w.y); x[3] = bfhi(w.y); }
__device__ __forceinline__ void st4(bf16_t* p, const float (&x)[4]) { u32x2 o; o.x = pk2(x[0], x[1]); o.y = pk2(x[2], x[3]); *(u32x2*)p = o; }
__device__ void p2_qkv(const Params& P, LAS unsigned char* lds) {
    const int tid = threadIdx.x, lane = tid & 63, wave = tid >> 6, h = wave & 3, half = wave >> 2;
    unsigned char* ws = P.ws;
    const bf16_t* PROJ = (const bf16_t*)(ws + WS_PROJ);
    bf16_t* Q = (bf16_t*)P.out; bf16_t* K = Q + (size_t)NTOK * DM; bf16_t* V = (bf16_t*)(ws + WS_XN);
    float* GATES = (float*)(ws + WS_GATES);
    LAS float* part = (LAS float*)lds;
    const int ch = h * 256 + lane * 4, blk = ch >> 2;
    float cw[4][4], cb[4], wq[4][4], wk[4][4], wv[4][4], wc[4][8], wx[4][8];
#pragma unroll
    for (int j = 0; j < 4; ++j)
#pragma unroll
        for (int d = 0; d < 4; ++d) cw[j][d] = P.in[I_CONV_W][j * DM + ch + d];
#pragma unroll
    for (int d = 0; d < 4; ++d) { cb[d] = P.in[I_CONV_B][ch + d];
#pragma unroll
        for (int e = 0; e < 4; ++e) { wq[d][e] = P.in[I_WQ][blk * 16 + d * 4 + e]; wk[d][e] = P.in[I_WK][blk * 16 + d * 4 + e]; wv[d][e] = P.in[I_WV][blk * 16 + d * 4 + e]; }
#pragma unroll
        for (int j = 0; j < 8; ++j) { wc[d][j] = ((const float*)(ws + WS_WCX))[(ch + d) * 8 + j]; wx[d][j] = ((const float*)(ws + WS_WCX))[DM * 8 + (ch + d) * 8 + j]; } }
    for (int item = blockIdx.x; item < NTOK / 16; item += gridDim.x) {
        const int tb = item * 16 + half * 8;
        u32x2 raw[11];
        const bool seq0 = (tb & (SEQ - 1)) == 0;
#pragma unroll
        for (int i = 0; i < 11; ++i) raw[i] = (i < 3 && seq0) ? (u32x2){0u, 0u} : *(const u32x2*)(PROJ + (size_t)(tb - 3 + i) * PROJW + ch);
        float x0[4], x1[4], x2[4], x3[4];
        up4(raw[0], x0); up4(raw[1], x1); up4(raw[2], x2);
#pragma unroll
        for (int i = 0; i < 8; ++i) {
            const int t = tb + i;
            up4(raw[3 + i], x3);
            float mc[4], q[4], k[4], v[4], gp[8];
#pragma unroll
            for (int d = 0; d < 4; ++d) mc[d] = siluf_(cw[0][d] * x0[d] + cw[1][d] * x1[d] + cw[2][d] * x2[d] + cw[3][d] * x3[d] + cb[d]);
#pragma unroll
            for (int e = 0; e < 4; ++e) { q[e] = mc[0] * wq[0][e] + mc[1] * wq[1][e] + mc[2] * wq[2][e] + mc[3] * wq[3][e];
                k[e] = mc[0] * wk[0][e] + mc[1] * wk[1][e] + mc[2] * wk[2][e] + mc[3] * wk[3][e];
                v[e] = x3[0] * wv[0][e] + x3[1] * wv[1][e] + x3[2] * wv[2][e] + x3[3] * wv[3][e]; }
            st4(Q + (size_t)t * DM + ch, q); st4(K + (size_t)t * DM + ch, k); st4(V + (size_t)t * DM + ch, v);
#pragma unroll
            for (int j = 0; j < 8; ++j) { float s = 0.f;
#pragma unroll
                for (int d = 0; d < 4; ++d) s += mc[d] * wc[d][j] + x3[d] * wx[d][j];
                gp[j] = wave_sum(s); }
            if (lane == 0) {
#pragma unroll
                for (int j = 0; j < 8; ++j) part[((half * 8 + i) * 4 + h) * 8 + j] = gp[j]; }
#pragma unroll
            for (int d = 0; d < 4; ++d) { x0[d] = x1[d]; x1[d] = x2[d]; x2[d] = x3[d]; }
        }
        __syncthreads();
        if (tid < 128) { const int tok = tid >> 3, j = tid & 7;
            const float val = part[(tok * 4 + 0) * 8 + j] + part[(tok * 4 + 1) * 8 + j] + part[(tok * 4 + 2) * 8 + j] + part[(tok * 4 + 3) * 8 + j] + P.in[I_B_IF][j];
            GATES[(size_t)(item * 16 + tok) * 8 + j] = (j < 4) ? val : log_sigmoid(val); }
        __syncthreads();
    }
    bf16_t* PW = (bf16_t*)(ws + WS_PROJ);
    const int gw = blockIdx.x * NWAVES + wave, NGW = gridDim.x * NWAVES;
    for (int m = gw; m < NTOK; m += NGW) {
        bf16_t* row = PW + (size_t)m * PROJW + 3 * DM + lane * 16;
        const u32x4 a = *(const u32x4*)row, b = *(const u32x4*)(row + 8);
        float x[16] = {bflo(a.x), bfhi(a.x), bflo(a.y), bfhi(a.y), bflo(a.z), bfhi(a.z), bflo(a.w), bfhi(a.w), bflo(b.x), bfhi(b.x), bflo(b.y), bfhi(b.y), bflo(b.z), bfhi(b.z), bflo(b.w), bfhi(b.w)};
        float s = 0.f;
#pragma unroll
        for (int i = 0; i < 16; ++i) s += x[i];
        const float mu = wave_sum(s) * (1.f / DM); float s2 = 0.f;
#pragma unroll
        for (int i = 0; i < 16; ++i) { x[i] -= mu; s2 += x[i] * x[i]; }
        const float r = 1.0f / sqrtf(wave_sum(s2) * (1.f / DM) + EPS);
        const float* lw = P.in[I_G_LN_W] + lane * 16; const float* lb = P.in[I_G_LN_B] + lane * 16;
#pragma unroll
        for (int i = 0; i < 16; ++i) x[i] = x[i] * r * lw[i] + lb[i];
        u32x4 oa, ob; oa.x = pk2(x[0], x[1]); oa.y = pk2(x[2], x[3]); oa.z = pk2(x[4], x[5]); oa.w = pk2(x[6], x[7]); ob.x = pk2(x[8], x[9]); ob.y = pk2(x[10], x[11]); ob.z = pk2(x[12], x[13]); ob.w = pk2(x[14], x[15]);
        *(u32x4*)row = oa; *(u32x4*)(row + 8) = ob;
    }
}

constexpr int ML_C = 0, ML_N = 65536, ML_Q = ML_N + 1024, ML_K = ML_Q + 32768, ML_V = ML_K + 32768, ML_P = ML_V + 8192, ML_S = ML_P + 16384, ML_BYTES = ML_S + 2048;
__device__ void p3_mlstm_naive(const Params& P, LAS unsigned char* lds) {
    const int tid = threadIdx.x, lane = tid & 63, wave = tid >> 6;
    unsigned char* ws = P.ws;
    const bf16_t* Q = (const bf16_t*)P.out; const bf16_t* K = Q + (size_t)NTOK * DM; bf16_t* V = (bf16_t*)(ws + WS_XN);
    const float* GATES = (const float*)(ws + WS_GATES);
    LAS float* Cs = (LAS float*)(lds + ML_C); LAS float* ns = (LAS float*)(lds + ML_N);
    LAS unsigned* qs = (LAS unsigned*)(lds + ML_Q); LAS unsigned* ks = (LAS unsigned*)(lds + ML_K);
    LAS bf16_t* vs = (LAS bf16_t*)(lds + ML_V);
    LAS float* Ps = (LAS float*)(lds + ML_P);
    LAS float* sc = (LAS float*)(lds + ML_S);
    for (int item = blockIdx.x; item < 256; item += gridDim.x) {
        const int b = item >> 4, h = (item >> 2) & 3, j = item & 3;
        for (int i = tid; i < 256 * 64; i += NTHR) Cs[i] = 0.f;
        if (tid < 256) ns[tid] = 0.f;
        float m = 0.f;
        __syncthreads();
        for (int c = 0; c < 32; ++c) {
            const size_t t0 = (size_t)b * SEQ + c * 64;
#pragma unroll
            for (int i = 0; i < 4; ++i) { const int p = tid + i * NTHR, r = p >> 5, cc = p & 31;
                *(LAS u32x4*)(qs + r * 128 + cc * 4) = *(const u32x4*)(Q + (t0 + r) * DM + h * 256 + cc * 8);
                *(LAS u32x4*)(ks + r * 128 + cc * 4) = *(const u32x4*)(K + (t0 + r) * DM + h * 256 + cc * 8); }
            { const int r = tid >> 3, cc = tid & 7; *(LAS u32x4*)(vs + r * 64 + cc * 8) = *(const u32x4*)(V + (t0 + r) * DM + h * 256 + j * 64 + cc * 8); }
            if (wave == 0) {
                const float ig = GATES[(t0 + lane) * 8 + h], lf = GATES[(t0 + lane) * 8 + 4 + h];
                float bs = lf;
#pragma unroll
                for (int o = 1; o < 64; o <<= 1) { const float t = __shfl_up(bs, o); if (lane >= o) bs += t; }
                const float u = ig - bs; float gm = u;
#pragma unroll
                for (int o = 1; o < 64; o <<= 1) { const float t = __shfl_up(gm, o); if (lane >= o) gm = fmaxf(gm, t); }
                const float g = fmaxf(gm, m), gL = __shfl(g, 63), bL = __shfl(bs, 63);
                sc[lane] = u; sc[64 + lane] = g; sc[128 + lane] = expf(m - g); sc[192 + lane] = expf(-bs - g); sc[256 + lane] = expf(u - gL);
                if (lane == 0) sc[384] = expf(m - gL);
                m = bL + gL;
            }
            __syncthreads();
            { const int t = tid >> 3, sg = tid & 7; float acc[8];
#pragma unroll
                for (int i = 0; i < 8; ++i) acc[i] = 0.f;
                if (sg * 8 <= t) {
                    for (int d2 = 0; d2 < 128; ++d2) { const unsigned qw = qs[t * 128 + d2]; const float ql = bflo(qw), qh = bfhi(qw);
#pragma unroll
                        for (int i = 0; i < 8; ++i) { const unsigned kw = ks[(sg * 8 + i) * 128 + d2]; acc[i] += ql * bflo(kw) + qh * bfhi(kw); } } }
                const float gt = sc[64 + t];
#pragma unroll
                for (int i = 0; i < 8; ++i) { const int s = sg * 8 + i; Ps[t * 64 + s] = (s <= t) ? acc[i] * 0.0625f * expf(sc[s] - gt) : 0.f; } }
            __syncthreads();
            if (tid < 64) { const int t = tid; float qn = 0.f;
                for (int d2 = 0; d2 < 128; ++d2) { const unsigned qw = qs[t * 128 + d2]; qn += bflo(qw) * ns[2 * d2] + bfhi(qw) * ns[2 * d2 + 1]; }
                float ps = 0.f;
                for (int s = 0; s <= t; ++s) ps += Ps[t * 64 + s];
                sc[320 + t] = sc[128 + t] * qn + ps; }
            __syncthreads();
            { const int t = tid >> 3, eg = tid & 7; float acc[8];
#pragma unroll
                for (int i = 0; i < 8; ++i) acc[i] = 0.f;
                for (int d2 = 0; d2 < 128; ++d2) { const unsigned qw = qs[t * 128 + d2]; const float ql = bflo(qw), qh = bfhi(qw);
#pragma unroll
                    for (int i = 0; i < 8; ++i) acc[i] += ql * Cs[(2 * d2) * 64 + eg * 8 + i] + qh * Cs[(2 * d2 + 1) * 64 + eg * 8 + i]; }
                const float iw = sc[128 + t];
#pragma unroll
                for (int i = 0; i < 8; ++i) acc[i] *= iw;
                for (int s = 0; s <= t; ++s) { const float pv = Ps[t * 64 + s];
#pragma unroll
                    for (int i = 0; i < 8; ++i) acc[i] += pv * bf2f(vs[s * 64 + eg * 8 + i]); }
                const float dn = 1.0f / fmaxf(fabsf(sc[320 + t]), sc[192 + t]);
                u32x4 o; o.x = pk2(acc[0] * dn, acc[1] * dn); o.y = pk2(acc[2] * dn, acc[3] * dn); o.z = pk2(acc[4] * dn, acc[5] * dn); o.w = pk2(acc[6] * dn, acc[7] * dn);
                *(u32x4*)(V + (t0 + t) * DM + h * 256 + j * 64 + eg * 8) = o;
            }
            __syncthreads();
            { const int d = tid >> 1, eh = tid & 1; const float decay = sc[384]; float acc[32];
#pragma unroll
                for (int i = 0; i < 32; ++i) acc[i] = decay * Cs[d * 64 + eh * 32 + i];
                float nacc = decay * ns[d];
                for (int s = 0; s < 64; ++s) { const unsigned kw = ks[s * 128 + (d >> 1)]; const float kv = ((d & 1) ? bfhi(kw) : bflo(kw)) * 0.0625f * sc[256 + s];
                    nacc += kv;
#pragma unroll
                    for (int i = 0; i < 32; ++i) acc[i] += kv * bf2f(vs[s * 64 + eh * 32 + i]); }
#pragma unroll
                for (int i = 0; i < 32; ++i) Cs[d * 64 + eh * 32 + i] = acc[i];
                if (eh == 0) ns[d] = nacc; }
            __syncthreads();
        }
    }
}

__device__ void p3_gmlp_naive(const Params& P, LAS unsigned char* lds) {
    const int tid = threadIdx.x;
    bf16_t* PROJ = (bf16_t*)(P.ws + WS_PROJ);
    LAS bf16_t* vv = (LAS bf16_t*)lds;
    const float* WSP = P.in[I_W_SP]; const float* BSP = P.in[I_B_SP];
    for (int item = blockIdx.x; item < 2048; item += gridDim.x) {
        const int g = item & 7, c = (item >> 3) & 15, b = item >> 7; const size_t t0 = (size_t)b * SEQ + c * 128;
#pragma unroll
        for (int i = 0; i < 4; ++i) { const int p = tid + i * NTHR, r = p >> 4, cc = p & 15; *(LAS u32x4*)(vv + r * 128 + cc * 8) = *(const u32x4*)(PROJ + (t0 + r) * PROJW + 3 * DM + g * 128 + cc * 8); }
        __syncthreads();
        const int t = tid >> 2, dg = tid & 3; float acc[32];
#pragma unroll
        for (int i = 0; i < 32; ++i) acc[i] = 0.f;
        const float* wrow = WSP + ((size_t)g * 128 + t) * 128;
        for (int s = 0; s <= t; ++s) { const float w = wrow[s];
#pragma unroll
            for (int i = 0; i < 32; ++i) acc[i] += w * bf2f(vv[s * 128 + dg * 32 + i]); }
        const float bs = BSP[g * 128 + t];
        bf16_t* gu = PROJ + (t0 + t) * PROJW + 2 * DM + g * 128 + dg * 32;
#pragma unroll
        for (int i = 0; i < 4; ++i) { const u32x4 w = *(const u32x4*)(gu + i * 8); u32x4 o;
            o.x = pk2(bflo(w.x) * (acc[i * 8 + 0] + bs), bfhi(w.x) * (acc[i * 8 + 1] + bs)); o.y = pk2(bflo(w.y) * (acc[i * 8 + 2] + bs), bfhi(w.y) * (acc[i * 8 + 3] + bs));
            o.z = pk2(bflo(w.z) * (acc[i * 8 + 4] + bs), bfhi(w.z) * (acc[i * 8 + 5] + bs)); o.w = pk2(bflo(w.w) * (acc[i * 8 + 6] + bs), bfhi(w.w) * (acc[i * 8 + 7] + bs));
            *(u32x4*)(gu + i * 8) = o; }
        __syncthreads();
    }
}

namespace mlm {
constexpr int QP = 264, VP = 88, PP = 72;
constexpr int VSB = 64 * VP * 2;
constexpr int QS_OFF = 0, KS_OFF = QS_OFF + 64 * QP * 2, VS_OFF = KS_OFF + 64 * QP * 2, CT_OFF = VS_OFF + 2 * VSB, PS_OFF = CT_OFF + 80 * QP * 2, SC_OFF = PS_OFF + 64 * PP * 2, BYTES = SC_OFF + 4096;
typedef short s16x4 __attribute__((ext_vector_type(4)));
typedef float f32x2_t __attribute__((ext_vector_type(2)));
typedef __bf16 bf16x2_t __attribute__((ext_vector_type(2)));
__device__ __forceinline__ unsigned cvtpk(float lo, float hi) { f32x2_t v = {lo, hi}; bf16x2_t b = __builtin_convertvector(v, bf16x2_t); return __builtin_bit_cast(unsigned, b); }
__device__ __forceinline__ s16x4 tr16(LAS unsigned char* p) { return __builtin_bit_cast(s16x4, __builtin_amdgcn_ds_read_tr16_b64_v4i16((LAS s16x4*)p)); }
__device__ __forceinline__ bf16x8 frag_tr(LAS unsigned char* p, int pitch_bytes) {
    const s16x4 lo = tr16(p), hi = tr16(p + 4 * pitch_bytes);
    return (bf16x8){lo.x, lo.y, lo.z, lo.w, hi.x, hi.y, hi.z, hi.w};
}
}
__device__ void p3_mlstm_mfma(const Params& P, LAS unsigned char* lds) {
    using namespace mlm;
    const int tid = threadIdx.x, lane = tid & 63, wave = __builtin_amdgcn_readfirstlane(tid >> 6), fr = lane & 15, fq = lane >> 4, q_ = fr >> 2, p_ = fr & 3;
    const int tau = wave >> 1, par = wave & 1;
    unsigned char* ws = P.ws;
    const bf16_t* Q = (const bf16_t*)P.out; const bf16_t* K = Q + (size_t)NTOK * DM; bf16_t* V = (bf16_t*)(ws + WS_XN);
    const float* GATES = (const float*)(ws + WS_GATES);
    for (int it = blockIdx.x; it < 256; it += gridDim.x) {
        const int item = (gridDim.x == 256) ? (((it & 7) * 8 + (it >> 5)) * 4 + ((it >> 3) & 3)) : it;
        const int b = item >> 4, h = (item >> 2) & 3, j = item & 3;
        float* scg = (float*)(ws + WS_END) + (size_t)it * 32 * 384;
        {
            LAS float* cb = (LAS float*)(lds + SC_OFF);
            float bs[4], uu[4], cm[4];
#pragma unroll
            for (int i = 0; i < 4; ++i) { const int c = wave + 8 * i; const size_t t = (size_t)b * SEQ + c * 64 + lane;
                float s = GATES[t * 8 + 4 + h]; const float ig = GATES[t * 8 + h];
#pragma unroll
                for (int o = 1; o < 64; o <<= 1) { const float x = __shfl_up(s, o); if (lane >= o) s += x; }
                const float u = ig - s; float g = u;
#pragma unroll
                for (int o = 1; o < 64; o <<= 1) { const float x = __shfl_up(g, o); if (lane >= o) g = fmaxf(g, x); }
                bs[i] = s; uu[i] = u; cm[i] = g;
                if (lane == 63) { cb[c] = s; cb[32 + c] = g; } }
            __syncthreads();
            if (tid == 0) { float m = 0.f; for (int c = 0; c < 32; ++c) { const float gL = fmaxf(m, cb[32 + c]); cb[64 + c] = m; cb[96 + c] = gL; m = cb[c] + gL; } }
            __syncthreads();
#pragma unroll
            for (int i = 0; i < 4; ++i) { const int c = wave + 8 * i; const float m = cb[64 + c], gL = cb[96 + c], g = fmaxf(m, cm[i]); float* o = scg + c * 384;
                o[lane] = uu[i]; o[64 + lane] = g; o[128 + lane] = expf(m - g); o[192 + lane] = expf(-bs[i] - g); o[256 + lane] = expf(uu[i] - gL) * 0.0625f;
                if (lane == 0) o[320] = expf(m - gL); }
            asm volatile("s_waitcnt vmcnt(0)" ::: "memory");
            __syncthreads();
        }
        for (int i = tid; i < 80 * QP * 2 / 16; i += NTHR) ((LAS u32x4*)(lds + CT_OFF))[i] = (u32x4){0u, 0u, 0u, 0u};
        if (tid < 128) { LAS bf16_t* r = (LAS bf16_t*)(lds + VS_OFF + (tid >> 6) * VSB) + (tid & 63) * VP + 64; r[0] = 0x3F80;
#pragma unroll
            for (int i = 1; i < 24; ++i) r[i] = 0; }
        f32x4 cacc[2][5];
#pragma unroll
        for (int a = 0; a < 2; ++a)
#pragma unroll
            for (int e = 0; e < 5; ++e) cacc[a][e] = (f32x4){0.f, 0.f, 0.f, 0.f};
        u32x4 pq[4], pk[4], pv; float psc[6];
        const bf16_t* qb = Q + (size_t)b * SEQ * DM + h * 256; const bf16_t* kb = K + (size_t)b * SEQ * DM + h * 256; bf16_t* vb = V + (size_t)b * SEQ * DM + h * 256 + j * 64;
#define ML_LOAD(c_) do { const size_t r0_ = (size_t)(c_) * 64; \
            _Pragma("unroll") for (int i = 0; i < 4; ++i) { const int p = tid + i * NTHR, r = p >> 5, cc = p & 31; pq[i] = *(const u32x4*)(qb + (r0_ + r) * DM + cc * 8); pk[i] = *(const u32x4*)(kb + (r0_ + r) * DM + cc * 8); } \
            pv = *(const u32x4*)(vb + (r0_ + (tid >> 3)) * DM + (tid & 7) * 8); \
            if (wave == 0) { const float* s_ = scg + (c_) * 384; _Pragma("unroll") for (int i = 0; i < 5; ++i) psc[i] = __builtin_nontemporal_load(s_ + 64 * i + lane); psc[5] = __builtin_nontemporal_load(s_ + 320); } } while (0)
#define ML_STORE(c_) do { \
            _Pragma("unroll") for (int i = 0; i < 4; ++i) { const int p = tid + i * NTHR, r = p >> 5, cc = p & 31; *(LAS u32x4*)(lds + QS_OFF + r * QP * 2 + cc * 16) = pq[i]; *(LAS u32x4*)(lds + KS_OFF + r * QP * 2 + cc * 16) = pk[i]; } \
            *(LAS u32x4*)(lds + VS_OFF + ((c_) & 1) * VSB + (tid >> 3) * VP * 2 + (tid & 7) * 16) = pv; \
            if (wave == 0) { LAS float* s_ = (LAS float*)(lds + SC_OFF) + ((c_) & 1) * 512; _Pragma("unroll") for (int i = 0; i < 5; ++i) s_[64 * i + lane] = psc[i]; if (lane == 0) s_[320] = psc[5]; } } while (0)
        ML_LOAD(0);
        __syncthreads();
        ML_STORE(0);
        __syncthreads();
        for (int c = 0; c < 32; ++c) {
            LAS float* sc = (LAS float*)(lds + SC_OFF) + (c & 1) * 512;
            if (c + 1 < 32) ML_LOAD(c + 1);
            bf16x8 qf[8];
#pragma unroll
            for (int kap = 0; kap < 8; ++kap) qf[kap] = *(const LAS bf16x8*)(lds + QS_OFF + ((16 * tau + fr) * QP + 32 * kap + 8 * fq) * 2);
            const float gt = sc[64 + 16 * tau + fr];
#pragma unroll
            for (int si = 0; si < 2; ++si) {
                const int sig = 2 * par + si; f32x4 acc = (f32x4){0.f, 0.f, 0.f, 0.f};
                if (sig <= tau) {
#pragma unroll
                    for (int kap = 0; kap < 8; ++kap) acc = __builtin_amdgcn_mfma_f32_16x16x32_bf16(*(const LAS bf16x8*)(lds + KS_OFF + ((16 * sig + fr) * QP + 32 * kap + 8 * fq) * 2), qf[kap], acc, 0, 0, 0);
                }
                const f32x4 us = *(const LAS f32x4*)(sc + 16 * sig + 4 * fq);
                const int t = 16 * tau + fr, s0 = 16 * sig + 4 * fq;
                const float w0 = (s0 + 0 <= t) ? acc.x * 0.0625f * __expf(us.x - gt) : 0.f, w1 = (s0 + 1 <= t) ? acc.y * 0.0625f * __expf(us.y - gt) : 0.f;
                const float w2 = (s0 + 2 <= t) ? acc.z * 0.0625f * __expf(us.z - gt) : 0.f, w3 = (s0 + 3 <= t) ? acc.w * 0.0625f * __expf(us.w - gt) : 0.f;
                u32x2 o; o.x = cvtpk(w0, w1); o.y = cvtpk(w2, w3);
                *(LAS u32x2*)(lds + PS_OFF + (t * PP + s0) * 2) = o;
            }
            f32x4 nacc[3];
#pragma unroll
            for (int ei = 0; ei < 3; ++ei) {
                const int eps = (ei == 2) ? 4 : 2 * par + ei; f32x4 acc = (f32x4){0.f, 0.f, 0.f, 0.f};
#pragma unroll
                for (int kap = 0; kap < 8; ++kap) acc = __builtin_amdgcn_mfma_f32_16x16x32_bf16(*(const LAS bf16x8*)(lds + CT_OFF + ((16 * eps + fr) * QP + 32 * kap + 8 * fq) * 2), qf[kap], acc, 0, 0, 0);
                nacc[ei] = acc * sc[128 + 16 * tau + fr];
            }
            bf16x8 kw[2][2];
#pragma unroll
            for (int dl = 0; dl < 2; ++dl)
#pragma unroll
                for (int kp = 0; kp < 2; ++kp) {
                    const bf16x8 f = frag_tr(lds + KS_OFF + ((32 * kp + 8 * fq + q_) * QP + 16 * (2 * wave + dl) + 4 * p_) * 2, QP * 2);
                    const u32x4 fw = __builtin_bit_cast(u32x4, f);
                    const f32x4 wa = *(const LAS f32x4*)(sc + 256 + 32 * kp + 8 * fq), wb = *(const LAS f32x4*)(sc + 256 + 32 * kp + 8 * fq + 4);
                    u32x4 o; o.x = cvtpk(bflo(fw.x) * wa.x, bfhi(fw.x) * wa.y); o.y = cvtpk(bflo(fw.y) * wa.z, bfhi(fw.y) * wa.w); o.z = cvtpk(bflo(fw.z) * wb.x, bfhi(fw.z) * wb.y); o.w = cvtpk(bflo(fw.w) * wb.z, bfhi(fw.w) * wb.w);
                    kw[dl][kp] = __builtin_bit_cast(bf16x8, o);
                }
            LAS unsigned char* vsc = lds + VS_OFF + (c & 1) * VSB;
            const float lowb = sc[192 + 16 * tau + fr], decay = sc[320];
            __syncthreads();
            {
                bf16x8 pf[2];
#pragma unroll
                for (int kp = 0; kp < 2; ++kp) pf[kp] = *(const LAS bf16x8*)(lds + PS_OFF + ((16 * tau + fr) * PP + 32 * kp + 8 * fq) * 2);
#pragma unroll
                for (int ei = 0; ei < 3; ++ei) {
#pragma unroll
                    for (int kp = 0; kp < 2; ++kp) {
                        const int eps = (ei == 2) ? 4 : 2 * par + ei;
                        nacc[ei] = __builtin_amdgcn_mfma_f32_16x16x32_bf16(frag_tr(vsc + ((32 * kp + 8 * fq + q_) * VP + 16 * eps + 4 * p_) * 2, VP * 2), pf[kp], nacc[ei], 0, 0, 0);
                    }
                }
                const float den = __shfl(nacc[2].x, fr);
                const float rinv = 1.0f / fmaxf(fabsf(den), lowb);
                bf16_t* hrow = vb + ((size_t)c * 64 + 16 * tau + fr) * DM;
#pragma unroll
                for (int ei = 0; ei < 2; ++ei) { const int eps = 2 * par + ei; u32x2 o; o.x = cvtpk(nacc[ei].x * rinv, nacc[ei].y * rinv); o.y = cvtpk(nacc[ei].z * rinv, nacc[ei].w * rinv);
                    *(u32x2*)(hrow + 16 * eps + 4 * fq) = o; }
            }
#pragma unroll
            for (int eps = 0; eps < 5; ++eps) {
                bf16x8 vf[2];
#pragma unroll
                for (int kp = 0; kp < 2; ++kp) vf[kp] = frag_tr(vsc + ((32 * kp + 8 * fq + q_) * VP + 16 * eps + 4 * p_) * 2, VP * 2);
#pragma unroll
                for (int dl = 0; dl < 2; ++dl) {
                    f32x4 a = cacc[dl][eps] * decay;
                    a = __builtin_amdgcn_mfma_f32_16x16x32_bf16(kw[dl][0], vf[0], a, 0, 0, 0);
                    a = __builtin_amdgcn_mfma_f32_16x16x32_bf16(kw[dl][1], vf[1], a, 0, 0, 0);
                    cacc[dl][eps] = a;
                    u32x2 o; o.x = cvtpk(a.x, a.y); o.y = cvtpk(a.z, a.w);
                    *(LAS u32x2*)(lds + CT_OFF + ((16 * eps + fr) * QP + 16 * (2 * wave + dl) + 4 * fq) * 2) = o;
                }
            }
            if (c + 1 < 32) ML_STORE(c + 1);
            __syncthreads();
        }
#undef ML_LOAD
#undef ML_STORE
    }
}

namespace gmm { constexpr int VVP = 136, VV_OFF = 0, WS_OFF = 128 * VVP * 2, BYTES = 2 * 128 * VVP * 2; }
__device__ void p3_gmlp_mfma(const Params& P, LAS unsigned char* lds) {
    using namespace gmm;
    const int tid = threadIdx.x, lane = tid & 63, wave = __builtin_amdgcn_readfirstlane(tid >> 6), fr = lane & 15, fq = lane >> 4, q_ = fr >> 2, p_ = fr & 3;
    bf16_t* PROJ = (bf16_t*)(P.ws + WS_PROJ); const bf16_t* WSPb = (const bf16_t*)(P.ws + WS_WSP); const float* BSP = P.in[I_B_SP];
    int g_staged = -1;
    u32x4 pre[4];
#define GM_LOAD(it_) do { const int g_ = (it_) & 7, c_ = ((it_) >> 3) & 15, b_ = (it_) >> 7; const size_t t0_ = (size_t)b_ * SEQ + c_ * 128; \
        _Pragma("unroll") for (int i = 0; i < 4; ++i) { const int p = tid + i * NTHR, r = p >> 4, cc = p & 15; pre[i] = *(const u32x4*)(PROJ + (t0_ + r) * PROJW + 3 * DM + g_ * 128 + cc * 8); } } while (0)
    if ((int)blockIdx.x < 2048) GM_LOAD(blockIdx.x);
    for (int item = blockIdx.x; item < 2048; item += gridDim.x) {
        const int g = item & 7, c = (item >> 3) & 15, b = item >> 7; const size_t t0 = (size_t)b * SEQ + c * 128;
#pragma unroll
        for (int i = 0; i < 4; ++i) { const int p = tid + i * NTHR, r = p >> 4, cc = p & 15; *(LAS u32x4*)(lds + VV_OFF + (r * VVP + cc * 8) * 2) = pre[i]; }
        if (g != g_staged) {
#pragma unroll
            for (int i = 0; i < 4; ++i) { const int p = tid + i * NTHR, r = p >> 4, cc = p & 15; *(LAS u32x4*)(lds + WS_OFF + (r * VVP + cc * 8) * 2) = *(const u32x4*)(WSPb + ((size_t)g * 128 + r) * 128 + cc * 8); }
            g_staged = g;
        }
        __syncthreads();
        if (item + (int)gridDim.x < 2048) GM_LOAD(item + gridDim.x);
        bf16x8 af[4];
#pragma unroll
        for (int kap = 0; kap < 4; ++kap) af[kap] = mlm::frag_tr(lds + VV_OFF + ((32 * kap + 8 * fq + q_) * VVP + 16 * wave + 4 * p_) * 2, VVP * 2);
#pragma unroll
        for (int th = 0; th < 8; ++th) {
            f32x4 acc = (f32x4){0.f, 0.f, 0.f, 0.f};
#pragma unroll
            for (int kap = 0; kap <= (th >> 1); ++kap) acc = __builtin_amdgcn_mfma_f32_16x16x32_bf16(af[kap], *(const LAS bf16x8*)(lds + WS_OFF + ((16 * th + fr) * VVP + 32 * kap + 8 * fq) * 2), acc, 0, 0, 0);
            const int t = 16 * th + fr; const float bs = BSP[g * 128 + t];
            bf16_t* gu = PROJ + (t0 + t) * PROJW + 2 * DM + g * 128 + 16 * wave + 4 * fq;
            const u32x2 w = *(const u32x2*)gu; u32x2 o;
            o.x = mlm::cvtpk(bflo(w.x) * (acc.x + bs), bfhi(w.x) * (acc.y + bs)); o.y = mlm::cvtpk(bflo(w.y) * (acc.z + bs), bfhi(w.y) * (acc.w + bs));
            *(u32x2*)gu = o;
        }
        __syncthreads();
    }
#undef GM_LOAD
}

__device__ void p4_ym(const Params& P, LAS unsigned char*) {
    const int tid = threadIdx.x, lane = tid & 63, wave = tid >> 6, h = wave & 3, half = wave >> 2;
    bf16_t* PROJ = (bf16_t*)(P.ws + WS_PROJ); const bf16_t* HM = (const bf16_t*)(P.ws + WS_XN);
    const int ch = h * 256 + lane * 4;
    float cw[4][4], cb[4], ng[4], sk[4];
#pragma unroll
    for (int j = 0; j < 4; ++j)
#pragma unroll
        for (int d = 0; d < 4; ++d) cw[j][d] = P.in[I_CONV_W][j * DM + ch + d];
#pragma unroll
    for (int d = 0; d < 4; ++d) { cb[d] = P.in[I_CONV_B][ch + d]; ng[d] = P.in[I_M_NORM_G][ch + d]; sk[d] = P.in[I_M_SKIP][ch + d]; }
    for (int item = blockIdx.x; item < NTOK / 16; item += gridDim.x) {
        const int tb = item * 16 + half * 8;
        u32x2 raw[11], rh[8], rz[8];
        const bool seq0 = (tb & (SEQ - 1)) == 0;
#pragma unroll
        for (int i = 0; i < 11; ++i) raw[i] = (i < 3 && seq0) ? (u32x2){0u, 0u} : *(const u32x2*)(PROJ + (size_t)(tb - 3 + i) * PROJW + ch);
#pragma unroll
        for (int i = 0; i < 8; ++i) { rh[i] = *(const u32x2*)(HM + (size_t)(tb + i) * DM + ch); rz[i] = *(const u32x2*)(PROJ + (size_t)(tb + i) * PROJW + DM + ch); }
        float x0[4], x1[4], x2[4], x3[4];
        up4(raw[0], x0); up4(raw[1], x1); up4(raw[2], x2);
#pragma unroll
        for (int i = 0; i < 8; ++i) {
            const int t = tb + i;
            up4(raw[3 + i], x3);
            float hm[4], sz[4], y[4];
            up4(rh[i], hm); up4(rz[i], sz);
            const float mu = wave_sum(hm[0] + hm[1] + hm[2] + hm[3]) * (1.f / 256.f);
            float s2 = 0.f;
#pragma unroll
            for (int d = 0; d < 4; ++d) { hm[d] -= mu; s2 += hm[d] * hm[d]; }
            const float r = 1.0f / sqrtf(wave_sum(s2) * (1.f / 256.f) + EPS);
#pragma unroll
            for (int d = 0; d < 4; ++d) { const float mc = siluf_(cw[0][d] * x0[d] + cw[1][d] * x1[d] + cw[2][d] * x2[d] + cw[3][d] * x3[d] + cb[d]);
                y[d] = (hm[d] * r * ng[d] + sk[d] * mc) * sz[d]; }
            st4(PROJ + (size_t)t * PROJW + DM + ch, y);
#pragma unroll
            for (int d = 0; d < 4; ++d) { x0[d] = x1[d]; x1[d] = x2[d]; x2[d] = x3[d]; }
        }
    }
}

__device__ void norm_pass(const float* xi, const bf16_t* y, const float* g1, float* xo, const float* g2, bf16_t* hn, int ldh, int hoff, const float* pin) {
    const int tid = threadIdx.x, lane = tid & 63, wave = tid >> 6;
    const int gw = blockIdx.x * NWAVES + wave, NGW = gridDim.x * NWAVES;
    for (int m0 = gw; m0 < NTOK; m0 += 2 * NGW) {
        const int m1 = m0 + NGW; const bool has1 = m1 < NTOK; const int mm[2] = {m0, has1 ? m1 : m0};
        f32x4 v[2][4], xv[2][4]; float s[2] = {0.f, 0.f};
#pragma unroll
        for (int r = 0; r < 2; ++r) {
            const u32x2* yr = (const u32x2*)(y + (size_t)mm[r] * DM) + lane; const f32x4* xr = (const f32x4*)(xi + (size_t)mm[r] * DM) + lane;
#pragma unroll
            for (int j = 0; j < 4; ++j) { const u32x2 w = yr[64 * j]; v[r][j] = (f32x4){bflo(w.x), bfhi(w.x), bflo(w.y), bfhi(w.y)}; xv[r][j] = xr[64 * j]; }
        }
        f32x4 gv1[4];
#pragma unroll
        for (int j = 0; j < 4; ++j) gv1[j] = ((const f32x4*)g1 + lane)[64 * j];
#pragma unroll
        for (int r = 0; r < 2; ++r)
#pragma unroll
            for (int j = 0; j < 4; ++j) s[r] += (v[r][j].x * v[r][j].x + v[r][j].y * v[r][j].y) + (v[r][j].z * v[r][j].z + v[r][j].w * v[r][j].w);
#pragma unroll
        for (int o = 1; o < 64; o <<= 1) { s[0] += __shfl_xor(s[0], o); s[1] += __shfl_xor(s[1], o); }
        float s2[2] = {0.f, 0.f};
#pragma unroll
        for (int r = 0; r < 2; ++r) {
            const float rr = 1.0f / sqrtf(s[r] * (1.f / DM) + EPS);
            f32x4* orow = (f32x4*)(xo + (size_t)mm[r] * DM) + lane;
#pragma unroll
            for (int j = 0; j < 4; ++j) { v[r][j] = xv[r][j] + v[r][j] * rr * gv1[j]; if (r == 0 || has1) orow[64 * j] = v[r][j];
                s2[r] += (v[r][j].x * v[r][j].x + v[r][j].y * v[r][j].y) + (v[r][j].z * v[r][j].z + v[r][j].w * v[r][j].w); }
        }
        if (hn) {
#pragma unroll
            for (int o = 1; o < 64; o <<= 1) { s2[0] += __shfl_xor(s2[0], o); s2[1] += __shfl_xor(s2[1], o); }
            f32x4 gv2[4];
#pragma unroll
            for (int j = 0; j < 4; ++j) gv2[j] = ((const f32x4*)g2 + lane)[64 * j];
#pragma unroll
            for (int r = 0; r < 2; ++r) {
                if (r == 1 && !has1) break;
                const float r2 = 1.0f / sqrtf(s2[r] * (1.f / DM) + EPS);
                u32x2* o8 = (u32x2*)(hn + (size_t)mm[r] * ldh + hoff) + lane;
#pragma unroll
                for (int j = 0; j < 4; ++j) { u32x2 o; o.x = pk2(v[r][j].x * r2 * gv2[j].x, v[r][j].y * r2 * gv2[j].y); o.y = pk2(v[r][j].z * r2 * gv2[j].z, v[r][j].w * r2 * gv2[j].w); o8[64 * j] = o; }
                if (pin) { const f32x4 pv = ((const f32x4*)(pin + (size_t)mm[r] * PLE))[lane]; u32x2 o; o.x = pk2(pv.x, pv.y); o.y = pk2(pv.z, pv.w); ((u32x2*)(hn + (size_t)mm[r] * ldh))[lane] = o; }
            }
        }
    }
}

#define XB_TMO      128
#define XB_XCNT(j)  (256  + 64 * (j))
#define XB_XSUB(j)  (1280 + 64 * (j))
#define XB_XGEN(j)  (2304 + 64 * (j))
#define XB_TOP      3328
#define XB_TOPGEN   3392
#define XCD_BAR_WORDS 3456
#define XB_SPIN_CAP (1u << 20)
__device__ __forceinline__ unsigned xb_ld(unsigned* p)              { return __hip_atomic_load(p, __ATOMIC_RELAXED, __HIP_MEMORY_SCOPE_AGENT); }
__device__ __forceinline__ unsigned xb_add(unsigned* p, unsigned v) { return __hip_atomic_fetch_add(p, v, __ATOMIC_RELAXED, __HIP_MEMORY_SCOPE_AGENT); }
__device__ __forceinline__ unsigned xb_xcc_id() { return (unsigned)__builtin_amdgcn_s_getreg((3 << 11) | 20) & 0xFu; }
#define XB_SPIN(cond, bar) do { unsigned _sp = 0; while (cond) { __builtin_amdgcn_s_sleep(1); \
    if ((++_sp & 255u) == 0u) { if (xb_ld(&(bar)[XB_TMO])) break; if (_sp > XB_SPIN_CAP) { atomicAdd(&(bar)[XB_TMO], 1u); break; } } } } while (0)
struct XcdBarrier { unsigned* bar; unsigned x; volatile LAS unsigned* st; };
__device__ __forceinline__ XcdBarrier xcd_barrier_post(unsigned* bar, volatile LAS unsigned* st) {
    XcdBarrier b; b.bar = bar; b.x = xb_xcc_id(); b.st = st;
    if (threadIdx.x == 0) (void)xb_add(&bar[XB_XCNT(b.x)], 1u);
    return b;
}
__device__ __forceinline__ void xcd_barrier_complete(unsigned* bar, unsigned x, unsigned& nloc, unsigned& nx) {
    const unsigned G = gridDim.x * gridDim.y * gridDim.z;
    unsigned sum, cnt, mine, sp = 0u;
    for (;;) {
        sum = 0u; cnt = 0u; mine = 0u;
#pragma unroll
        for (unsigned j = 0; j < 16; ++j) { const unsigned c = xb_ld(&bar[XB_XCNT(j)]); sum += c; cnt += (c > 0u) ? 1u : 0u; mine = (j == x) ? c : mine; }
        if (sum == G) break;
        __builtin_amdgcn_s_sleep(1);
        if ((++sp & 255u) == 0u) { if (xb_ld(&bar[XB_TMO])) break; if (sp > XB_SPIN_CAP) { atomicAdd(&bar[XB_TMO], 1u); break; } }
    }
    nloc = mine > 0u ? mine : 1u; nx = cnt > 0u ? cnt : 1u;
}
__device__ __forceinline__ void xcd_barrier(const XcdBarrier& b) {
    asm volatile("s_waitcnt vmcnt(0)" ::: "memory");
    __syncthreads();
    if (threadIdx.x == 0) {
        unsigned* bar = b.bar;
        __builtin_amdgcn_s_waitcnt(0);
        unsigned nloc = b.st[0], nx = b.st[1];
        if (nloc == 0u) { xcd_barrier_complete(bar, b.x, nloc, nx); b.st[0] = nloc; b.st[1] = nx; }
        const unsigned old = xb_add(&bar[XB_XSUB(b.x)], 1u);
        const unsigned gen = old / nloc;
        if (old + 1u == (gen + 1u) * nloc) {
            __builtin_amdgcn_fence(__ATOMIC_RELEASE, "agent");
            asm volatile("s_waitcnt vmcnt(0)" ::: "memory");
            const unsigned og = xb_add(&bar[XB_TOP], 1u);
            const unsigned tg = og / nx;
            if (og + 1u == (tg + 1u) * nx) xb_add(&bar[XB_TOPGEN], 1u);
            else XB_SPIN(xb_ld(&bar[XB_TOPGEN]) == tg, bar);
            __builtin_amdgcn_fence(__ATOMIC_ACQUIRE, "agent");
            xb_add(&bar[XB_XGEN(b.x)], 1u);
            asm volatile("s_waitcnt vmcnt(0)" ::: "memory");
        } else {
            XB_SPIN(xb_ld(&bar[XB_XGEN(b.x)]) == gen, bar);
            __builtin_amdgcn_fence(__ATOMIC_ACQUIRE, "agent");
            asm volatile("s_waitcnt vmcnt(0)" ::: "memory");
        }
    }
    __syncthreads();
}

#ifndef MEGA
#define MEGA 1
#endif
namespace cg = cooperative_groups;
constexpr int NPHASE = 13;
constexpr int LDS_BYTES = 160 * 1024 - 1024;
constexpr int MISC_OFF = LDS_BYTES - 256;
constexpr int CW_BAR = 4096;
constexpr size_t CTL_ZERO_BYTES = 64 * 1024;
#ifndef USE_CG_SYNC
#define USE_CG_SYNC 0
#endif
static_assert(ML_BYTES <= LDS_BYTES && pg8::STAGE_BYTES <= LDS_BYTES && mlm::BYTES <= MISC_OFF && ML_BYTES <= MISC_OFF && (CW_BAR + XCD_BAR_WORDS) * 4 <= (int)CTL_ZERO_BYTES, "lds");

template <int LO, int HI> __global__ void __launch_bounds__(NTHR, 2) fwd_kernel(Params P) {
    extern __shared__ __attribute__((aligned(16))) unsigned char lds_raw[];
    LAS unsigned char* lds = (LAS unsigned char*)lds_raw;
    unsigned char* ws = P.ws;
    bf16_t* PROJ = (bf16_t*)(ws + WS_PROJ); bf16_t* XN = (bf16_t*)(ws + WS_XN); bf16_t* HB = (bf16_t*)(ws + WS_HB); bf16_t* Y = (bf16_t*)(ws + WS_Y);
    const int G = gridDim.x, bid = blockIdx.x;
#define IN(k) (LO <= (k) && (k) < HI)
#if USE_CG_SYNC
#define SEAM(k) do { if (IN(k) && IN((k) + 1)) cg::this_grid().sync(); } while (0)
#else
    if (HI - LO > 1) { volatile LAS unsigned* misc = (volatile LAS unsigned*)(lds + MISC_OFF); if (threadIdx.x < 2) misc[threadIdx.x] = 0u; __syncthreads(); (void)xcd_barrier_post((unsigned*)(P.ws + WS_CTL) + CW_BAR, misc); }
#define SEAM(k) do { if (IN(k) && IN((k) + 1)) { XcdBarrier xb_; xb_.bar = (unsigned*)(P.ws + WS_CTL) + CW_BAR; xb_.x = xb_xcc_id(); xb_.st = (volatile LAS unsigned*)((LAS unsigned char*)lds_raw + MISC_OFF); xcd_barrier(xb_); } } while (0)
#endif
    if (IN(0)) p0_prologue(P, lds);
    SEAM(0);
    if (IN(1)) { pg8::Gemm g{XN, (const bf16_t*)(ws + WS_WIN), DM, DM, NTOK, PROJW, DM}; pg8::StaticOrder S; S.init(NTOK, PROJW, G, bid);
        pg8::Epi8<ProjF> E{ProjF{PROJ}}; pg8::gemm_phase<pg8::Epi8<ProjF>, -1, true>(lds, g, S, E); }
    SEAM(1);
    if (IN(2)) p2_qkv(P, lds);
    SEAM(2);
    if (IN(3)) { p3_mlstm_mfma(P, lds); __syncthreads(); p3_gmlp_mfma(P, lds); }
    SEAM(3);
    if (IN(4)) p4_ym(P, lds);
    SEAM(4);
    if (IN(5)) { pg8::Gemm g{PROJ + DM, (const bf16_t*)(ws + WS_WBR), PROJW, 2 * DM, NTOK, DM, 2 * DM}; pg8::StaticOrder S; S.init(NTOK, DM, G, bid);
        pg8::Epi8<MergeF> E{MergeF{PROJ, XN}}; pg8::gemm_phase<pg8::Epi8<MergeF>, 16, true>(lds, g, S, E); }
    SEAM(5);
    if (IN(6)) { pg8::Gemm g{XN, (const bf16_t*)(ws + WS_WOUT), DM, DM, NTOK, DM, DM}; pg8::StaticOrder S; S.init(NTOK, DM, G, bid);
        pg8::Epi8<Bf16F> E{Bf16F{Y, DM}}; pg8::gemm_phase<pg8::Epi8<Bf16F>, -1, true>(lds, g, S, E); }
    SEAM(6);
    if (IN(7)) norm_pass(P.in[I_X], Y, P.in[I_MIX_POST_G], P.out, P.in[I_MLP_PRE_G], XN, DM, 0, nullptr);
    SEAM(7);
    if (IN(8)) { pg8::Gemm g{XN, (const bf16_t*)(ws + WS_WUP), DM, DM, NTOK, DFF, DM}; pg8::StaticOrder S; S.init(NTOK, DFF, G, bid);
        pg8::Epi8<Relu2F> E{Relu2F{HB, DFF}}; pg8::gemm_phase<pg8::Epi8<Relu2F>, -1, true>(lds, g, S, E); }
    SEAM(8);
    if (IN(9)) { pg8::Gemm g{HB, (const bf16_t*)(ws + WS_WDN), DFF, DFF, NTOK, DM, DFF}; pg8::StaticOrder S; S.init(NTOK, DM, G, bid);
        pg8::Epi8<Bf16F> E{Bf16F{Y, DM}}; pg8::gemm_phase<pg8::Epi8<Bf16F>, -1, true>(lds, g, S, E); }
    SEAM(9);
    if (IN(10)) norm_pass(P.out, Y, P.in[I_MLP_POST_G], P.out, P.in[I_PLE_PRE_G], HB, PLEK, PLE, P.in[I_P]);
    SEAM(10);
    if (IN(11)) { pg8::Gemm g{HB, (const bf16_t*)(ws + WS_WPLE), PLEK, PLEK, NTOK, DM, PLEK}; pg8::StaticOrder S; S.init(NTOK, DM, G, bid);
        pg8::Epi8<PleF> E{PleF{Y, (f32x4*)(ws + WS_XN)}}; pg8::gemm_phase<pg8::Epi8<PleF>, 4, true>(lds, g, S, E); }
    SEAM(11);
    if (IN(12)) norm_pass(P.out, Y, P.in[I_PLE_POST_G], P.out, nullptr, nullptr, 0, 0, nullptr);
#undef IN
#undef SEAM
}

template <int LO, int HI> static void launch_range(const Params& P, int grid, hipStream_t stream, bool coop) {
    static bool attr = false;
    if (!attr) { (void)hipFuncSetAttribute((const void*)fwd_kernel<LO, HI>, hipFuncAttributeMaxDynamicSharedMemorySize, LDS_BYTES); attr = true; }
    if (coop) {
        Params p = P; void* args[] = {&p};
        const hipError_t e = hipLaunchCooperativeKernel((const void*)fwd_kernel<LO, HI>, dim3(grid), dim3(NTHR), args, LDS_BYTES, stream);
        if (e != hipSuccess) fprintf(stderr, "cooperative launch failed: %s (grid %d)\n", hipGetErrorString(e), grid);
    } else hipLaunchKernelGGL((fwd_kernel<LO, HI>), dim3(grid), dim3(NTHR), LDS_BYTES, stream, P);
}
template <int I> static void launch_each(const Params& P, int grid, hipStream_t stream) {
    if constexpr (I < NPHASE) { launch_range<I, I + 1>(P, grid, stream, false); launch_each<I + 1>(P, grid, stream); }
}

extern "C" void kernel_launch(void* const* d_in, const int* in_sizes, int n_in, void* d_out, int out_size, void* d_ws, size_t ws_size, hipStream_t stream) {
    if (n_in != 29 || out_size != NTOK * DM || ws_size < WS_END + 16 * MiB) { fprintf(stderr, "kernel_launch: unexpected shapes (n_in %d out %d ws %zu)\n", n_in, out_size, ws_size); return; }
    Params P{};
    for (int i = 0; i < 29; ++i) P.in[i] = (const float*)d_in[i];
    P.out = (float*)d_out; P.ws = (unsigned char*)d_ws;
#if MEGA
    static int grid = 0;
    if (!grid) {
        int dev = 0, cus = 0, per_cu = 0;
        (void)hipGetDevice(&dev); (void)hipDeviceGetAttribute(&cus, hipDeviceAttributeMultiprocessorCount, dev);
        (void)hipFuncSetAttribute((const void*)fwd_kernel<0, NPHASE>, hipFuncAttributeMaxDynamicSharedMemorySize, LDS_BYTES);
        (void)hipOccupancyMaxActiveBlocksPerMultiprocessor(&per_cu, (const void*)fwd_kernel<0, NPHASE>, NTHR, LDS_BYTES);
        if (per_cu < 1) per_cu = 1;
        grid = cus;
        if (grid > cus * per_cu) grid = cus * per_cu;
    }
    (void)hipMemsetAsync((char*)d_ws + WS_CTL, 0, CTL_ZERO_BYTES, stream);
    launch_range<0, NPHASE>(P, grid, stream, true);
#else
    launch_each<0>(P, 256, stream);
#endif
}
```

```cpp
#include <hip/hip_runtime.h>
#include <hip/hip_cooperative_groups.h>
#include <cstdio>
#include <cstdint>
#include <cmath>

#define LAS __attribute__((address_space(3)))
typedef unsigned short bf16_t;
typedef short bf16x8 __attribute__((ext_vector_type(8)));
typedef float f32x4 __attribute__((ext_vector_type(4)));
typedef unsigned u32x4 __attribute__((ext_vector_type(4)));
typedef unsigned u32x2 __attribute__((ext_vector_type(2)));

constexpr int NTOK = 32768, DM = 1024, SEQ = 2048, PROJW = 6144, DFF = 4096, PLE = 256, PLEK = PLE + DM;
constexpr float EPS = 1e-6f;
constexpr int NWAVES = 8, NTHR = 512;
constexpr size_t MiB = 1u << 20;
constexpr size_t WS_CTL = 0;
constexpr size_t WS_WIN = 1 * MiB;
constexpr size_t WS_WBR = 13 * MiB;
constexpr size_t WS_WOUT = 17 * MiB;
constexpr size_t WS_WUP = 19 * MiB;
constexpr size_t WS_WDN = 27 * MiB;
constexpr size_t WS_WPLE = 35 * MiB;
constexpr size_t WS_WCX = 38 * MiB;
constexpr size_t WS_WSP = 38 * MiB + 256 * 1024;
constexpr size_t WS_RS = 38 * MiB + 512 * 1024;
constexpr size_t WS_GATES = 39 * MiB;
constexpr size_t WS_XN = 40 * MiB;
constexpr size_t WS_PROJ = 104 * MiB;
constexpr size_t WS_HB = WS_PROJ;
constexpr size_t WS_Y = WS_PROJ + 256 * MiB;
constexpr size_t WS_END = 488 * MiB;

struct Params {
    const float* in[29];
    float* out;
    unsigned char* ws;
};
enum { I_X = 0, I_P, I_MIX_PRE_G, I_W_IN, I_CONV_W, I_CONV_B, I_WQ, I_WK, I_WV, I_W_IF, I_B_IF, I_M_NORM_G, I_M_SKIP, I_G_LN_W, I_G_LN_B, I_W_SP, I_B_SP,
       I_W_BR_M, I_W_BR_G, I_W_OUT, I_MIX_POST_G, I_MLP_PRE_G, I_W_UP, I_W_DOWN, I_MLP_POST_G, I_PLE_PRE_G, I_W_PLE_GATE, I_W_PLE_PROJ, I_PLE_POST_G };

__device__ __forceinline__ unsigned f2bf(float f) { unsigned u = __builtin_bit_cast(unsigned, f); return (u + 0x7fffu + ((u >> 16) & 1u)) >> 16; }
typedef float f32x2_t_ __attribute__((ext_vector_type(2)));
typedef __bf16 bf16x2_t_ __attribute__((ext_vector_type(2)));
__device__ __forceinline__ unsigned pk2(float lo, float hi) { f32x2_t_ v = {lo, hi}; bf16x2_t_ b = __builtin_convertvector(v, bf16x2_t_); return __builtin_bit_cast(unsigned, b); }
__device__ __forceinline__ float bflo(unsigned w) { return __builtin_bit_cast(float, w << 16); }
__device__ __forceinline__ float bfhi(unsigned w) { return __builtin_bit_cast(float, w & 0xffff0000u); }
__device__ __forceinline__ float bf2f(bf16_t h) { return __builtin_bit_cast(float, (unsigned)h << 16); }
__device__ __forceinline__ float sigmoidf_(float x) { return __builtin_amdgcn_rcpf(1.0f + __builtin_amdgcn_exp2f(-1.4426950408889634f * x)); }
__device__ __forceinline__ float siluf_(float x) { return x * sigmoidf_(x); }
__device__ __forceinline__ float gelu_tanh(float x) { const float z = 0.7978845608028654f * (x + 0.044715f * x * x * x); return x * sigmoidf_(2.0f * z); }
__device__ __forceinline__ float log_sigmoid(float x) { return fminf(x, 0.f) - log1pf(expf(-fabsf(x))); }
__device__ __forceinline__ float wave_sum(float v) {
#pragma unroll
    for (int o = 1; o < 64; o <<= 1) v += __shfl_xor(v, o);
    return v;
}
#define LDS_WAIT() asm volatile("s_waitcnt lgkmcnt(0)" ::: "memory")

template <bool GATE_REMAP = false>
__device__ __forceinline__ void transpose_item(const float* W, int K, int N, bf16_t* WT, int ldw, int koff, LAS float* scr, int item, int lane, const float* kscale = nullptr) {
    const int nblk = N / 32, kb = item / nblk, nb = item % nblk, k0 = 64 * kb, n0 = 32 * nb;
    int r0 = n0; if (GATE_REMAP && n0 >= 4 * DM) { const int g = n0 - 4 * DM, j = g & (DM - 1); r0 = 4 * DM + (j >> 7) * 256 + (g >= DM ? 128 : 0) + (j & 127); }
#pragma unroll 8
    for (int i = 0; i < 32; ++i) { const int kk = 2 * i + (lane >> 5); const float sc_ = kscale ? kscale[k0 + kk] : 1.0f; scr[kk * 33 + (lane & 31)] = W[(size_t)(k0 + kk) * N + n0 + (lane & 31)] * sc_; }
    LDS_WAIT();
    const int c = lane & 7;
#pragma unroll
    for (int j = 0; j < 4; ++j) { const int n = (lane >> 3) + 8 * j; const LAS float* s = scr + (8 * c) * 33 + n;
        u32x4 o; o.x = pk2(s[0 * 33], s[1 * 33]); o.y = pk2(s[2 * 33], s[3 * 33]); o.z = pk2(s[4 * 33], s[5 * 33]); o.w = pk2(s[6 * 33], s[7 * 33]);
        *(u32x4*)(WT + (size_t)(r0 + n) * ldw + koff + k0 + 8 * c) = o; }
    LDS_WAIT();
}
__device__ __forceinline__ void rms_row_to_bf16(const float* xrow, const float* g, bf16_t* orow, int lane) {
    const f32x4* xr = (const f32x4*)xrow + lane; const f32x4* gr = (const f32x4*)g + lane;
    f32x4 v[4]; float s = 0.f;
#pragma unroll
    for (int j = 0; j < 4; ++j) { v[j] = xr[64 * j]; s += (v[j].x * v[j].x + v[j].y * v[j].y) + (v[j].z * v[j].z + v[j].w * v[j].w); }
    const float r = 1.0f / sqrtf(wave_sum(s) * (1.f / DM) + EPS);
    u32x2* o8 = (u32x2*)orow + lane;
#pragma unroll
    for (int j = 0; j < 4; ++j) { const f32x4 gv = gr[64 * j]; u32x2 o; o.x = pk2(v[j].x * r * gv.x, v[j].y * r * gv.y); o.y = pk2(v[j].z * r * gv.z, v[j].w * r * gv.w); o8[64 * j] = o; }
}
__device__ void p0_prologue(const Params& P, LAS unsigned char* lds) {
    const int tid = threadIdx.x, lane = tid & 63, wave = tid >> 6;
    LAS float* scr = (LAS float*)(lds + wave * 16384);
    const int gw = blockIdx.x * NWAVES + wave, NGW = gridDim.x * NWAVES;
    unsigned char* ws = P.ws;
    constexpr int I_IN = 16 * 192, I_SQ = 16 * 32, I_UP = 16 * 128, I_DN = 64 * 32, I_PP = 4 * 32;
    constexpr int NIT = I_IN + 4 * I_SQ + I_UP + I_DN + I_PP;
    for (int it = gw; it < NIT; it += NGW) {
        int r = it;
        if (r < I_IN) { transpose_item<true>(P.in[I_W_IN], DM, PROJW, (bf16_t*)(ws + WS_WIN), DM, 0, scr, r, lane); continue; } r -= I_IN;
        if (r < I_SQ) { transpose_item(P.in[I_W_BR_M], DM, DM, (bf16_t*)(ws + WS_WBR), 2 * DM, 0, scr, r, lane); continue; } r -= I_SQ;
        if (r < I_SQ) { transpose_item(P.in[I_W_BR_G], DM, DM, (bf16_t*)(ws + WS_WBR), 2 * DM, DM, scr, r, lane); continue; } r -= I_SQ;
        if (r < I_SQ) { transpose_item(P.in[I_W_OUT], DM, DM, (bf16_t*)(ws + WS_WOUT), DM, 0, scr, r, lane); continue; } r -= I_SQ;
        if (r < I_SQ) { transpose_item(P.in[I_W_PLE_GATE], DM, DM, (bf16_t*)(ws + WS_WPLE), PLEK, PLE, scr, r, lane, P.in[I_PLE_PRE_G]); continue; } r -= I_SQ;
        if (r < I_UP) { transpose_item(P.in[I_W_UP], DM, DFF, (bf16_t*)(ws + WS_WUP), DM, 0, scr, r, lane, P.in[I_MLP_PRE_G]); continue; } r -= I_UP;
        if (r < I_DN) { transpose_item(P.in[I_W_DOWN], DFF, DM, (bf16_t*)(ws + WS_WDN), DFF, 0, scr, r, lane); continue; } r -= I_DN;
        transpose_item(P.in[I_W_PLE_PROJ], PLE, DM, (bf16_t*)(ws + WS_WPLE), PLEK, 0, scr, r, lane);
    }
    {
        float* wcx = (float*)(ws + WS_WCX);
        const float* wq = P.in[I_WQ]; const float* wk = P.in[I_WK]; const float* wv = P.in[I_WV]; const float* wif = P.in[I_W_IF];
        for (int i = blockIdx.x * NTHR + tid; i < DM * 8; i += gridDim.x * NTHR) {
            const int c = i >> 3, j = i & 7, blk = c >> 2, d = c & 3; float sc = 0.f, sx = 0.f;
#pragma unroll
            for (int e = 0; e < 4; ++e) {
                sc += wq[blk * 16 + d * 4 + e] * wif[(size_t)(blk * 4 + e) * 8 + j] + wk[blk * 16 + d * 4 + e] * wif[(size_t)(DM + blk * 4 + e) * 8 + j];
                sx += wv[blk * 16 + d * 4 + e] * wif[(size_t)(2 * DM + blk * 4 + e) * 8 + j]; }
            wcx[i] = sc; wcx[DM * 8 + i] = sx;
        }
    }
    { bf16_t* wsp = (bf16_t*)(ws + WS_WSP); const float* w = P.in[I_W_SP];
      for (int i = blockIdx.x * NTHR + tid; i < 8 * 128 * 128; i += gridDim.x * NTHR) { const int t = (i >> 7) & 127, s = i & 127; wsp[i] = (bf16_t)f2bf(s <= t ? w[i] : 0.f); } }
    bf16_t* XN = (bf16_t*)(ws + WS_XN);
    for (int m = gw; m < NTOK; m += NGW) rms_row_to_bf16(P.in[I_X] + (size_t)m * DM, P.in[I_MIX_PRE_G], XN + (size_t)m * DM, lane);
}

namespace pg8 {
constexpr int BM = 256, BK = 64, HALF = 128, HTB = HALF * BK * 2, STAGE_BYTES = 8 * HTB, NXCD = 8, WGM = 8;
__host__ __device__ __forceinline__ int lds_byte(int r, int c) { const int st = (r >> 4) * 2 + (c >> 5), rr = r & 15, cc = c & 31, ob = rr * 64 + cc * 2; return st * 1024 + (ob ^ (((ob >> 9) & 1) << 5)); }
__host__ __device__ __forceinline__ void stage_rc(int b, int& R, int& C) { const int st = b / 1024, sb = b % 1024, swz = sb ^ (((sb >> 9) & 1) << 5); R = (st >> 1) * 16 + swz / 64; C = (st & 1) * 32 + (swz % 64) / 2; }
__host__ __device__ __forceinline__ int perm32(int rho) { const int n = rho >> 4, i = rho & 15; return 8 * (i >> 2) + 4 * n + (i & 3); }
struct Unit { int pm, pn; };
struct Gemm { const bf16_t* A; const bf16_t* Bt; int lda, ldb, M, N, K; };
struct StaticOrder {
    int nM, nN, nwg, G, c;
    __host__ __device__ void init(int M, int N, int G_, int c_) { nM = M / BM; nN = N / BM; nwg = nM * nN; G = G_; c = c_; }
    __host__ __device__ bool next(int i, Unit& u) const {
        const long L = (long)i * G + c; if (L >= nwg) return false;
        int wgid = (int)L; { const int q = nwg / NXCD, r = nwg % NXCD, xcd = wgid % NXCD, off = wgid / NXCD; wgid = (xcd < r ? xcd * (q + 1) : r * (q + 1) + (xcd - r) * q) + off; }
        const int nig = WGM * nN, gid = wgid / nig, fm = gid * WGM, gsz = (nM - fm) < WGM ? (nM - fm) : WGM;
        u.pm = fm + ((wgid % nig) % gsz); u.pn = (wgid % nig) / gsz; return true;
    }
};
template <class F> struct Epi8 {
    static constexpr bool PERM = true; F f;
    __device__ __forceinline__ void operator()(f32x4 (&acc)[2][2][4][2], const Unit& u_, int wr, int wc, int fr, int fq) const {
        Unit u = u_; asm volatile("" : "+s"(u.pm), "+s"(u.pn));
#pragma unroll
        for (int ai = 0; ai < 2; ++ai)
#pragma unroll
            for (int m = 0; m < 4; ++m)
                { f.store16(u.pm * BM + ai * HALF + wr * 64 + m * 16 + fr, u.pn, wc * 32 + 8 * fq, acc[ai][0][m][0], acc[ai][0][m][1], acc[ai][1][m][0], acc[ai][1][m][1], ai * 4 + m); asm volatile("" ::: "memory"); }
    }
    __device__ __forceinline__ void mid(f32x4 (&acc)[2][2][4][2], const Unit& u_, int wr, int wc, int fr, int fq) const {
        Unit u = u_; asm volatile("" : "+s"(u.pm), "+s"(u.pn));
#pragma unroll
        for (int ai = 0; ai < 2; ++ai)
#pragma unroll
            for (int m = 0; m < 4; ++m)
#pragma unroll
                for (int bj = 0; bj < 2; ++bj) { f.mid8(u.pm * BM + ai * HALF + wr * 64 + m * 16 + fr, u.pn * BM + bj * HALF + wc * 32 + 8 * fq, acc[ai][bj][m][0], acc[ai][bj][m][1], (ai * 4 + m) * 2 + bj); asm volatile("" ::: "memory"); }
    }
};
template <class F> struct Epi4 {
    static constexpr bool PERM = false; F f;
    __device__ __forceinline__ void operator()(f32x4 (&acc)[2][2][4][2], const Unit& u_, int wr, int wc, int fr, int fq) const {
        Unit u = u_; asm volatile("" : "+s"(u.pm), "+s"(u.pn));
#pragma unroll
        for (int ai = 0; ai < 2; ++ai)
#pragma unroll
            for (int m = 0; m < 4; ++m)
#pragma unroll
                for (int bj = 0; bj < 2; ++bj)
#pragma unroll
                    for (int n = 0; n < 2; ++n) { f.store4(u.pm * BM + ai * HALF + wr * 64 + m * 16 + fr, u.pn * BM + bj * HALF + wc * 32 + 16 * n + 4 * fq, acc[ai][bj][m][n], ((ai * 4 + m) * 2 + bj) * 2 + n); if (n) asm volatile("" ::: "memory"); }
    }
    __device__ __forceinline__ void mid(f32x4 (&acc)[2][2][4][2], const Unit& u_, int wr, int wc, int fr, int fq) const {
        Unit u = u_; asm volatile("" : "+s"(u.pm), "+s"(u.pn));
#pragma unroll
        for (int ai = 0; ai < 2; ++ai)
#pragma unroll
            for (int m = 0; m < 4; ++m)
#pragma unroll
                for (int bj = 0; bj < 2; ++bj)
#pragma unroll
                    for (int n = 0; n < 2; ++n) { f.mid4(u.pm * BM + ai * HALF + wr * 64 + m * 16 + fr, u.pn * BM + bj * HALF + wc * 32 + 16 * n + 4 * fq, acc[ai][bj][m][n], ((ai * 4 + m) * 2 + bj) * 2 + n); if (n) asm volatile("" ::: "memory"); }
    }
};
template <class Epi, int HOOK_T, bool ALIGN_EPI>
__device__ __forceinline__ void gemm_phase(LAS unsigned char* lds, const Gemm g, const StaticOrder& S, const Epi& E) {
    int tid_ = threadIdx.x; asm volatile("" : "+v"(tid_));
    const int tid = tid_, wid = __builtin_amdgcn_readfirstlane(tid >> 6), lane = tid & 63, wr = wid >> 2, wc = wid & 3, fr = lane & 15, fq = lane >> 4;
    const int K = g.K, nt = K / BK;
    unsigned voffA[2], voffB[2];
#pragma unroll
    for (int i = 0; i < 2; ++i) { int R, C; stage_rc(tid * 16 + i * 8192, R, C); const int Rb = Epi::PERM ? ((R & ~31) + perm32(R & 31)) : R;
        voffA[i] = (unsigned)(R * g.lda + C) * 2u; voffB[i] = (unsigned)(Rb * g.ldb + C) * 2u; }
    const size_t kstep = (size_t)(BK * 2);
    const size_t hstepA = (size_t)HALF * g.lda * 2, hstepB = (size_t)HALF * g.ldb * 2;
    const size_t tstepA = 2 * hstepA, tstepB = 2 * hstepB;
    const unsigned ldsw = (unsigned)wid * 1024u;
    const int aoff = lds_byte(wr * 64 + fr, fq * 8), boff = lds_byte(wc * 32 + fr, fq * 8);
#define PG8_SA(b, h) (((b) * 2 + (h)) * HTB)
#define PG8_SB(b, h) ((4 + (b) * 2 + (h)) * HTB)
#define PG8_STAGE(bufoff, gbase, voff) do { _Pragma("unroll") for (int _i = 0; _i < 2; ++_i) \
        __builtin_amdgcn_global_load_lds((const unsigned*)((const char*)(gbase) + (voff)[_i]), (LAS unsigned*)(lds + (bufoff) + ldsw + _i * 8192), 16, 0, 0); } while (0)
#define PG8_LDA(dst, b, h) do { _Pragma("unroll") for (int m = 0; m < 4; ++m) _Pragma("unroll") for (int k = 0; k < 2; ++k) dst[m][k] = *(const LAS bf16x8*)(lds + PG8_SA(b, h) + aoff + m * 2048 + k * 1024); } while (0)
#define PG8_LDB(dst, b, h) do { _Pragma("unroll") for (int n = 0; n < 2; ++n) _Pragma("unroll") for (int k = 0; k < 2; ++k) dst[n][k] = *(const LAS bf16x8*)(lds + PG8_SB(b, h) + boff + n * 2048 + k * 1024); } while (0)
#define PG8_MMA(ai, bj, At, Bt) do { __builtin_amdgcn_s_setprio(1); _Pragma("unroll") for (int m = 0; m < 4; ++m) _Pragma("unroll") for (int n = 0; n < 2; ++n) _Pragma("unroll") for (int k = 0; k < 2; ++k) \
        acc[ai][bj][m][n] = __builtin_amdgcn_mfma_f32_16x16x32_bf16(Bt[n][k], At[m][k], acc[ai][bj][m][n], 0, 0, 0); __builtin_amdgcn_s_setprio(0); } while (0)
#define PG8_WAIT_V(n) asm volatile("s_waitcnt vmcnt(" #n ")" ::: "memory")
#define PG8_WAIT_L(n) asm volatile("s_waitcnt lgkmcnt(" #n ")" ::: "memory")
#define PG8_BAR __builtin_amdgcn_s_barrier()
#define PG8_SCHED __builtin_amdgcn_sched_barrier(0)
    Unit cur, nxt; int ui = 0;
    if (!S.next(0, cur)) return;
    f32x4 acc[2][2][4][2];
#pragma unroll
    for (int a = 0; a < 2; ++a)
#pragma unroll
        for (int b = 0; b < 2; ++b)
#pragma unroll
            for (int m = 0; m < 4; ++m)
#pragma unroll
                for (int n = 0; n < 2; ++n) acc[a][b][m][n] = (f32x4){0.f, 0.f, 0.f, 0.f};
    bf16x8 At[4][2], B0[2][2], B1[2][2];
    const char* cA = (const char*)g.A + (size_t)cur.pm * tstepA; const char* cB = (const char*)g.Bt + (size_t)cur.pn * tstepB;
    PG8_STAGE(PG8_SB(0, 0), cB, voffB); PG8_STAGE(PG8_SB(0, 1), cB + hstepB, voffB); PG8_STAGE(PG8_SA(0, 0), cA, voffA); PG8_STAGE(PG8_SA(0, 1), cA + hstepA, voffA);
    if (wr == 1) PG8_BAR;
    PG8_WAIT_V(2); PG8_BAR;
    PG8_STAGE(PG8_SB(1, 0), cB + kstep, voffB); PG8_STAGE(PG8_SA(1, 0), cA + kstep, voffA); PG8_STAGE(PG8_SB(1, 1), cB + hstepB + kstep, voffB);
    PG8_WAIT_V(6); PG8_BAR;
    for (;;) {
        const bool has_next = S.next(ui + 1, nxt);
        const char* nA = has_next ? (const char*)g.A + (size_t)nxt.pm * tstepA : cA; const char* nB = has_next ? (const char*)g.Bt + (size_t)nxt.pn * tstepB : cB;
#define PG8_KBODY() do { \
            const bool last = (t == nt - 2); \
            const char* a1 = cA + (size_t)(t + 1) * kstep; \
            const char* a2 = last ? nA : cA + (size_t)(t + 2) * kstep; const char* b2 = last ? nB : cB + (size_t)(t + 2) * kstep; \
            const char* a3 = a2 + kstep; const char* b3 = b2 + kstep; \
            PG8_LDB(B0, 0, 0); PG8_LDB(B1, 0, 1); PG8_SCHED; PG8_LDA(At, 0, 0); PG8_STAGE(PG8_SA(1, 1), a1 + hstepA, voffA); \
            PG8_WAIT_V(8); PG8_WAIT_L(0); PG8_BAR; PG8_MMA(0, 0, At, B0); PG8_MMA(0, 1, At, B1); PG8_BAR; PG8_SCHED; \
            PG8_LDA(At, 0, 1); PG8_STAGE(PG8_SB(0, 0), b2, voffB); PG8_STAGE(PG8_SB(0, 1), b2 + hstepB, voffB); PG8_STAGE(PG8_SA(0, 0), a2, voffA); \
            PG8_WAIT_V(8); PG8_WAIT_L(0); PG8_BAR; PG8_MMA(1, 0, At, B0); PG8_MMA(1, 1, At, B1); PG8_BAR; PG8_SCHED; \
            PG8_LDB(B0, 1, 0); PG8_LDB(B1, 1, 1); PG8_SCHED; PG8_LDA(At, 1, 0); PG8_STAGE(PG8_SA(0, 1), a2 + hstepA, voffA); \
            PG8_WAIT_V(8); PG8_WAIT_L(0); PG8_BAR; PG8_MMA(0, 0, At, B0); PG8_MMA(0, 1, At, B1); PG8_BAR; PG8_SCHED; \
            PG8_LDA(At, 1, 1); PG8_STAGE(PG8_SB(1, 0), b3, voffB); PG8_STAGE(PG8_SB(1, 1), b3 + hstepB, voffB); PG8_STAGE(PG8_SA(1, 0), a3, voffA); \
            PG8_WAIT_V(8); PG8_WAIT_L(0); PG8_BAR; PG8_MMA(1, 0, At, B0); PG8_MMA(1, 1, At, B1); PG8_BAR; PG8_SCHED; \
        } while (0)
        int t = 0;
        if constexpr (HOOK_T > 0) {
            for (; t < HOOK_T; t += 2) PG8_KBODY();
            PG8_SCHED; E.mid(acc, cur, wr, wc, fr, fq); PG8_SCHED;
        }
        for (; t < nt; t += 2) PG8_KBODY();
#undef PG8_KBODY
        if constexpr (ALIGN_EPI) { if (wr == 0) PG8_BAR; }
        E(acc, cur, wr, wc, fr, fq);
        if (!has_next) break;
#pragma unroll
        for (int a = 0; a < 2; ++a)
#pragma unroll
            for (int b = 0; b < 2; ++b)
#pragma unroll
                for (int m = 0; m < 4; ++m)
#pragma unroll
                    for (int n = 0; n < 2; ++n) acc[a][b][m][n] = (f32x4){0.f, 0.f, 0.f, 0.f};
        cur = nxt; cA = nA; cB = nB; ++ui;
        if constexpr (ALIGN_EPI) { if (wr == 1) PG8_BAR; }
    }
    PG8_WAIT_V(0);
    if constexpr (!ALIGN_EPI) { if (wr == 0) PG8_BAR; }
    PG8_BAR;
#undef PG8_SA
#undef PG8_SB
#undef PG8_STAGE
#undef PG8_LDA
#undef PG8_LDB
#undef PG8_MMA
#undef PG8_WAIT_V
#undef PG8_WAIT_L
#undef PG8_BAR
#undef PG8_SCHED
}
}
__device__ __forceinline__ void st_bf16x8(bf16_t* p, f32x4 a, f32x4 b) { u32x4 o; o.x = pk2(a.x, a.y); o.y = pk2(a.z, a.w); o.z = pk2(b.x, b.y); o.w = pk2(b.z, b.w); *(u32x4*)p = o; }
__device__ __forceinline__ void ld_bf16x8(const bf16_t* p, f32x4& a, f32x4& b) { const u32x4 w = *(const u32x4*)p; a = (f32x4){bflo(w.x), bfhi(w.x), bflo(w.y), bfhi(w.y)}; b = (f32x4){bflo(w.z), bfhi(w.z), bflo(w.w), bfhi(w.w)}; }
template <class FN> __device__ __forceinline__ f32x4 map4(f32x4 v, FN fn) { return (f32x4){fn(v.x), fn(v.y), fn(v.z), fn(v.w)}; }
struct ProjF {
    bf16_t* proj;
    __device__ __forceinline__ void store16(int row, int pn, int cl, f32x4 a0, f32x4 a1, f32x4 b0, f32x4 b1, int) const {
        bf16_t* rp = proj + (size_t)row * PROJW;
        if (pn < 16) {
            const int sec = pn >> 2;
            if (sec == 1) { a0 = map4(a0, siluf_); a1 = map4(a1, siluf_); b0 = map4(b0, siluf_); b1 = map4(b1, siluf_); }
            else if (sec >= 2) { a0 = map4(a0, gelu_tanh); a1 = map4(a1, gelu_tanh); b0 = map4(b0, gelu_tanh); b1 = map4(b1, gelu_tanh); }
            st_bf16x8(rp + pn * 256 + cl, a0, a1); st_bf16x8(rp + pn * 256 + 128 + cl, b0, b1);
        } else {
            const int j = (pn - 16) * 128 + cl;
            a0 = map4(a0, sigmoidf_); a1 = map4(a1, sigmoidf_); b0 = map4(b0, sigmoidf_); b1 = map4(b1, sigmoidf_);
            st_bf16x8(rp + 4 * DM + j, a0 / b0, a1 / b1); st_bf16x8(rp + 5 * DM + j, b0, b1);
        }
    }
    __device__ __forceinline__ void mid8(int, int, f32x4&, f32x4&, int) const {}
};
struct MergeF {
    const bf16_t* proj; bf16_t* merged;
    __device__ __forceinline__ void mid8(int row, int col, f32x4& a, f32x4& b, int) const {
        f32x4 r0, r1; ld_bf16x8(proj + (size_t)row * PROJW + 4 * DM + col, r0, r1); a = a * r0; b = b * r1;
    }
    __device__ __forceinline__ void store16(int row, int pn, int cl, f32x4 a0, f32x4 a1, f32x4 b0, f32x4 b1, int) const {
        const int col = pn * 256 + cl; f32x4 g0, g1;
        ld_bf16x8(proj + (size_t)row * PROJW + 5 * DM + col, g0, g1); st_bf16x8(merged + (size_t)row * DM + col, a0 * g0, a1 * g1);
        ld_bf16x8(proj + (size_t)row * PROJW + 5 * DM + col + 128, g0, g1); st_bf16x8(merged + (size_t)row * DM + col + 128, b0 * g0, b1 * g1);
    }
};
struct Bf16F {
    bf16_t* o; int ldc;
    __device__ __forceinline__ void store16(int row, int pn, int cl, f32x4 a0, f32x4 a1, f32x4 b0, f32x4 b1, int) const {
        bf16_t* p = o + (size_t)row * ldc + pn * 256 + cl; st_bf16x8(p, a0, a1); st_bf16x8(p + 128, b0, b1);
    }
    __device__ __forceinline__ void mid8(int, int, f32x4&, f32x4&, int) const {}
};
struct Relu2F {
    bf16_t* o; int ldc; const float* rs;
    __device__ __forceinline__ void store16(int row, int pn, int cl, f32x4 a0, f32x4 a1, f32x4 b0, f32x4 b1, int) const {
        const float rr = rs[row]; auto r2 = [rr](float x) { const float r = fmaxf(x * rr, 0.f); return r * r; };
        bf16_t* p = o + (size_t)row * ldc + pn * 256 + cl;
        st_bf16x8(p, map4(a0, r2), map4(a1, r2)); st_bf16x8(p + 128, map4(b0, r2), map4(b1, r2));
    }
    __device__ __forceinline__ void mid8(int, int, f32x4&, f32x4&, int) const {}
};
struct PleF {
    bf16_t* o; f32x4* stash; const float* rs;
    __device__ __forceinline__ void mid8(int, int, f32x4& a, f32x4& b, int idx2) const {
        unsigned t = threadIdx.x; asm volatile("" : "+v"(t));
        f32x4* s = stash + ((size_t)blockIdx.x * 32 + idx2 * 2) * NTHR + t; s[0] = a; s[NTHR] = b; a = (f32x4){0.f, 0.f, 0.f, 0.f}; b = (f32x4){0.f, 0.f, 0.f, 0.f};
    }
    __device__ __forceinline__ void store16(int row, int pn, int cl, f32x4 a0, f32x4 a1, f32x4 b0, f32x4 b1, int idx) const {
        unsigned t = threadIdx.x; asm volatile("" : "+v"(t));
        const f32x4* s = stash + ((size_t)blockIdx.x * 32 + idx * 4) * NTHR + t;
        bf16_t* p = o + (size_t)row * DM + pn * 256 + cl;
        const float rr = rs[row]; auto sg = [rr](float x) { return sigmoidf_(x * rr); };
        st_bf16x8(p, map4(a0, sg) * s[0], map4(a1, sg) * s[NTHR]); st_bf16x8(p + 128, map4(b0, sg) * s[2 * NTHR], map4(b1, sg) * s[3 * NTHR]);
    }
};

__device__ __forceinline__ void ld4(const bf16_t* p, float (&x)[4]) { const u32x2 w = *(const u32x2*)p; x[0] = bflo(w.x); x[1] = bfhi(w.x); x[2] = bflo(w.y); x[3] = bfhi(w.y); }
__device__ __forceinline__ void up4(u32x2 w, float (&x)[4]) { x[0] = bflo(w.x); x[1] = bfhi(w.x); x[2] = bflo(w.y); x[3] = bfhi(w.y); }
__device__ __forceinline__ void st4(bf16_t* p, const float (&x)[4]) { u32x2 o; o.x = pk2(x[0], x[1]); o.y = pk2(x[2], x[3]); *(u32x2*)p = o; }
__device__ void p2_qkv(const Params& P, LAS unsigned char* lds) {
    const int tid = threadIdx.x, lane = tid & 63, wave = tid >> 6, h = wave & 3, half = wave >> 2;
    unsigned char* ws = P.ws;
    const bf16_t* PROJ = (const bf16_t*)(ws + WS_PROJ);
    bf16_t* Q = (bf16_t*)P.out; bf16_t* K = Q + (size_t)NTOK * DM; bf16_t* V = (bf16_t*)(ws + WS_XN);
    float* GATES = (float*)(ws + WS_GATES);
    LAS float* part = (LAS float*)lds;
    const int ch = h * 256 + lane * 4, blk = ch >> 2;
    float cw[4][4], cb[4], wq[4][4], wk[4][4], wv[4][4], wc[4][8], wx[4][8];
#pragma unroll
    for (int j = 0; j < 4; ++j)
#pragma unroll
        for (int d = 0; d < 4; ++d) cw[j][d] = P.in[I_CONV_W][j * DM + ch + d];
#pragma unroll
    for (int d = 0; d < 4; ++d) { cb[d] = P.in[I_CONV_B][ch + d];
#pragma unroll
        for (int e = 0; e < 4; ++e) { wq[d][e] = P.in[I_WQ][blk * 16 + d * 4 + e]; wk[d][e] = P.in[I_WK][blk * 16 + d * 4 + e]; wv[d][e] = P.in[I_WV][blk * 16 + d * 4 + e]; }
#pragma unroll
        for (int j = 0; j < 8; ++j) { wc[d][j] = ((const float*)(ws + WS_WCX))[(ch + d) * 8 + j]; wx[d][j] = ((const float*)(ws + WS_WCX))[DM * 8 + (ch + d) * 8 + j]; } }
    for (int item = blockIdx.x; item < NTOK / 16; item += gridDim.x) {
        const int tb = item * 16 + half * 8;
        u32x2 raw[11];
        const bool seq0 = (tb & (SEQ - 1)) == 0;
#pragma unroll
        for (int i = 0; i < 11; ++i) raw[i] = (i < 3 && seq0) ? (u32x2){0u, 0u} : *(const u32x2*)(PROJ + (size_t)(tb - 3 + i) * PROJW + ch);
        float x0[4], x1[4], x2[4], x3[4];
        up4(raw[0], x0); up4(raw[1], x1); up4(raw[2], x2);
#pragma unroll
        for (int i = 0; i < 8; ++i) {
            const int t = tb + i;
            up4(raw[3 + i], x3);
            float mc[4], q[4], k[4], v[4], gp[8];
#pragma unroll
            for (int d = 0; d < 4; ++d) mc[d] = siluf_(cw[0][d] * x0[d] + cw[1][d] * x1[d] + cw[2][d] * x2[d] + cw[3][d] * x3[d] + cb[d]);
#pragma unroll
            for (int e = 0; e < 4; ++e) { q[e] = mc[0] * wq[0][e] + mc[1] * wq[1][e] + mc[2] * wq[2][e] + mc[3] * wq[3][e];
                k[e] = mc[0] * wk[0][e] + mc[1] * wk[1][e] + mc[2] * wk[2][e] + mc[3] * wk[3][e];
                v[e] = x3[0] * wv[0][e] + x3[1] * wv[1][e] + x3[2] * wv[2][e] + x3[3] * wv[3][e]; }
            st4(Q + (size_t)t * DM + ch, q); st4(K + (size_t)t * DM + ch, k); st4(V + (size_t)t * DM + ch, v);
#pragma unroll
            for (int j = 0; j < 8; ++j) { float s = 0.f;
#pragma unroll
                for (int d = 0; d < 4; ++d) s += mc[d] * wc[d][j] + x3[d] * wx[d][j];
                gp[j] = wave_sum(s); }
            if (lane == 0) {
#pragma unroll
                for (int j = 0; j < 8; ++j) part[((half * 8 + i) * 4 + h) * 8 + j] = gp[j]; }
#pragma unroll
            for (int d = 0; d < 4; ++d) { x0[d] = x1[d]; x1[d] = x2[d]; x2[d] = x3[d]; }
        }
        __syncthreads();
        if (tid < 128) { const int tok = tid >> 3, j = tid & 7;
            const float val = part[(tok * 4 + 0) * 8 + j] + part[(tok * 4 + 1) * 8 + j] + part[(tok * 4 + 2) * 8 + j] + part[(tok * 4 + 3) * 8 + j] + P.in[I_B_IF][j];
            GATES[(size_t)(item * 16 + tok) * 8 + j] = (j < 4) ? val : log_sigmoid(val); }
        __syncthreads();
    }
    bf16_t* PW = (bf16_t*)(ws + WS_PROJ);
    const int gw = blockIdx.x * NWAVES + wave, NGW = gridDim.x * NWAVES;
    for (int m = gw; m < NTOK; m += NGW) {
        bf16_t* row = PW + (size_t)m * PROJW + 3 * DM + lane * 16;
        const u32x4 a = *(const u32x4*)row, b = *(const u32x4*)(row + 8);
        float x[16] = {bflo(a.x), bfhi(a.x), bflo(a.y), bfhi(a.y), bflo(a.z), bfhi(a.z), bflo(a.w), bfhi(a.w), bflo(b.x), bfhi(b.x), bflo(b.y), bfhi(b.y), bflo(b.z), bfhi(b.z), bflo(b.w), bfhi(b.w)};
        float s = 0.f;
#pragma unroll
        for (int i = 0; i < 16; ++i) s += x[i];
        const float mu = wave_sum(s) * (1.f / DM); float s2 = 0.f;
#pragma unroll
        for (int i = 0; i < 16; ++i) { x[i] -= mu; s2 += x[i] * x[i]; }
        const float r = 1.0f / sqrtf(wave_sum(s2) * (1.f / DM) + EPS);
        const float* lw = P.in[I_G_LN_W] + lane * 16; const float* lb = P.in[I_G_LN_B] + lane * 16;
#pragma unroll
        for (int i = 0; i < 16; ++i) x[i] = x[i] * r * lw[i] + lb[i];
        u32x4 oa, ob; oa.x = pk2(x[0], x[1]); oa.y = pk2(x[2], x[3]); oa.z = pk2(x[4], x[5]); oa.w = pk2(x[6], x[7]); ob.x = pk2(x[8], x[9]); ob.y = pk2(x[10], x[11]); ob.z = pk2(x[12], x[13]); ob.w = pk2(x[14], x[15]);
        *(u32x4*)row = oa; *(u32x4*)(row + 8) = ob;
    }
}

constexpr int ML_C = 0, ML_N = 65536, ML_Q = ML_N + 1024, ML_K = ML_Q + 32768, ML_V = ML_K + 32768, ML_P = ML_V + 8192, ML_S = ML_P + 16384, ML_BYTES = ML_S + 2048;
__device__ void p3_mlstm_naive(const Params& P, LAS unsigned char* lds) {
    const int tid = threadIdx.x, lane = tid & 63, wave = tid >> 6;
    unsigned char* ws = P.ws;
    const bf16_t* Q = (const bf16_t*)P.out; const bf16_t* K = Q + (size_t)NTOK * DM; bf16_t* V = (bf16_t*)(ws + WS_XN);
    const float* GATES = (const float*)(ws + WS_GATES);
    LAS float* Cs = (LAS float*)(lds + ML_C); LAS float* ns = (LAS float*)(lds + ML_N);
    LAS unsigned* qs = (LAS unsigned*)(lds + ML_Q); LAS unsigned* ks = (LAS unsigned*)(lds + ML_K);
    LAS bf16_t* vs = (LAS bf16_t*)(lds + ML_V);
    LAS float* Ps = (LAS float*)(lds + ML_P);
    LAS float* sc = (LAS float*)(lds + ML_S);
    for (int item = blockIdx.x; item < 256; item += gridDim.x) {
        const int b = item >> 4, h = (item >> 2) & 3, j = item & 3;
        for (int i = tid; i < 256 * 64; i += NTHR) Cs[i] = 0.f;
        if (tid < 256) ns[tid] = 0.f;
        float m = 0.f;
        __syncthreads();
        for (int c = 0; c < 32; ++c) {
            const size_t t0 = (size_t)b * SEQ + c * 64;
#pragma unroll
            for (int i = 0; i < 4; ++i) { const int p = tid + i * NTHR, r = p >> 5, cc = p & 31;
                *(LAS u32x4*)(qs + r * 128 + cc * 4) = *(const u32x4*)(Q + (t0 + r) * DM + h * 256 + cc * 8);
                *(LAS u32x4*)(ks + r * 128 + cc * 4) = *(const u32x4*)(K + (t0 + r) * DM + h * 256 + cc * 8); }
            { const int r = tid >> 3, cc = tid & 7; *(LAS u32x4*)(vs + r * 64 + cc * 8) = *(const u32x4*)(V + (t0 + r) * DM + h * 256 + j * 64 + cc * 8); }
            if (wave == 0) {
                const float ig = GATES[(t0 + lane) * 8 + h], lf = GATES[(t0 + lane) * 8 + 4 + h];
                float bs = lf;
#pragma unroll
                for (int o = 1; o < 64; o <<= 1) { const float t = __shfl_up(bs, o); if (lane >= o) bs += t; }
                const float u = ig - bs; float gm = u;
#pragma unroll
                for (int o = 1; o < 64; o <<= 1) { const float t = __shfl_up(gm, o); if (lane >= o) gm = fmaxf(gm, t); }
                const float g = fmaxf(gm, m), gL = __shfl(g, 63), bL = __shfl(bs, 63);
                sc[lane] = u; sc[64 + lane] = g; sc[128 + lane] = expf(m - g); sc[192 + lane] = expf(-bs - g); sc[256 + lane] = expf(u - gL);
                if (lane == 0) sc[384] = expf(m - gL);
                m = bL + gL;
            }
            __syncthreads();
            { const int t = tid >> 3, sg = tid & 7; float acc[8];
#pragma unroll
                for (int i = 0; i < 8; ++i) acc[i] = 0.f;
                if (sg * 8 <= t) {
                    for (int d2 = 0; d2 < 128; ++d2) { const unsigned qw = qs[t * 128 + d2]; const float ql = bflo(qw), qh = bfhi(qw);
#pragma unroll
                        for (int i = 0; i < 8; ++i) { const unsigned kw = ks[(sg * 8 + i) * 128 + d2]; acc[i] += ql * bflo(kw) + qh * bfhi(kw); } } }
                const float gt = sc[64 + t];
#pragma unroll
                for (int i = 0; i < 8; ++i) { const int s = sg * 8 + i; Ps[t * 64 + s] = (s <= t) ? acc[i] * 0.0625f * expf(sc[s] - gt) : 0.f; } }
            __syncthreads();
            if (tid < 64) { const int t = tid; float qn = 0.f;
                for (int d2 = 0; d2 < 128; ++d2) { const unsigned qw = qs[t * 128 + d2]; qn += bflo(qw) * ns[2 * d2] + bfhi(qw) * ns[2 * d2 + 1]; }
                float ps = 0.f;
                for (int s = 0; s <= t; ++s) ps += Ps[t * 64 + s];
                sc[320 + t] = sc[128 + t] * qn + ps; }
            __syncthreads();
            { const int t = tid >> 3, eg = tid & 7; float acc[8];
#pragma unroll
                for (int i = 0; i < 8; ++i) acc[i] = 0.f;
                for (int d2 = 0; d2 < 128; ++d2) { const unsigned qw = qs[t * 128 + d2]; const float ql = bflo(qw), qh = bfhi(qw);
#pragma unroll
                    for (int i = 0; i < 8; ++i) acc[i] += ql * Cs[(2 * d2) * 64 + eg * 8 + i] + qh * Cs[(2 * d2 + 1) * 64 + eg * 8 + i]; }
                const float iw = sc[128 + t];
#pragma unroll
                for (int i = 0; i < 8; ++i) acc[i] *= iw;
                for (int s = 0; s <= t; ++s) { const float pv = Ps[t * 64 + s];
#pragma unroll
                    for (int i = 0; i < 8; ++i) acc[i] += pv * bf2f(vs[s * 64 + eg * 8 + i]); }
                const float dn = 1.0f / fmaxf(fabsf(sc[320 + t]), sc[192 + t]);
                u32x4 o; o.x = pk2(acc[0] * dn, acc[1] * dn); o.y = pk2(acc[2] * dn, acc[3] * dn); o.z = pk2(acc[4] * dn, acc[5] * dn); o.w = pk2(acc[6] * dn, acc[7] * dn);
                *(u32x4*)(V + (t0 + t) * DM + h * 256 + j * 64 + eg * 8) = o;
            }
            __syncthreads();
            { const int d = tid >> 1, eh = tid & 1; const float decay = sc[384]; float acc[32];
#pragma unroll
                for (int i = 0; i < 32; ++i) acc[i] = decay * Cs[d * 64 + eh * 32 + i];
                float nacc = decay * ns[d];
                for (int s = 0; s < 64; ++s) { const unsigned kw = ks[s * 128 + (d >> 1)]; const float kv = ((d & 1) ? bfhi(kw) : bflo(kw)) * 0.0625f * sc[256 + s];
                    nacc += kv;
#pragma unroll
                    for (int i = 0; i < 32; ++i) acc[i] += kv * bf2f(vs[s * 64 + eh * 32 + i]); }
#pragma unroll
                for (int i = 0; i < 32; ++i) Cs[d * 64 + eh * 32 + i] = acc[i];
                if (eh == 0) ns[d] = nacc; }
            __syncthreads();
        }
    }
}

__device__ void p3_gmlp_naive(const Params& P, LAS unsigned char* lds) {
    const int tid = threadIdx.x;
    bf16_t* PROJ = (bf16_t*)(P.ws + WS_PROJ);
    LAS bf16_t* vv = (LAS bf16_t*)lds;
    const float* WSP = P.in[I_W_SP]; const float* BSP = P.in[I_B_SP];
    for (int item = blockIdx.x; item < 2048; item += gridDim.x) {
        const int g = item & 7, c = (item >> 3) & 15, b = item >> 7; const size_t t0 = (size_t)b * SEQ + c * 128;
#pragma unroll
        for (int i = 0; i < 4; ++i) { const int p = tid + i * NTHR, r = p >> 4, cc = p & 15; *(LAS u32x4*)(vv + r * 128 + cc * 8) = *(const u32x4*)(PROJ + (t0 + r) * PROJW + 3 * DM + g * 128 + cc * 8); }
        __syncthreads();
        const int t = tid >> 2, dg = tid & 3; float acc[32];
#pragma unroll
        for (int i = 0; i < 32; ++i) acc[i] = 0.f;
        const float* wrow = WSP + ((size_t)g * 128 + t) * 128;
        for (int s = 0; s <= t; ++s) { const float w = wrow[s];
#pragma unroll
            for (int i = 0; i < 32; ++i) acc[i] += w * bf2f(vv[s * 128 + dg * 32 + i]); }
        const float bs = BSP[g * 128 + t];
        bf16_t* gu = PROJ + (t0 + t) * PROJW + 2 * DM + g * 128 + dg * 32;
#pragma unroll
        for (int i = 0; i < 4; ++i) { const u32x4 w = *(const u32x4*)(gu + i * 8); u32x4 o;
            o.x = pk2(bflo(w.x) * (acc[i * 8 + 0] + bs), bfhi(w.x) * (acc[i * 8 + 1] + bs)); o.y = pk2(bflo(w.y) * (acc[i * 8 + 2] + bs), bfhi(w.y) * (acc[i * 8 + 3] + bs));
            o.z = pk2(bflo(w.z) * (acc[i * 8 + 4] + bs), bfhi(w.z) * (acc[i * 8 + 5] + bs)); o.w = pk2(bflo(w.w) * (acc[i * 8 + 6] + bs), bfhi(w.w) * (acc[i * 8 + 7] + bs));
            *(u32x4*)(gu + i * 8) = o; }
        __syncthreads();
    }
}

namespace mlm {
constexpr int QP = 264, VP = 88, PP = 72;
constexpr int VSB = 64 * VP * 2;
constexpr int QS_OFF = 0, KS_OFF = QS_OFF + 64 * QP * 2, VS_OFF = KS_OFF + 64 * QP * 2, CT_OFF = VS_OFF + 2 * VSB, PS_OFF = CT_OFF + 80 * QP * 2, SC_OFF = PS_OFF + 64 * PP * 2, BYTES = SC_OFF + 4096;
typedef short s16x4 __attribute__((ext_vector_type(4)));
typedef float f32x2_t __attribute__((ext_vector_type(2)));
typedef __bf16 bf16x2_t __attribute__((ext_vector_type(2)));
__device__ __forceinline__ unsigned cvtpk(float lo, float hi) { f32x2_t v = {lo, hi}; bf16x2_t b = __builtin_convertvector(v, bf16x2_t); return __builtin_bit_cast(unsigned, b); }
__device__ __forceinline__ s16x4 tr16(LAS unsigned char* p) { return __builtin_bit_cast(s16x4, __builtin_amdgcn_ds_read_tr16_b64_v4i16((LAS s16x4*)p)); }
__device__ __forceinline__ bf16x8 frag_tr(LAS unsigned char* p, int pitch_bytes) {
    const s16x4 lo = tr16(p), hi = tr16(p + 4 * pitch_bytes);
    return (bf16x8){lo.x, lo.y, lo.z, lo.w, hi.x, hi.y, hi.z, hi.w};
}
}
__device__ void p3_mlstm_mfma(const Params& P, LAS unsigned char* lds) {
    using namespace mlm;
    const int tid = threadIdx.x, lane = tid & 63, wave = __builtin_amdgcn_readfirstlane(tid >> 6), fr = lane & 15, fq = lane >> 4, q_ = fr >> 2, p_ = fr & 3;
    const int tau = wave >> 1, par = wave & 1;
    unsigned char* ws = P.ws;
    const bf16_t* Q = (const bf16_t*)P.out; const bf16_t* K = Q + (size_t)NTOK * DM; bf16_t* V = (bf16_t*)(ws + WS_XN);
    const float* GATES = (const float*)(ws + WS_GATES);
    for (int it = blockIdx.x; it < 256; it += gridDim.x) {
        const int item = (gridDim.x == 256) ? (((it & 7) * 8 + (it >> 5)) * 4 + ((it >> 3) & 3)) : it;
        const int b = item >> 4, h = (item >> 2) & 3, j = item & 3;
        float* scg = (float*)(ws + WS_END) + (size_t)it * 32 * 384;
        {
            LAS float* cb = (LAS float*)(lds + SC_OFF);
            float bs[4], uu[4], cm[4];
#pragma unroll
            for (int i = 0; i < 4; ++i) { const int c = wave + 8 * i; const size_t t = (size_t)b * SEQ + c * 64 + lane;
                float s = GATES[t * 8 + 4 + h]; const float ig = GATES[t * 8 + h];
#pragma unroll
                for (int o = 1; o < 64; o <<= 1) { const float x = __shfl_up(s, o); if (lane >= o) s += x; }
                const float u = ig - s; float g = u;
#pragma unroll
                for (int o = 1; o < 64; o <<= 1) { const float x = __shfl_up(g, o); if (lane >= o) g = fmaxf(g, x); }
                bs[i] = s; uu[i] = u; cm[i] = g;
                if (lane == 63) { cb[c] = s; cb[32 + c] = g; } }
            __syncthreads();
            if (tid == 0) { float m = 0.f; for (int c = 0; c < 32; ++c) { const float gL = fmaxf(m, cb[32 + c]); cb[64 + c] = m; cb[96 + c] = gL; m = cb[c] + gL; } }
            __syncthreads();
#pragma unroll
            for (int i = 0; i < 4; ++i) { const int c = wave + 8 * i; const float m = cb[64 + c], gL = cb[96 + c], g = fmaxf(m, cm[i]); float* o = scg + c * 384;
                o[lane] = uu[i]; o[64 + lane] = g; o[128 + lane] = expf(m - g); o[192 + lane] = expf(-bs[i] - g); o[256 + lane] = expf(uu[i] - gL) * 0.0625f;
                if (lane == 0) o[320] = expf(m - gL); }
            asm volatile("s_waitcnt vmcnt(0)" ::: "memory");
            __syncthreads();
        }
        for (int i = tid; i < 80 * QP * 2 / 16; i += NTHR) ((LAS u32x4*)(lds + CT_OFF))[i] = (u32x4){0u, 0u, 0u, 0u};
        if (tid < 128) { LAS bf16_t* r = (LAS bf16_t*)(lds + VS_OFF + (tid >> 6) * VSB) + (tid & 63) * VP + 64; r[0] = 0x3F80;
#pragma unroll
            for (int i = 1; i < 24; ++i) r[i] = 0; }
        f32x4 cacc[2][5];
#pragma unroll
        for (int a = 0; a < 2; ++a)
#pragma unroll
            for (int e = 0; e < 5; ++e) cacc[a][e] = (f32x4){0.f, 0.f, 0.f, 0.f};
        u32x4 pq[4], pk[4], pv; float psc[6];
        const bf16_t* qb = Q + (size_t)b * SEQ * DM + h * 256; const bf16_t* kb = K + (size_t)b * SEQ * DM + h * 256; bf16_t* vb = V + (size_t)b * SEQ * DM + h * 256 + j * 64;
#define ML_LOAD(c_) do { const size_t r0_ = (size_t)(c_) * 64; \
            _Pragma("unroll") for (int i = 0; i < 4; ++i) { const int p = tid + i * NTHR, r = p >> 5, cc = p & 31; pq[i] = *(const u32x4*)(qb + (r0_ + r) * DM + cc * 8); pk[i] = *(const u32x4*)(kb + (r0_ + r) * DM + cc * 8); } \
            pv = *(const u32x4*)(vb + (r0_ + (tid >> 3)) * DM + (tid & 7) * 8); \
            if (wave == 0) { const float* s_ = scg + (c_) * 384; _Pragma("unroll") for (int i = 0; i < 5; ++i) psc[i] = __builtin_nontemporal_load(s_ + 64 * i + lane); psc[5] = __builtin_nontemporal_load(s_ + 320); } } while (0)
#define ML_STORE(c_) do { \
            _Pragma("unroll") for (int i = 0; i < 4; ++i) { const int p = tid + i * NTHR, r = p >> 5, cc = p & 31; *(LAS u32x4*)(lds + QS_OFF + r * QP * 2 + cc * 16) = pq[i]; *(LAS u32x4*)(lds + KS_OFF + r * QP * 2 + cc * 16) = pk[i]; } \
            *(LAS u32x4*)(lds + VS_OFF + ((c_) & 1) * VSB + (tid >> 3) * VP * 2 + (tid & 7) * 16) = pv; \
            if (wave == 0) { LAS float* s_ = (LAS float*)(lds + SC_OFF) + ((c_) & 1) * 512; _Pragma("unroll") for (int i = 0; i < 5; ++i) s_[64 * i + lane] = psc[i]; if (lane == 0) s_[320] = psc[5]; } } while (0)
        ML_LOAD(0);
        __syncthreads();
        ML_STORE(0);
        __syncthreads();
        for (int c = 0; c < 32; ++c) {
            LAS float* sc = (LAS float*)(lds + SC_OFF) + (c & 1) * 512;
            if (c + 1 < 32) ML_LOAD(c + 1);
            bf16x8 qf[8];
#pragma unroll
            for (int kap = 0; kap < 8; ++kap) qf[kap] = *(const LAS bf16x8*)(lds + QS_OFF + ((16 * tau + fr) * QP + 32 * kap + 8 * fq) * 2);
            const float gt = sc[64 + 16 * tau + fr];
#pragma unroll
            for (int si = 0; si < 2; ++si) {
                const int sig = 2 * par + si; f32x4 acc = (f32x4){0.f, 0.f, 0.f, 0.f};
                if (sig <= tau) {
#pragma unroll
                    for (int kap = 0; kap < 8; ++kap) acc = __builtin_amdgcn_mfma_f32_16x16x32_bf16(*(const LAS bf16x8*)(lds + KS_OFF + ((16 * sig + fr) * QP + 32 * kap + 8 * fq) * 2), qf[kap], acc, 0, 0, 0);
                }
                const f32x4 us = *(const LAS f32x4*)(sc + 16 * sig + 4 * fq);
                const int t = 16 * tau + fr, s0 = 16 * sig + 4 * fq;
                const float w0 = (s0 + 0 <= t) ? acc.x * 0.0625f * __expf(us.x - gt) : 0.f, w1 = (s0 + 1 <= t) ? acc.y * 0.0625f * __expf(us.y - gt) : 0.f;
                const float w2 = (s0 + 2 <= t) ? acc.z * 0.0625f * __expf(us.z - gt) : 0.f, w3 = (s0 + 3 <= t) ? acc.w * 0.0625f * __expf(us.w - gt) : 0.f;
                u32x2 o; o.x = cvtpk(w0, w1); o.y = cvtpk(w2, w3);
                *(LAS u32x2*)(lds + PS_OFF + (t * PP + s0) * 2) = o;
            }
            f32x4 nacc[3];
#pragma unroll
            for (int ei = 0; ei < 3; ++ei) {
                const int eps = (ei == 2) ? 4 : 2 * par + ei; f32x4 acc = (f32x4){0.f, 0.f, 0.f, 0.f};
#pragma unroll
                for (int kap = 0; kap < 8; ++kap) acc = __builtin_amdgcn_mfma_f32_16x16x32_bf16(*(const LAS bf16x8*)(lds + CT_OFF + ((16 * eps + fr) * QP + 32 * kap + 8 * fq) * 2), qf[kap], acc, 0, 0, 0);
                nacc[ei] = acc * sc[128 + 16 * tau + fr];
            }
            bf16x8 kw[2][2];
#pragma unroll
            for (int dl = 0; dl < 2; ++dl)
#pragma unroll
                for (int kp = 0; kp < 2; ++kp) {
                    const bf16x8 f = frag_tr(lds + KS_OFF + ((32 * kp + 8 * fq + q_) * QP + 16 * (2 * wave + dl) + 4 * p_) * 2, QP * 2);
                    const u32x4 fw = __builtin_bit_cast(u32x4, f);
                    const f32x4 wa = *(const LAS f32x4*)(sc + 256 + 32 * kp + 8 * fq), wb = *(const LAS f32x4*)(sc + 256 + 32 * kp + 8 * fq + 4);
                    u32x4 o; o.x = cvtpk(bflo(fw.x) * wa.x, bfhi(fw.x) * wa.y); o.y = cvtpk(bflo(fw.y) * wa.z, bfhi(fw.y) * wa.w); o.z = cvtpk(bflo(fw.z) * wb.x, bfhi(fw.z) * wb.y); o.w = cvtpk(bflo(fw.w) * wb.z, bfhi(fw.w) * wb.w);
                    kw[dl][kp] = __builtin_bit_cast(bf16x8, o);
                }
            LAS unsigned char* vsc = lds + VS_OFF + (c & 1) * VSB;
            const float lowb = sc[192 + 16 * tau + fr], decay = sc[320];
            __syncthreads();
            {
                bf16x8 pf[2];
#pragma unroll
                for (int kp = 0; kp < 2; ++kp) pf[kp] = *(const LAS bf16x8*)(lds + PS_OFF + ((16 * tau + fr) * PP + 32 * kp + 8 * fq) * 2);
#pragma unroll
                for (int ei = 0; ei < 3; ++ei) {
#pragma unroll
                    for (int kp = 0; kp < 2; ++kp) {
                        const int eps = (ei == 2) ? 4 : 2 * par + ei;
                        nacc[ei] = __builtin_amdgcn_mfma_f32_16x16x32_bf16(frag_tr(vsc + ((32 * kp + 8 * fq + q_) * VP + 16 * eps + 4 * p_) * 2, VP * 2), pf[kp], nacc[ei], 0, 0, 0);
                    }
                }
                const float den = __shfl(nacc[2].x, fr);
                const float rinv = 1.0f / fmaxf(fabsf(den), lowb);
                bf16_t* hrow = vb + ((size_t)c * 64 + 16 * tau + fr) * DM;
#pragma unroll
                for (int ei = 0; ei < 2; ++ei) { const int eps = 2 * par + ei; u32x2 o; o.x = cvtpk(nacc[ei].x * rinv, nacc[ei].y * rinv); o.y = cvtpk(nacc[ei].z * rinv, nacc[ei].w * rinv);
                    *(u32x2*)(hrow + 16 * eps + 4 * fq) = o; }
            }
#pragma unroll
            for (int eps = 0; eps < 5; ++eps) {
                bf16x8 vf[2];
#pragma unroll
                for (int kp = 0; kp < 2; ++kp) vf[kp] = frag_tr(vsc + ((32 * kp + 8 * fq + q_) * VP + 16 * eps + 4 * p_) * 2, VP * 2);
#pragma unroll
                for (int dl = 0; dl < 2; ++dl) {
                    f32x4 a = cacc[dl][eps] * decay;
                    a = __builtin_amdgcn_mfma_f32_16x16x32_bf16(kw[dl][0], vf[0], a, 0, 0, 0);
                    a = __builtin_amdgcn_mfma_f32_16x16x32_bf16(kw[dl][1], vf[1], a, 0, 0, 0);
                    cacc[dl][eps] = a;
                    u32x2 o; o.x = cvtpk(a.x, a.y); o.y = cvtpk(a.z, a.w);
                    *(LAS u32x2*)(lds + CT_OFF + ((16 * eps + fr) * QP + 16 * (2 * wave + dl) + 4 * fq) * 2) = o;
                }
            }
            if (c + 1 < 32) ML_STORE(c + 1);
            __syncthreads();
        }
#undef ML_LOAD
#undef ML_STORE
    }
}

namespace gmm { constexpr int VVP = 136, VV_OFF = 0, WS_OFF = 128 * VVP * 2, BYTES = 2 * 128 * VVP * 2; }
__device__ void p3_gmlp_mfma(const Params& P, LAS unsigned char* lds) {
    using namespace gmm;
    const int tid = threadIdx.x, lane = tid & 63, wave = __builtin_amdgcn_readfirstlane(tid >> 6), fr = lane & 15, fq = lane >> 4, q_ = fr >> 2, p_ = fr & 3;
    bf16_t* PROJ = (bf16_t*)(P.ws + WS_PROJ); const bf16_t* WSPb = (const bf16_t*)(P.ws + WS_WSP); const float* BSP = P.in[I_B_SP];
    int g_staged = -1;
    u32x4 pre[4];
#define GM_LOAD(it_) do { const int g_ = (it_) & 7, c_ = ((it_) >> 3) & 15, b_ = (it_) >> 7; const size_t t0_ = (size_t)b_ * SEQ + c_ * 128; \
        _Pragma("unroll") for (int i = 0; i < 4; ++i) { const int p = tid + i * NTHR, r = p >> 4, cc = p & 15; pre[i] = *(const u32x4*)(PROJ + (t0_ + r) * PROJW + 3 * DM + g_ * 128 + cc * 8); } } while (0)
    if ((int)blockIdx.x < 2048) GM_LOAD(blockIdx.x);
    for (int item = blockIdx.x; item < 2048; item += gridDim.x) {
        const int g = item & 7, c = (item >> 3) & 15, b = item >> 7; const size_t t0 = (size_t)b * SEQ + c * 128;
#pragma unroll
        for (int i = 0; i < 4; ++i) { const int p = tid + i * NTHR, r = p >> 4, cc = p & 15; *(LAS u32x4*)(lds + VV_OFF + (r * VVP + cc * 8) * 2) = pre[i]; }
        if (g != g_staged) {
#pragma unroll
            for (int i = 0; i < 4; ++i) { const int p = tid + i * NTHR, r = p >> 4, cc = p & 15; *(LAS u32x4*)(lds + WS_OFF + (r * VVP + cc * 8) * 2) = *(const u32x4*)(WSPb + ((size_t)g * 128 + r) * 128 + cc * 8); }
            g_staged = g;
        }
        __syncthreads();
        if (item + (int)gridDim.x < 2048) GM_LOAD(item + gridDim.x);
        bf16x8 af[4];
#pragma unroll
        for (int kap = 0; kap < 4; ++kap) af[kap] = mlm::frag_tr(lds + VV_OFF + ((32 * kap + 8 * fq + q_) * VVP + 16 * wave + 4 * p_) * 2, VVP * 2);
#pragma unroll
        for (int th = 0; th < 8; ++th) {
            f32x4 acc = (f32x4){0.f, 0.f, 0.f, 0.f};
#pragma unroll
            for (int kap = 0; kap <= (th >> 1); ++kap) acc = __builtin_amdgcn_mfma_f32_16x16x32_bf16(af[kap], *(const LAS bf16x8*)(lds + WS_OFF + ((16 * th + fr) * VVP + 32 * kap + 8 * fq) * 2), acc, 0, 0, 0);
            const int t = 16 * th + fr; const float bs = BSP[g * 128 + t];
            bf16_t* gu = PROJ + (t0 + t) * PROJW + 2 * DM + g * 128 + 16 * wave + 4 * fq;
            const u32x2 w = *(const u32x2*)gu; u32x2 o;
            o.x = mlm::cvtpk(bflo(w.x) * (acc.x + bs), bfhi(w.x) * (acc.y + bs)); o.y = mlm::cvtpk(bflo(w.y) * (acc.z + bs), bfhi(w.y) * (acc.w + bs));
            *(u32x2*)gu = o;
        }
        __syncthreads();
    }
#undef GM_LOAD
}

__device__ void p4_ym(const Params& P, LAS unsigned char*) {
    const int tid = threadIdx.x, lane = tid & 63, wave = tid >> 6, h = wave & 3, half = wave >> 2;
    bf16_t* PROJ = (bf16_t*)(P.ws + WS_PROJ); const bf16_t* HM = (const bf16_t*)(P.ws + WS_XN);
    const int ch = h * 256 + lane * 4;
    float cw[4][4], cb[4], ng[4], sk[4];
#pragma unroll
    for (int j = 0; j < 4; ++j)
#pragma unroll
        for (int d = 0; d < 4; ++d) cw[j][d] = P.in[I_CONV_W][j * DM + ch + d];
#pragma unroll
    for (int d = 0; d < 4; ++d) { cb[d] = P.in[I_CONV_B][ch + d]; ng[d] = P.in[I_M_NORM_G][ch + d]; sk[d] = P.in[I_M_SKIP][ch + d]; }
    for (int item = blockIdx.x; item < NTOK / 16; item += gridDim.x) {
        const int tb = item * 16 + half * 8;
        u32x2 raw[11], rh[8], rz[8];
        const bool seq0 = (tb & (SEQ - 1)) == 0;
#pragma unroll
        for (int i = 0; i < 11; ++i) raw[i] = (i < 3 && seq0) ? (u32x2){0u, 0u} : *(const u32x2*)(PROJ + (size_t)(tb - 3 + i) * PROJW + ch);
#pragma unroll
        for (int i = 0; i < 8; ++i) { rh[i] = *(const u32x2*)(HM + (size_t)(tb + i) * DM + ch); rz[i] = *(const u32x2*)(PROJ + (size_t)(tb + i) * PROJW + DM + ch); }
        float x0[4], x1[4], x2[4], x3[4];
        up4(raw[0], x0); up4(raw[1], x1); up4(raw[2], x2);
#pragma unroll
        for (int i = 0; i < 8; ++i) {
            const int t = tb + i;
            up4(raw[3 + i], x3);
            float hm[4], sz[4], y[4];
            up4(rh[i], hm); up4(rz[i], sz);
            const float mu = wave_sum(hm[0] + hm[1] + hm[2] + hm[3]) * (1.f / 256.f);
            float s2 = 0.f;
#pragma unroll
            for (int d = 0; d < 4; ++d) { hm[d] -= mu; s2 += hm[d] * hm[d]; }
            const float r = 1.0f / sqrtf(wave_sum(s2) * (1.f / 256.f) + EPS);
#pragma unroll
            for (int d = 0; d < 4; ++d) { const float mc = siluf_(cw[0][d] * x0[d] + cw[1][d] * x1[d] + cw[2][d] * x2[d] + cw[3][d] * x3[d] + cb[d]);
                y[d] = (hm[d] * r * ng[d] + sk[d] * mc) * sz[d]; }
            st4(PROJ + (size_t)t * PROJW + DM + ch, y);
#pragma unroll
            for (int d = 0; d < 4; ++d) { x0[d] = x1[d]; x1[d] = x2[d]; x2[d] = x3[d]; }
        }
    }
}

template <bool XI_BF16, bool XO_BF16>
__device__ void norm_pass(const void* xi_, int ldxi, const bf16_t* y, const float* g1, void* xo_, int ldxo, float* rs, const float* pin, bf16_t* pout, int ldp) {
    const int tid = threadIdx.x, lane = tid & 63, wave = tid >> 6;
    const int gw = blockIdx.x * NWAVES + wave, NGW = gridDim.x * NWAVES;
    f32x4 gv1[4];
#pragma unroll
    for (int j = 0; j < 4; ++j) gv1[j] = ((const f32x4*)g1 + lane)[64 * j];
    for (int m0 = gw; m0 < NTOK; m0 += 2 * NGW) {
        const int m1 = m0 + NGW; const bool has1 = m1 < NTOK; const int mm[2] = {m0, has1 ? m1 : m0};
        f32x4 v[2][4], xv[2][4]; float s[2] = {0.f, 0.f};
#pragma unroll
        for (int r = 0; r < 2; ++r) {
            const u32x2* yr = (const u32x2*)(y + (size_t)mm[r] * DM) + lane;
#pragma unroll
            for (int j = 0; j < 4; ++j) { const u32x2 w = yr[64 * j]; v[r][j] = (f32x4){bflo(w.x), bfhi(w.x), bflo(w.y), bfhi(w.y)};
                if (XI_BF16) { const u32x2 xw = ((const u32x2*)((const bf16_t*)xi_ + (size_t)mm[r] * ldxi) + lane)[64 * j]; xv[r][j] = (f32x4){bflo(xw.x), bfhi(xw.x), bflo(xw.y), bfhi(xw.y)}; }
                else xv[r][j] = ((const f32x4*)((const float*)xi_ + (size_t)mm[r] * ldxi) + lane)[64 * j]; }
        }
#pragma unroll
        for (int r = 0; r < 2; ++r)
#pragma unroll
            for (int j = 0; j < 4; ++j) s[r] += (v[r][j].x * v[r][j].x + v[r][j].y * v[r][j].y) + (v[r][j].z * v[r][j].z + v[r][j].w * v[r][j].w);
#pragma unroll
        for (int o = 1; o < 64; o <<= 1) { s[0] += __shfl_xor(s[0], o); s[1] += __shfl_xor(s[1], o); }
        float s2[2] = {0.f, 0.f};
#pragma unroll
        for (int r = 0; r < 2; ++r) {
            const float rr = 1.0f / sqrtf(s[r] * (1.f / DM) + EPS);
#pragma unroll
            for (int j = 0; j < 4; ++j) { v[r][j] = xv[r][j] + v[r][j] * rr * gv1[j];
                s2[r] += (v[r][j].x * v[r][j].x + v[r][j].y * v[r][j].y) + (v[r][j].z * v[r][j].z + v[r][j].w * v[r][j].w);
                if (r == 0 || has1) {
                    if (XO_BF16) { u32x2 o; o.x = pk2(v[r][j].x, v[r][j].y); o.y = pk2(v[r][j].z, v[r][j].w); ((u32x2*)((bf16_t*)xo_ + (size_t)mm[r] * ldxo) + lane)[64 * j] = o; }
                    else ((f32x4*)((float*)xo_ + (size_t)mm[r] * ldxo) + lane)[64 * j] = v[r][j]; } }
        }
        if (rs) {
#pragma unroll
            for (int o = 1; o < 64; o <<= 1) { s2[0] += __shfl_xor(s2[0], o); s2[1] += __shfl_xor(s2[1], o); }
            if (lane == 0) { rs[mm[0]] = 1.0f / sqrtf(s2[0] * (1.f / DM) + EPS); if (has1) rs[mm[1]] = 1.0f / sqrtf(s2[1] * (1.f / DM) + EPS); }
        }
        if (pin) {
#pragma unroll
            for (int r = 0; r < 2; ++r) { if (r == 1 && !has1) break;
                const f32x4 pv = ((const f32x4*)(pin + (size_t)mm[r] * PLE))[lane]; u32x2 o; o.x = pk2(pv.x, pv.y); o.y = pk2(pv.z, pv.w); ((u32x2*)(pout + (size_t)mm[r] * ldp))[lane] = o; }
        }
    }
}

#define XB_TMO      128
#define XB_XCNT(j)  (256  + 64 * (j))
#define XB_XSUB(j)  (1280 + 64 * (j))
#define XB_XGEN(j)  (2304 + 64 * (j))
#define XB_TOP      3328
#define XB_TOPGEN   3392
#define XCD_BAR_WORDS 3456
#define XB_SPIN_CAP (1u << 20)
__device__ __forceinline__ unsigned xb_ld(unsigned* p)              { return __hip_atomic_load(p, __ATOMIC_RELAXED, __HIP_MEMORY_SCOPE_AGENT); }
__device__ __forceinline__ unsigned xb_add(unsigned* p, unsigned v) { return __hip_atomic_fetch_add(p, v, __ATOMIC_RELAXED, __HIP_MEMORY_SCOPE_AGENT); }
__device__ __forceinline__ unsigned xb_xcc_id() { return (unsigned)__builtin_amdgcn_s_getreg((3 << 11) | 20) & 0xFu; }
#define XB_SPIN(cond, bar) do { unsigned _sp = 0; while (cond) { __builtin_amdgcn_s_sleep(1); \
    if ((++_sp & 255u) == 0u) { if (xb_ld(&(bar)[XB_TMO])) break; if (_sp > XB_SPIN_CAP) { atomicAdd(&(bar)[XB_TMO], 1u); break; } } } } while (0)
struct XcdBarrier { unsigned* bar; unsigned x; volatile LAS unsigned* st; };
__device__ __forceinline__ XcdBarrier xcd_barrier_post(unsigned* bar, volatile LAS unsigned* st) {
    XcdBarrier b; b.bar = bar; b.x = xb_xcc_id(); b.st = st;
    if (threadIdx.x == 0) (void)xb_add(&bar[XB_XCNT(b.x)], 1u);
    return b;
}
__device__ __forceinline__ void xcd_barrier_complete(unsigned* bar, unsigned x, unsigned& nloc, unsigned& nx) {
    const unsigned G = gridDim.x * gridDim.y * gridDim.z;
    unsigned sum, cnt, mine, sp = 0u;
    for (;;) {
        sum = 0u; cnt = 0u; mine = 0u;
#pragma unroll
        for (unsigned j = 0; j < 16; ++j) { const unsigned c = xb_ld(&bar[XB_XCNT(j)]); sum += c; cnt += (c > 0u) ? 1u : 0u; mine = (j == x) ? c : mine; }
        if (sum == G) break;
        __builtin_amdgcn_s_sleep(1);
        if ((++sp & 255u) == 0u) { if (xb_ld(&bar[XB_TMO])) break; if (sp > XB_SPIN_CAP) { atomicAdd(&bar[XB_TMO], 1u); break; } }
    }
    nloc = mine > 0u ? mine : 1u; nx = cnt > 0u ? cnt : 1u;
}
__device__ __forceinline__ void xcd_barrier(const XcdBarrier& b) {
    asm volatile("s_waitcnt vmcnt(0)" ::: "memory");
    __syncthreads();
    if (threadIdx.x == 0) {
        unsigned* bar = b.bar;
        __builtin_amdgcn_s_waitcnt(0);
        unsigned nloc = b.st[0], nx = b.st[1];
        if (nloc == 0u) { xcd_barrier_complete(bar, b.x, nloc, nx); b.st[0] = nloc; b.st[1] = nx; }
        const unsigned old = xb_add(&bar[XB_XSUB(b.x)], 1u);
        const unsigned gen = old / nloc;
        if (old + 1u == (gen + 1u) * nloc) {
            __builtin_amdgcn_fence(__ATOMIC_RELEASE, "agent");
            asm volatile("s_waitcnt vmcnt(0)" ::: "memory");
            const unsigned og = xb_add(&bar[XB_TOP], 1u);
            const unsigned tg = og / nx;
            if (og + 1u == (tg + 1u) * nx) xb_add(&bar[XB_TOPGEN], 1u);
            else XB_SPIN(xb_ld(&bar[XB_TOPGEN]) == tg, bar);
            __builtin_amdgcn_fence(__ATOMIC_ACQUIRE, "agent");
            xb_add(&bar[XB_XGEN(b.x)], 1u);
            asm volatile("s_waitcnt vmcnt(0)" ::: "memory");
        } else {
            XB_SPIN(xb_ld(&bar[XB_XGEN(b.x)]) == gen, bar);
            __builtin_amdgcn_fence(__ATOMIC_ACQUIRE, "agent");
            asm volatile("s_waitcnt vmcnt(0)" ::: "memory");
        }
    }
    __syncthreads();
}

#ifndef MEGA
#define MEGA 1
#endif
namespace cg = cooperative_groups;
constexpr int NPHASE = 13;
constexpr int LDS_BYTES = 160 * 1024 - 1024;
constexpr int MISC_OFF = LDS_BYTES - 256;
constexpr int CW_BAR = 4096;
constexpr size_t CTL_ZERO_BYTES = 64 * 1024;
#ifndef USE_CG_SYNC
#define USE_CG_SYNC 0
#endif
static_assert(ML_BYTES <= LDS_BYTES && pg8::STAGE_BYTES <= LDS_BYTES && mlm::BYTES <= MISC_OFF && ML_BYTES <= MISC_OFF && (CW_BAR + XCD_BAR_WORDS) * 4 <= (int)CTL_ZERO_BYTES, "lds");

template <int LO, int HI> __global__ void __launch_bounds__(NTHR, 2) fwd_kernel(Params P) {
    extern __shared__ __attribute__((aligned(16))) unsigned char lds_raw[];
    LAS unsigned char* lds = (LAS unsigned char*)lds_raw;
    unsigned char* ws = P.ws;
    bf16_t* PROJ = (bf16_t*)(ws + WS_PROJ); bf16_t* XN = (bf16_t*)(ws + WS_XN); bf16_t* HB = (bf16_t*)(ws + WS_HB); bf16_t* Y = (bf16_t*)(ws + WS_Y); float* RS1 = (float*)(ws + WS_RS); float* RS2 = RS1 + NTOK;
    const int G = gridDim.x, bid = blockIdx.x;
#define IN(k) (LO <= (k) && (k) < HI)
#if USE_CG_SYNC
#define SEAM(k) do { if (IN(k) && IN((k) + 1)) cg::this_grid().sync(); } while (0)
#else
    if (HI - LO > 1) { volatile LAS unsigned* misc = (volatile LAS unsigned*)(lds + MISC_OFF); if (threadIdx.x < 2) misc[threadIdx.x] = 0u; __syncthreads(); (void)xcd_barrier_post((unsigned*)(P.ws + WS_CTL) + CW_BAR, misc); }
#define SEAM(k) do { if (IN(k) && IN((k) + 1)) { XcdBarrier xb_; xb_.bar = (unsigned*)(P.ws + WS_CTL) + CW_BAR; xb_.x = xb_xcc_id(); xb_.st = (volatile LAS unsigned*)((LAS unsigned char*)lds_raw + MISC_OFF); xcd_barrier(xb_); } } while (0)
#endif
    if (IN(0)) p0_prologue(P, lds);
    SEAM(0);
    if (IN(1)) { pg8::Gemm g{XN, (const bf16_t*)(ws + WS_WIN), DM, DM, NTOK, PROJW, DM}; pg8::StaticOrder S; S.init(NTOK, PROJW, G, bid);
        pg8::Epi8<ProjF> E{ProjF{PROJ}}; pg8::gemm_phase<pg8::Epi8<ProjF>, -1, true>(lds, g, S, E); }
    SEAM(1);
    if (IN(2)) p2_qkv(P, lds);
    SEAM(2);
    if (IN(3)) { p3_mlstm_mfma(P, lds); __syncthreads(); p3_gmlp_mfma(P, lds); }
    SEAM(3);
    if (IN(4)) p4_ym(P, lds);
    SEAM(4);
    if (IN(5)) { pg8::Gemm g{PROJ + DM, (const bf16_t*)(ws + WS_WBR), PROJW, 2 * DM, NTOK, DM, 2 * DM}; pg8::StaticOrder S; S.init(NTOK, DM, G, bid);
        pg8::Epi8<MergeF> E{MergeF{PROJ, XN}}; pg8::gemm_phase<pg8::Epi8<MergeF>, 16, true>(lds, g, S, E); }
    SEAM(5);
    if (IN(6)) { pg8::Gemm g{XN, (const bf16_t*)(ws + WS_WOUT), DM, DM, NTOK, DM, DM}; pg8::StaticOrder S; S.init(NTOK, DM, G, bid);
        pg8::Epi8<Bf16F> E{Bf16F{Y, DM}}; pg8::gemm_phase<pg8::Epi8<Bf16F>, -1, true>(lds, g, S, E); }
    SEAM(6);
    if (IN(7)) norm_pass<false, true>(P.in[I_X], DM, Y, P.in[I_MIX_POST_G], XN, DM, RS1, nullptr, nullptr, 0);
    SEAM(7);
    if (IN(8)) { pg8::Gemm g{XN, (const bf16_t*)(ws + WS_WUP), DM, DM, NTOK, DFF, DM}; pg8::StaticOrder S; S.init(NTOK, DFF, G, bid);
        pg8::Epi8<Relu2F> E{Relu2F{HB, DFF, RS1}}; pg8::gemm_phase<pg8::Epi8<Relu2F>, -1, true>(lds, g, S, E); }
    SEAM(8);
    if (IN(9)) { pg8::Gemm g{HB, (const bf16_t*)(ws + WS_WDN), DFF, DFF, NTOK, DM, DFF}; pg8::StaticOrder S; S.init(NTOK, DM, G, bid);
        pg8::Epi8<Bf16F> E{Bf16F{Y, DM}}; pg8::gemm_phase<pg8::Epi8<Bf16F>, -1, true>(lds, g, S, E); }
    SEAM(9);
    if (IN(10)) norm_pass<true, true>(XN, DM, Y, P.in[I_MLP_POST_G], HB + PLE, PLEK, RS2, P.in[I_P], HB, PLEK);
    SEAM(10);
    if (IN(11)) { pg8::Gemm g{HB, (const bf16_t*)(ws + WS_WPLE), PLEK, PLEK, NTOK, DM, PLEK}; pg8::StaticOrder S; S.init(NTOK, DM, G, bid);
        pg8::Epi8<PleF> E{PleF{Y, (f32x4*)(ws + WS_XN), RS2}}; pg8::gemm_phase<pg8::Epi8<PleF>, 4, true>(lds, g, S, E); }
    SEAM(11);
    if (IN(12)) norm_pass<true, false>(HB + PLE, PLEK, Y, P.in[I_PLE_POST_G], P.out, DM, nullptr, nullptr, nullptr, 0);
#undef IN
#undef SEAM
}

template <int LO, int HI> static void launch_range(const Params& P, int grid, hipStream_t stream, bool coop) {
    static bool attr = false;
    if (!attr) { (void)hipFuncSetAttribute((const void*)fwd_kernel<LO, HI>, hipFuncAttributeMaxDynamicSharedMemorySize, LDS_BYTES); attr = true; }
    if (coop) {
        Params p = P; void* args[] = {&p};
        const hipError_t e = hipLaunchCooperativeKernel((const void*)fwd_kernel<LO, HI>, dim3(grid), dim3(NTHR), args, LDS_BYTES, stream);
        if (e != hipSuccess) fprintf(stderr, "cooperative launch failed: %s (grid %d)\n", hipGetErrorString(e), grid);
    } else hipLaunchKernelGGL((fwd_kernel<LO, HI>), dim3(grid), dim3(NTHR), LDS_BYTES, stream, P);
}
template <int I> static void launch_each(const Params& P, int grid, hipStream_t stream) {
    if constexpr (I < NPHASE) { launch_range<I, I + 1>(P, grid, stream, false); launch_each<I + 1>(P, grid, stream); }
}

extern "C" void kernel_launch(void* const* d_in, const int* in_sizes, int n_in, void* d_out, int out_size, void* d_ws, size_t ws_size, hipStream_t stream) {
    if (n_in != 29 || out_size != NTOK * DM || ws_size < WS_END + 16 * MiB) { fprintf(stderr, "kernel_launch: unexpected shapes (n_in %d out %d ws %zu)\n", n_in, out_size, ws_size); return; }
    Params P{};
    for (int i = 0; i < 29; ++i) P.in[i] = (const float*)d_in[i];
    P.out = (float*)d_out; P.ws = (unsigned char*)d_ws;
#if MEGA
    static int grid = 0;
    if (!grid) {
        int dev = 0, cus = 0, per_cu = 0;
        (void)hipGetDevice(&dev); (void)hipDeviceGetAttribute(&cus, hipDeviceAttributeMultiprocessorCount, dev);
        (void)hipFuncSetAttribute((const void*)fwd_kernel<0, NPHASE>, hipFuncAttributeMaxDynamicSharedMemorySize, LDS_BYTES);
        (void)hipOccupancyMaxActiveBlocksPerMultiprocessor(&per_cu, (const void*)fwd_kernel<0, NPHASE>, NTHR, LDS_BYTES);
        if (per_cu < 1) per_cu = 1;
        grid = cus;
        if (grid > cus * per_cu) grid = cus * per_cu;
    }
    (void)hipMemsetAsync((char*)d_ws + WS_CTL, 0, CTL_ZERO_BYTES, stream);
    launch_range<0, NPHASE>(P, grid, stream, true);
#else
    launch_each<0>(P, 256, stream);
#endif
}
```

```cpp
#include <hip/hip_runtime.h>
#include <hip/hip_cooperative_groups.h>
#include <cstdio>
#include <cstdint>
#include <cmath>

#define LAS __attribute__((address_space(3)))
typedef unsigned short bf16_t;
typedef short bf16x8 __attribute__((ext_vector_type(8)));
typedef float f32x4 __attribute__((ext_vector_type(4)));
typedef unsigned u32x4 __attribute__((ext_vector_type(4)));
typedef unsigned u32x2 __attribute__((ext_vector_type(2)));

constexpr int NTOK = 32768, DM = 1024, SEQ = 2048, PROJW = 6144, DFF = 4096, PLE = 256, PLEK = PLE + DM;
constexpr float EPS = 1e-6f;
constexpr int NWAVES = 8, NTHR = 512;
constexpr size_t MiB = 1u << 20;
constexpr size_t WS_CTL = 0;
constexpr size_t WS_WIN = 1 * MiB;
constexpr size_t WS_WBR = 13 * MiB;
constexpr size_t WS_WOUT = 17 * MiB;
constexpr size_t WS_WUP = 19 * MiB;
constexpr size_t WS_WDN = 27 * MiB;
constexpr size_t WS_WPLE = 35 * MiB;
constexpr size_t WS_WCX = 38 * MiB;
constexpr size_t WS_WSP = 38 * MiB + 256 * 1024;
constexpr size_t WS_RS = 38 * MiB + 512 * 1024;
constexpr size_t WS_GATES = 39 * MiB;
constexpr size_t WS_XN = 40 * MiB;
constexpr size_t WS_PROJ = 104 * MiB;
constexpr size_t WS_HB = WS_PROJ;
constexpr size_t WS_Y = WS_PROJ + 256 * MiB;
constexpr size_t WS_END = 488 * MiB;

struct Params {
    const float* in[29];
    float* out;
    unsigned char* ws;
};
enum { I_X = 0, I_P, I_MIX_PRE_G, I_W_IN, I_CONV_W, I_CONV_B, I_WQ, I_WK, I_WV, I_W_IF, I_B_IF, I_M_NORM_G, I_M_SKIP, I_G_LN_W, I_G_LN_B, I_W_SP, I_B_SP,
       I_W_BR_M, I_W_BR_G, I_W_OUT, I_MIX_POST_G, I_MLP_PRE_G, I_W_UP, I_W_DOWN, I_MLP_POST_G, I_PLE_PRE_G, I_W_PLE_GATE, I_W_PLE_PROJ, I_PLE_POST_G };

__device__ __forceinline__ unsigned f2bf(float f) { unsigned u = __builtin_bit_cast(unsigned, f); return (u + 0x7fffu + ((u >> 16) & 1u)) >> 16; }
typedef float f32x2_t_ __attribute__((ext_vector_type(2)));
typedef __bf16 bf16x2_t_ __attribute__((ext_vector_type(2)));
__device__ __forceinline__ unsigned pk2(float lo, float hi) { f32x2_t_ v = {lo, hi}; bf16x2_t_ b = __builtin_convertvector(v, bf16x2_t_); return __builtin_bit_cast(unsigned, b); }
__device__ __forceinline__ float bflo(unsigned w) { return __builtin_bit_cast(float, w << 16); }
__device__ __forceinline__ float bfhi(unsigned w) { return __builtin_bit_cast(float, w & 0xffff0000u); }
__device__ __forceinline__ float bf2f(bf16_t h) { return __builtin_bit_cast(float, (unsigned)h << 16); }
__device__ __forceinline__ float sigmoidf_(float x) { return __builtin_amdgcn_rcpf(1.0f + __builtin_amdgcn_exp2f(-1.4426950408889634f * x)); }
__device__ __forceinline__ float siluf_(float x) { return x * sigmoidf_(x); }
__device__ __forceinline__ float gelu_tanh(float x) { const float z = 0.7978845608028654f * (x + 0.044715f * x * x * x); return x * sigmoidf_(2.0f * z); }
__device__ __forceinline__ float log_sigmoid(float x) { return fminf(x, 0.f) - log1pf(expf(-fabsf(x))); }
__device__ __forceinline__ float wave_sum(float v) {
#pragma unroll
    for (int o = 1; o < 64; o <<= 1) v += __shfl_xor(v, o);
    return v;
}
#define LDS_WAIT() asm volatile("s_waitcnt lgkmcnt(0)" ::: "memory")

template <bool GATE_REMAP = false>
__device__ __forceinline__ void transpose_item(const float* W, int K, int N, bf16_t* WT, int ldw, int koff, LAS float* scr, int item, int lane, const float* kscale = nullptr) {
    const int nblk = N / 32, kb = item / nblk, nb = item % nblk, k0 = 64 * kb, n0 = 32 * nb;
    int r0 = n0; if (GATE_REMAP && n0 >= 4 * DM) { const int g = n0 - 4 * DM, j = g & (DM - 1); r0 = 4 * DM + (j >> 7) * 256 + (g >= DM ? 128 : 0) + (j & 127); }
#pragma unroll 8
    for (int i = 0; i < 32; ++i) { const int kk = 2 * i + (lane >> 5); const float sc_ = kscale ? kscale[k0 + kk] : 1.0f; scr[kk * 33 + (lane & 31)] = W[(size_t)(k0 + kk) * N + n0 + (lane & 31)] * sc_; }
    LDS_WAIT();
    const int c = lane & 7;
#pragma unroll
    for (int j = 0; j < 4; ++j) { const int n = (lane >> 3) + 8 * j; const LAS float* s = scr + (8 * c) * 33 + n;
        u32x4 o; o.x = pk2(s[0 * 33], s[1 * 33]); o.y = pk2(s[2 * 33], s[3 * 33]); o.z = pk2(s[4 * 33], s[5 * 33]); o.w = pk2(s[6 * 33], s[7 * 33]);
        *(u32x4*)(WT + (size_t)(r0 + n) * ldw + koff + k0 + 8 * c) = o; }
    LDS_WAIT();
}
__device__ __forceinline__ void rms_row_to_bf16(const float* xrow, const float* g, bf16_t* orow, int lane) {
    const f32x4* xr = (const f32x4*)xrow + lane; const f32x4* gr = (const f32x4*)g + lane;
    f32x4 v[4]; float s = 0.f;
#pragma unroll
    for (int j = 0; j < 4; ++j) { v[j] = xr[64 * j]; s += (v[j].x * v[j].x + v[j].y * v[j].y) + (v[j].z * v[j].z + v[j].w * v[j].w); }
    const float r = 1.0f / sqrtf(wave_sum(s) * (1.f / DM) + EPS);
    u32x2* o8 = (u32x2*)orow + lane;
#pragma unroll
    for (int j = 0; j < 4; ++j) { const f32x4 gv = gr[64 * j]; u32x2 o; o.x = pk2(v[j].x * r * gv.x, v[j].y * r * gv.y); o.y = pk2(v[j].z * r * gv.z, v[j].w * r * gv.w); o8[64 * j] = o; }
}
__device__ void p0_prologue(const Params& P, LAS unsigned char* lds) {
    const int tid = threadIdx.x, lane = tid & 63, wave = tid >> 6;
    LAS float* scr = (LAS float*)(lds + wave * 16384);
    const int gw = blockIdx.x * NWAVES + wave, NGW = gridDim.x * NWAVES;
    unsigned char* ws = P.ws;
    constexpr int I_IN = 16 * 192, I_SQ = 16 * 32, I_UP = 16 * 128, I_DN = 64 * 32, I_PP = 4 * 32;
    constexpr int NIT = I_IN + 4 * I_SQ + I_UP + I_DN + I_PP;
    for (int it = gw; it < NIT; it += NGW) {
        int r = it;
        if (r < I_IN) { transpose_item<true>(P.in[I_W_IN], DM, PROJW, (bf16_t*)(ws + WS_WIN), DM, 0, scr, r, lane); continue; } r -= I_IN;
        if (r < I_SQ) { transpose_item(P.in[I_W_BR_M], DM, DM, (bf16_t*)(ws + WS_WBR), 2 * DM, 0, scr, r, lane); continue; } r -= I_SQ;
        if (r < I_SQ) { transpose_item(P.in[I_W_BR_G], DM, DM, (bf16_t*)(ws + WS_WBR), 2 * DM, DM, scr, r, lane); continue; } r -= I_SQ;
        if (r < I_SQ) { transpose_item(P.in[I_W_OUT], DM, DM, (bf16_t*)(ws + WS_WOUT), DM, 0, scr, r, lane); continue; } r -= I_SQ;
        if (r < I_SQ) { transpose_item(P.in[I_W_PLE_GATE], DM, DM, (bf16_t*)(ws + WS_WPLE), PLEK, PLE, scr, r, lane, P.in[I_PLE_PRE_G]); continue; } r -= I_SQ;
        if (r < I_UP) { transpose_item(P.in[I_W_UP], DM, DFF, (bf16_t*)(ws + WS_WUP), DM, 0, scr, r, lane, P.in[I_MLP_PRE_G]); continue; } r -= I_UP;
        if (r < I_DN) { transpose_item(P.in[I_W_DOWN], DFF, DM, (bf16_t*)(ws + WS_WDN), DFF, 0, scr, r, lane); continue; } r -= I_DN;
        transpose_item(P.in[I_W_PLE_PROJ], PLE, DM, (bf16_t*)(ws + WS_WPLE), PLEK, 0, scr, r, lane);
    }
    {
        float* wcx = (float*)(ws + WS_WCX);
        const float* wq = P.in[I_WQ]; const float* wk = P.in[I_WK]; const float* wv = P.in[I_WV]; const float* wif = P.in[I_W_IF];
        for (int i = blockIdx.x * NTHR + tid; i < DM * 8; i += gridDim.x * NTHR) {
            const int c = i >> 3, j = i & 7, blk = c >> 2, d = c & 3; float sc = 0.f, sx = 0.f;
#pragma unroll
            for (int e = 0; e < 4; ++e) {
                sc += wq[blk * 16 + d * 4 + e] * wif[(size_t)(blk * 4 + e) * 8 + j] + wk[blk * 16 + d * 4 + e] * wif[(size_t)(DM + blk * 4 + e) * 8 + j];
                sx += wv[blk * 16 + d * 4 + e] * wif[(size_t)(2 * DM + blk * 4 + e) * 8 + j]; }
            wcx[i] = sc; wcx[DM * 8 + i] = sx;
        }
    }
    { bf16_t* wsp = (bf16_t*)(ws + WS_WSP); const float* w = P.in[I_W_SP];
      for (int i = blockIdx.x * NTHR + tid; i < 8 * 128 * 128; i += gridDim.x * NTHR) { const int t = (i >> 7) & 127, s = i & 127; wsp[i] = (bf16_t)f2bf(s <= t ? w[i] : 0.f); } }
    bf16_t* XN = (bf16_t*)(ws + WS_XN);
    for (int m = gw; m < NTOK; m += NGW) rms_row_to_bf16(P.in[I_X] + (size_t)m * DM, P.in[I_MIX_PRE_G], XN + (size_t)m * DM, lane);
}

namespace pg8 {
constexpr int BM = 256, BK = 64, HALF = 128, HTB = HALF * BK * 2, STAGE_BYTES = 8 * HTB, NXCD = 8, WGM = 8;
__host__ __device__ __forceinline__ int lds_byte(int r, int c) { const int st = (r >> 4) * 2 + (c >> 5), rr = r & 15, cc = c & 31, ob = rr * 64 + cc * 2; return st * 1024 + (ob ^ (((ob >> 9) & 1) << 5)); }
__host__ __device__ __forceinline__ void stage_rc(int b, int& R, int& C) { const int st = b / 1024, sb = b % 1024, swz = sb ^ (((sb >> 9) & 1) << 5); R = (st >> 1) * 16 + swz / 64; C = (st & 1) * 32 + (swz % 64) / 2; }
__host__ __device__ __forceinline__ int perm32(int rho) { const int n = rho >> 4, i = rho & 15; return 8 * (i >> 2) + 4 * n + (i & 3); }
struct Unit { int pm, pn; };
struct Gemm { const bf16_t* A; const bf16_t* Bt; int lda, ldb, M, N, K; };
struct StaticOrder {
    int nM, nN, nwg, G, c;
    __host__ __device__ void init(int M, int N, int G_, int c_) { nM = M / BM; nN = N / BM; nwg = nM * nN; G = G_; c = c_; }
    __host__ __device__ bool next(int i, Unit& u) const {
        const long L = (long)i * G + c; if (L >= nwg) return false;
        int wgid = (int)L; { const int q = nwg / NXCD, r = nwg % NXCD, xcd = wgid % NXCD, off = wgid / NXCD; wgid = (xcd < r ? xcd * (q + 1) : r * (q + 1) + (xcd - r) * q) + off; }
        const int nig = WGM * nN, gid = wgid / nig, fm = gid * WGM, gsz = (nM - fm) < WGM ? (nM - fm) : WGM;
        u.pm = fm + ((wgid % nig) % gsz); u.pn = (wgid % nig) / gsz; return true;
    }
};
template <class F> struct Epi8 {
    static constexpr bool PERM = true; F f;
    __device__ __forceinline__ void operator()(f32x4 (&acc)[2][2][4][2], const Unit& u_, int wr, int wc, int fr, int fq) const {
        Unit u = u_; asm volatile("" : "+s"(u.pm), "+s"(u.pn));
#pragma unroll
        for (int ai = 0; ai < 2; ++ai)
#pragma unroll
            for (int m = 0; m < 4; ++m)
                { f.store16(u.pm * BM + ai * HALF + wr * 64 + m * 16 + fr, u.pn, wc * 32 + 8 * fq, acc[ai][0][m][0], acc[ai][0][m][1], acc[ai][1][m][0], acc[ai][1][m][1], ai * 4 + m); asm volatile("" ::: "memory"); }
    }
    __device__ __forceinline__ void mid(f32x4 (&acc)[2][2][4][2], const Unit& u_, int wr, int wc, int fr, int fq) const {
        Unit u = u_; asm volatile("" : "+s"(u.pm), "+s"(u.pn));
#pragma unroll
        for (int ai = 0; ai < 2; ++ai)
#pragma unroll
            for (int m = 0; m < 4; ++m)
#pragma unroll
                for (int bj = 0; bj < 2; ++bj) { f.mid8(u.pm * BM + ai * HALF + wr * 64 + m * 16 + fr, u.pn * BM + bj * HALF + wc * 32 + 8 * fq, acc[ai][bj][m][0], acc[ai][bj][m][1], (ai * 4 + m) * 2 + bj); asm volatile("" ::: "memory"); }
    }
};
template <class F> struct Epi4 {
    static constexpr bool PERM = false; F f;
    __device__ __forceinline__ void operator()(f32x4 (&acc)[2][2][4][2], const Unit& u_, int wr, int wc, int fr, int fq) const {
        Unit u = u_; asm volatile("" : "+s"(u.pm), "+s"(u.pn));
#pragma unroll
        for (int ai = 0; ai < 2; ++ai)
#pragma unroll
            for (int m = 0; m < 4; ++m)
#pragma unroll
                for (int bj = 0; bj < 2; ++bj)
#pragma unroll
                    for (int n = 0; n < 2; ++n) { f.store4(u.pm * BM + ai * HALF + wr * 64 + m * 16 + fr, u.pn * BM + bj * HALF + wc * 32 + 16 * n + 4 * fq, acc[ai][bj][m][n], ((ai * 4 + m) * 2 + bj) * 2 + n); if (n) asm volatile("" ::: "memory"); }
    }
    __device__ __forceinline__ void mid(f32x4 (&acc)[2][2][4][2], const Unit& u_, int wr, int wc, int fr, int fq) const {
        Unit u = u_; asm volatile("" : "+s"(u.pm), "+s"(u.pn));
#pragma unroll
        for (int ai = 0; ai < 2; ++ai)
#pragma unroll
            for (int m = 0; m < 4; ++m)
#pragma unroll
                for (int bj = 0; bj < 2; ++bj)
#pragma unroll
                    for (int n = 0; n < 2; ++n) { f.mid4(u.pm * BM + ai * HALF + wr * 64 + m * 16 + fr, u.pn * BM + bj * HALF + wc * 32 + 16 * n + 4 * fq, acc[ai][bj][m][n], ((ai * 4 + m) * 2 + bj) * 2 + n); if (n) asm volatile("" ::: "memory"); }
    }
};
template <class Epi, int HOOK_T, bool ALIGN_EPI>
__device__ __forceinline__ void gemm_phase(LAS unsigned char* lds, const Gemm g, const StaticOrder& S, const Epi& E) {
    int tid_ = threadIdx.x; asm volatile("" : "+v"(tid_));
    const int tid = tid_, wid = __builtin_amdgcn_readfirstlane(tid >> 6), lane = tid & 63, wr = wid >> 2, wc = wid & 3, fr = lane & 15, fq = lane >> 4;
    const int K = g.K, nt = K / BK;
    unsigned voffA[2], voffB[2];
#pragma unroll
    for (int i = 0; i < 2; ++i) { int R, C; stage_rc(tid * 16 + i * 8192, R, C); const int Rb = Epi::PERM ? ((R & ~31) + perm32(R & 31)) : R;
        voffA[i] = (unsigned)(R * g.lda + C) * 2u; voffB[i] = (unsigned)(Rb * g.ldb + C) * 2u; }
    const size_t kstep = (size_t)(BK * 2);
    const size_t hstepA = (size_t)HALF * g.lda * 2, hstepB = (size_t)HALF * g.ldb * 2;
    const size_t tstepA = 2 * hstepA, tstepB = 2 * hstepB;
    const unsigned ldsw = (unsigned)wid * 1024u;
    const int aoff = lds_byte(wr * 64 + fr, fq * 8), boff = lds_byte(wc * 32 + fr, fq * 8);
#define PG8_SA(b, h) (((b) * 2 + (h)) * HTB)
#define PG8_SB(b, h) ((4 + (b) * 2 + (h)) * HTB)
#define PG8_STAGE(bufoff, gbase, voff) do { _Pragma("unroll") for (int _i = 0; _i < 2; ++_i) \
        __builtin_amdgcn_global_load_lds((const unsigned*)((const char*)(gbase) + (voff)[_i]), (LAS unsigned*)(lds + (bufoff) + ldsw + _i * 8192), 16, 0, 0); } while (0)
#define PG8_LDA(dst, b, h) do { _Pragma("unroll") for (int m = 0; m < 4; ++m) _Pragma("unroll") for (int k = 0; k < 2; ++k) dst[m][k] = *(const LAS bf16x8*)(lds + PG8_SA(b, h) + aoff + m * 2048 + k * 1024); } while (0)
#define PG8_LDB(dst, b, h) do { _Pragma("unroll") for (int n = 0; n < 2; ++n) _Pragma("unroll") for (int k = 0; k < 2; ++k) dst[n][k] = *(const LAS bf16x8*)(lds + PG8_SB(b, h) + boff + n * 2048 + k * 1024); } while (0)
#define PG8_MMA(ai, bj, At, Bt) do { __builtin_amdgcn_s_setprio(1); _Pragma("unroll") for (int m = 0; m < 4; ++m) _Pragma("unroll") for (int n = 0; n < 2; ++n) _Pragma("unroll") for (int k = 0; k < 2; ++k) \
        acc[ai][bj][m][n] = __builtin_amdgcn_mfma_f32_16x16x32_bf16(Bt[n][k], At[m][k], acc[ai][bj][m][n], 0, 0, 0); __builtin_amdgcn_s_setprio(0); } while (0)
#define PG8_WAIT_V(n) asm volatile("s_waitcnt vmcnt(" #n ")" ::: "memory")
#define PG8_WAIT_L(n) asm volatile("s_waitcnt lgkmcnt(" #n ")" ::: "memory")
#define PG8_BAR __builtin_amdgcn_s_barrier()
#define PG8_SCHED __builtin_amdgcn_sched_barrier(0)
    Unit cur, nxt; int ui = 0;
    if (!S.next(0, cur)) return;
    f32x4 acc[2][2][4][2];
#pragma unroll
    for (int a = 0; a < 2; ++a)
#pragma unroll
        for (int b = 0; b < 2; ++b)
#pragma unroll
            for (int m = 0; m < 4; ++m)
#pragma unroll
                for (int n = 0; n < 2; ++n) acc[a][b][m][n] = (f32x4){0.f, 0.f, 0.f, 0.f};
    bf16x8 At[4][2], B0[2][2], B1[2][2];
    const char* cA = (const char*)g.A + (size_t)cur.pm * tstepA; const char* cB = (const char*)g.Bt + (size_t)cur.pn * tstepB;
    PG8_STAGE(PG8_SB(0, 0), cB, voffB); PG8_STAGE(PG8_SB(0, 1), cB + hstepB, voffB); PG8_STAGE(PG8_SA(0, 0), cA, voffA); PG8_STAGE(PG8_SA(0, 1), cA + hstepA, voffA);
    if (wr == 1) PG8_BAR;
    PG8_WAIT_V(2); PG8_BAR;
    PG8_STAGE(PG8_SB(1, 0), cB + kstep, voffB); PG8_STAGE(PG8_SA(1, 0), cA + kstep, voffA); PG8_STAGE(PG8_SB(1, 1), cB + hstepB + kstep, voffB);
    PG8_WAIT_V(6); PG8_BAR;
    for (;;) {
        const bool has_next = S.next(ui + 1, nxt);
        const char* nA = has_next ? (const char*)g.A + (size_t)nxt.pm * tstepA : cA; const char* nB = has_next ? (const char*)g.Bt + (size_t)nxt.pn * tstepB : cB;
#define PG8_KBODY() do { \
            const bool last = (t == nt - 2); \
            const char* a1 = cA + (size_t)(t + 1) * kstep; \
            const char* a2 = last ? nA : cA + (size_t)(t + 2) * kstep; const char* b2 = last ? nB : cB + (size_t)(t + 2) * kstep; \
            const char* a3 = a2 + kstep; const char* b3 = b2 + kstep; \
            PG8_LDB(B0, 0, 0); PG8_LDB(B1, 0, 1); PG8_SCHED; PG8_LDA(At, 0, 0); PG8_STAGE(PG8_SA(1, 1), a1 + hstepA, voffA); \
            PG8_WAIT_V(8); PG8_WAIT_L(0); PG8_BAR; PG8_MMA(0, 0, At, B0); PG8_MMA(0, 1, At, B1); PG8_BAR; PG8_SCHED; \
            PG8_LDA(At, 0, 1); PG8_STAGE(PG8_SB(0, 0), b2, voffB); PG8_STAGE(PG8_SB(0, 1), b2 + hstepB, voffB); PG8_STAGE(PG8_SA(0, 0), a2, voffA); \
            PG8_WAIT_V(8); PG8_WAIT_L(0); PG8_BAR; PG8_MMA(1, 0, At, B0); PG8_MMA(1, 1, At, B1); PG8_BAR; PG8_SCHED; \
            PG8_LDB(B0, 1, 0); PG8_LDB(B1, 1, 1); PG8_SCHED; PG8_LDA(At, 1, 0); PG8_STAGE(PG8_SA(0, 1), a2 + hstepA, voffA); \
            PG8_WAIT_V(8); PG8_WAIT_L(0); PG8_BAR; PG8_MMA(0, 0, At, B0); PG8_MMA(0, 1, At, B1); PG8_BAR; PG8_SCHED; \
            PG8_LDA(At, 1, 1); PG8_STAGE(PG8_SB(1, 0), b3, voffB); PG8_STAGE(PG8_SB(1, 1), b3 + hstepB, voffB); PG8_STAGE(PG8_SA(1, 0), a3, voffA); \
            PG8_WAIT_V(8); PG8_WAIT_L(0); PG8_BAR; PG8_MMA(1, 0, At, B0); PG8_MMA(1, 1, At, B1); PG8_BAR; PG8_SCHED; \
        } while (0)
        int t = 0;
        if constexpr (HOOK_T > 0) {
            for (; t < HOOK_T; t += 2) PG8_KBODY();
            PG8_SCHED; E.mid(acc, cur, wr, wc, fr, fq); PG8_SCHED;
        }
        for (; t < nt; t += 2) PG8_KBODY();
#undef PG8_KBODY
        if constexpr (ALIGN_EPI) { if (wr == 0) PG8_BAR; }
        E(acc, cur, wr, wc, fr, fq);
        if (!has_next) break;
#pragma unroll
        for (int a = 0; a < 2; ++a)
#pragma unroll
            for (int b = 0; b < 2; ++b)
#pragma unroll
                for (int m = 0; m < 4; ++m)
#pragma unroll
                    for (int n = 0; n < 2; ++n) acc[a][b][m][n] = (f32x4){0.f, 0.f, 0.f, 0.f};
        cur = nxt; cA = nA; cB = nB; ++ui;
        if constexpr (ALIGN_EPI) { if (wr == 1) PG8_BAR; }
    }
    PG8_WAIT_V(0);
    if constexpr (!ALIGN_EPI) { if (wr == 0) PG8_BAR; }
    PG8_BAR;
#undef PG8_SA
#undef PG8_SB
#undef PG8_STAGE
#undef PG8_LDA
#undef PG8_LDB
#undef PG8_MMA
#undef PG8_WAIT_V
#undef PG8_WAIT_L
#undef PG8_BAR
#undef PG8_SCHED
}
}
__device__ __forceinline__ void st_bf16x8(bf16_t* p, f32x4 a, f32x4 b) { u32x4 o; o.x = pk2(a.x, a.y); o.y = pk2(a.z, a.w); o.z = pk2(b.x, b.y); o.w = pk2(b.z, b.w); *(u32x4*)p = o; }
__device__ __forceinline__ void ld_bf16x8(const bf16_t* p, f32x4& a, f32x4& b) { const u32x4 w = *(const u32x4*)p; a = (f32x4){bflo(w.x), bfhi(w.x), bflo(w.y), bfhi(w.y)}; b = (f32x4){bflo(w.z), bfhi(w.z), bflo(w.w), bfhi(w.w)}; }
template <class FN> __device__ __forceinline__ f32x4 map4(f32x4 v, FN fn) { return (f32x4){fn(v.x), fn(v.y), fn(v.z), fn(v.w)}; }
struct ProjF {
    bf16_t* proj;
    __device__ __forceinline__ void store16(int row, int pn, int cl, f32x4 a0, f32x4 a1, f32x4 b0, f32x4 b1, int) const {
        bf16_t* rp = proj + (size_t)row * PROJW;
        if (pn < 16) { st_bf16x8(rp + pn * 256 + cl, a0, a1); st_bf16x8(rp + pn * 256 + 128 + cl, b0, b1); }
        else {
            const int j = (pn - 16) * 128 + cl;
            auto ex = [](float x) { return 1.0f + __builtin_amdgcn_exp2f(-1.4426950408889634f * fmaxf(x, -60.f)); };
            auto rc = [](float x) { return __builtin_amdgcn_rcpf(x); };
            const f32x4 da0 = map4(a0, ex), da1 = map4(a1, ex), db0 = map4(b0, ex), db1 = map4(b1, ex);
            st_bf16x8(rp + 4 * DM + j, db0 * map4(da0, rc), db1 * map4(da1, rc)); st_bf16x8(rp + 5 * DM + j, map4(db0, rc), map4(db1, rc));
        }
    }
    __device__ __forceinline__ void mid8(int, int, f32x4&, f32x4&, int) const {}
};
struct MergeF {
    const bf16_t* proj; bf16_t* merged;
    __device__ __forceinline__ void mid8(int row, int col, f32x4& a, f32x4& b, int) const {
        f32x4 r0, r1; ld_bf16x8(proj + (size_t)row * PROJW + 4 * DM + col, r0, r1); a = a * r0; b = b * r1;
    }
    __device__ __forceinline__ void store16(int row, int pn, int cl, f32x4 a0, f32x4 a1, f32x4 b0, f32x4 b1, int) const {
        const int col = pn * 256 + cl; f32x4 g0, g1;
        ld_bf16x8(proj + (size_t)row * PROJW + 5 * DM + col, g0, g1); st_bf16x8(merged + (size_t)row * DM + col, a0 * g0, a1 * g1);
        ld_bf16x8(proj + (size_t)row * PROJW + 5 * DM + col + 128, g0, g1); st_bf16x8(merged + (size_t)row * DM + col + 128, b0 * g0, b1 * g1);
    }
};
struct Bf16F {
    bf16_t* o; int ldc;
    __device__ __forceinline__ void store16(int row, int pn, int cl, f32x4 a0, f32x4 a1, f32x4 b0, f32x4 b1, int) const {
        bf16_t* p = o + (size_t)row * ldc + pn * 256 + cl; st_bf16x8(p, a0, a1); st_bf16x8(p + 128, b0, b1);
    }
    __device__ __forceinline__ void mid8(int, int, f32x4&, f32x4&, int) const {}
};
struct Relu2F {
    bf16_t* o; int ldc; const float* rs;
    __device__ __forceinline__ void store16(int row, int pn, int cl, f32x4 a0, f32x4 a1, f32x4 b0, f32x4 b1, int) const {
        const float rr = rs[row]; auto r2 = [rr](float x) { const float r = fmaxf(x * rr, 0.f); return r * r; };
        bf16_t* p = o + (size_t)row * ldc + pn * 256 + cl;
        st_bf16x8(p, map4(a0, r2), map4(a1, r2)); st_bf16x8(p + 128, map4(b0, r2), map4(b1, r2));
    }
    __device__ __forceinline__ void mid8(int, int, f32x4&, f32x4&, int) const {}
};
struct PleF {
    bf16_t* o; f32x4* stash; const float* rs;
    __device__ __forceinline__ void mid8(int, int, f32x4& a, f32x4& b, int idx2) const {
        unsigned t = threadIdx.x; asm volatile("" : "+v"(t));
        f32x4* s = stash + ((size_t)blockIdx.x * 32 + idx2 * 2) * NTHR + t; s[0] = a; s[NTHR] = b; a = (f32x4){0.f, 0.f, 0.f, 0.f}; b = (f32x4){0.f, 0.f, 0.f, 0.f};
    }
    __device__ __forceinline__ void store16(int row, int pn, int cl, f32x4 a0, f32x4 a1, f32x4 b0, f32x4 b1, int idx) const {
        unsigned t = threadIdx.x; asm volatile("" : "+v"(t));
        const f32x4* s = stash + ((size_t)blockIdx.x * 32 + idx * 4) * NTHR + t;
        bf16_t* p = o + (size_t)row * DM + pn * 256 + cl;
        const float rr = rs[row]; auto sg = [rr](float x) { return sigmoidf_(x * rr); };
        st_bf16x8(p, map4(a0, sg) * s[0], map4(a1, sg) * s[NTHR]); st_bf16x8(p + 128, map4(b0, sg) * s[2 * NTHR], map4(b1, sg) * s[3 * NTHR]);
    }
};

__device__ __forceinline__ void ld4(const bf16_t* p, float (&x)[4]) { const u32x2 w = *(const u32x2*)p; x[0] = bflo(w.x); x[1] = bfhi(w.x); x[2] = bflo(w.y); x[3] = bfhi(w.y); }
__device__ __forceinline__ void up4(u32x2 w, float (&x)[4]) { x[0] = bflo(w.x); x[1] = bfhi(w.x); x[2] = bflo(w.y); x[3] = bfhi(w.y); }
__device__ __forceinline__ void st4(bf16_t* p, const float (&x)[4]) { u32x2 o; o.x = pk2(x[0], x[1]); o.y = pk2(x[2], x[3]); *(u32x2*)p = o; }
__device__ void p2_qkv(const Params& P, LAS unsigned char* lds) {
    const int tid = threadIdx.x, lane = tid & 63, wave = tid >> 6, h = wave & 3, half = wave >> 2;
    unsigned char* ws = P.ws;
    const bf16_t* PROJ = (const bf16_t*)(ws + WS_PROJ);
    bf16_t* Q = (bf16_t*)P.out; bf16_t* K = Q + (size_t)NTOK * DM; bf16_t* V = (bf16_t*)(ws + WS_XN);
    float* GATES = (float*)(ws + WS_GATES);
    LAS float* part = (LAS float*)lds;
    const int ch = h * 256 + lane * 4, blk = ch >> 2;
    float cw[4][4], cb[4], wq[4][4], wk[4][4], wv[4][4], wc[4][8], wx[4][8];
#pragma unroll
    for (int j = 0; j < 4; ++j)
#pragma unroll
        for (int d = 0; d < 4; ++d) cw[j][d] = P.in[I_CONV_W][j * DM + ch + d];
#pragma unroll
    for (int d = 0; d < 4; ++d) { cb[d] = P.in[I_CONV_B][ch + d];
#pragma unroll
        for (int e = 0; e < 4; ++e) { wq[d][e] = P.in[I_WQ][blk * 16 + d * 4 + e]; wk[d][e] = P.in[I_WK][blk * 16 + d * 4 + e]; wv[d][e] = P.in[I_WV][blk * 16 + d * 4 + e]; }
#pragma unroll
        for (int j = 0; j < 8; ++j) { wc[d][j] = ((const float*)(ws + WS_WCX))[(ch + d) * 8 + j]; wx[d][j] = ((const float*)(ws + WS_WCX))[DM * 8 + (ch + d) * 8 + j]; } }
    for (int item = blockIdx.x; item < NTOK / 16; item += gridDim.x) {
        const int tb = item * 16 + half * 8;
        u32x2 raw[11];
        const bool seq0 = (tb & (SEQ - 1)) == 0;
#pragma unroll
        for (int i = 0; i < 11; ++i) raw[i] = (i < 3 && seq0) ? (u32x2){0u, 0u} : *(const u32x2*)(PROJ + (size_t)(tb - 3 + i) * PROJW + ch);
        float x0[4], x1[4], x2[4], x3[4];
        up4(raw[0], x0); up4(raw[1], x1); up4(raw[2], x2);
#pragma unroll
        for (int i = 0; i < 8; ++i) {
            const int t = tb + i;
            up4(raw[3 + i], x3);
            float mc[4], q[4], k[4], v[4], gp[8];
#pragma unroll
            for (int d = 0; d < 4; ++d) mc[d] = siluf_(cw[0][d] * x0[d] + cw[1][d] * x1[d] + cw[2][d] * x2[d] + cw[3][d] * x3[d] + cb[d]);
#pragma unroll
            for (int e = 0; e < 4; ++e) { q[e] = mc[0] * wq[0][e] + mc[1] * wq[1][e] + mc[2] * wq[2][e] + mc[3] * wq[3][e];
                k[e] = mc[0] * wk[0][e] + mc[1] * wk[1][e] + mc[2] * wk[2][e] + mc[3] * wk[3][e];
                v[e] = x3[0] * wv[0][e] + x3[1] * wv[1][e] + x3[2] * wv[2][e] + x3[3] * wv[3][e]; }
            st4(Q + (size_t)t * DM + ch, q); st4(K + (size_t)t * DM + ch, k); st4(V + (size_t)t * DM + ch, v);
#pragma unroll
            for (int j = 0; j < 8; ++j) { float s = 0.f;
#pragma unroll
                for (int d = 0; d < 4; ++d) s += mc[d] * wc[d][j] + x3[d] * wx[d][j];
                gp[j] = wave_sum(s); }
            if (lane == 0) {
#pragma unroll
                for (int j = 0; j < 8; ++j) part[((half * 8 + i) * 4 + h) * 8 + j] = gp[j]; }
#pragma unroll
            for (int d = 0; d < 4; ++d) { x0[d] = x1[d]; x1[d] = x2[d]; x2[d] = x3[d]; }
        }
        __syncthreads();
        if (tid < 128) { const int tok = tid >> 3, j = tid & 7;
            const float val = part[(tok * 4 + 0) * 8 + j] + part[(tok * 4 + 1) * 8 + j] + part[(tok * 4 + 2) * 8 + j] + part[(tok * 4 + 3) * 8 + j] + P.in[I_B_IF][j];
            GATES[(size_t)(item * 16 + tok) * 8 + j] = (j < 4) ? val : log_sigmoid(val); }
        __syncthreads();
    }
    bf16_t* PW = (bf16_t*)(ws + WS_PROJ);
    const int gw = blockIdx.x * NWAVES + wave, NGW = gridDim.x * NWAVES;
    for (int m = gw; m < NTOK; m += NGW) {
        bf16_t* row = PW + (size_t)m * PROJW + 3 * DM + lane * 16;
        const u32x4 a = *(const u32x4*)row, b = *(const u32x4*)(row + 8);
        float x[16] = {bflo(a.x), bfhi(a.x), bflo(a.y), bfhi(a.y), bflo(a.z), bfhi(a.z), bflo(a.w), bfhi(a.w), bflo(b.x), bfhi(b.x), bflo(b.y), bfhi(b.y), bflo(b.z), bfhi(b.z), bflo(b.w), bfhi(b.w)};
        float s = 0.f;
#pragma unroll
        for (int i = 0; i < 16; ++i) { x[i] = gelu_tanh(x[i]); s += x[i]; }
        const float mu = wave_sum(s) * (1.f / DM); float s2 = 0.f;
#pragma unroll
        for (int i = 0; i < 16; ++i) { x[i] -= mu; s2 += x[i] * x[i]; }
        const float r = 1.0f / sqrtf(wave_sum(s2) * (1.f / DM) + EPS);
        const float* lw = P.in[I_G_LN_W] + lane * 16; const float* lb = P.in[I_G_LN_B] + lane * 16;
#pragma unroll
        for (int i = 0; i < 16; ++i) x[i] = x[i] * r * lw[i] + lb[i];
        u32x4 oa, ob; oa.x = pk2(x[0], x[1]); oa.y = pk2(x[2], x[3]); oa.z = pk2(x[4], x[5]); oa.w = pk2(x[6], x[7]); ob.x = pk2(x[8], x[9]); ob.y = pk2(x[10], x[11]); ob.z = pk2(x[12], x[13]); ob.w = pk2(x[14], x[15]);
        *(u32x4*)row = oa; *(u32x4*)(row + 8) = ob;
    }
}

namespace mlm {
constexpr int QP = 264, VP = 88, PP = 72;
constexpr int VSB = 64 * VP * 2;
constexpr int QS_OFF = 0, KS_OFF = QS_OFF + 64 * QP * 2, VS_OFF = KS_OFF + 64 * QP * 2, CT_OFF = VS_OFF + 2 * VSB, PS_OFF = CT_OFF + 80 * QP * 2, SC_OFF = PS_OFF + 64 * PP * 2, BYTES = SC_OFF + 4096;
typedef short s16x4 __attribute__((ext_vector_type(4)));
typedef float f32x2_t __attribute__((ext_vector_type(2)));
typedef __bf16 bf16x2_t __attribute__((ext_vector_type(2)));
__device__ __forceinline__ unsigned cvtpk(float lo, float hi) { f32x2_t v = {lo, hi}; bf16x2_t b = __builtin_convertvector(v, bf16x2_t); return __builtin_bit_cast(unsigned, b); }
__device__ __forceinline__ s16x4 tr16(LAS unsigned char* p) { return __builtin_bit_cast(s16x4, __builtin_amdgcn_ds_read_tr16_b64_v4i16((LAS s16x4*)p)); }
__device__ __forceinline__ bf16x8 frag_tr(LAS unsigned char* p, int pitch_bytes) {
    const s16x4 lo = tr16(p), hi = tr16(p + 4 * pitch_bytes);
    return (bf16x8){lo.x, lo.y, lo.z, lo.w, hi.x, hi.y, hi.z, hi.w};
}
}
__device__ void p3_mlstm_mfma(const Params& P, LAS unsigned char* lds) {
    using namespace mlm;
    const int tid = threadIdx.x, lane = tid & 63, wave = __builtin_amdgcn_readfirstlane(tid >> 6), fr = lane & 15, fq = lane >> 4, q_ = fr >> 2, p_ = fr & 3;
    const int tau = wave >> 1, par = wave & 1;
    unsigned char* ws = P.ws;
    const bf16_t* Q = (const bf16_t*)P.out; const bf16_t* K = Q + (size_t)NTOK * DM; bf16_t* V = (bf16_t*)(ws + WS_XN);
    const float* GATES = (const float*)(ws + WS_GATES);
    for (int it = blockIdx.x; it < 256; it += gridDim.x) {
        const int item = (gridDim.x == 256) ? (((it & 7) * 8 + (it >> 5)) * 4 + ((it >> 3) & 3)) : it;
        const int b = item >> 4, h = (item >> 2) & 3, j = item & 3;
        float* scg = (float*)(ws + WS_END) + (size_t)it * 32 * 384;
        {
            LAS float* cb = (LAS float*)(lds + SC_OFF);
            float bs[4], uu[4], cm[4];
#pragma unroll
            for (int i = 0; i < 4; ++i) { const int c = wave + 8 * i; const size_t t = (size_t)b * SEQ + c * 64 + lane;
                float s = GATES[t * 8 + 4 + h]; const float ig = GATES[t * 8 + h];
#pragma unroll
                for (int o = 1; o < 64; o <<= 1) { const float x = __shfl_up(s, o); if (lane >= o) s += x; }
                const float u = ig - s; float g = u;
#pragma unroll
                for (int o = 1; o < 64; o <<= 1) { const float x = __shfl_up(g, o); if (lane >= o) g = fmaxf(g, x); }
                bs[i] = s; uu[i] = u; cm[i] = g;
                if (lane == 63) { cb[c] = s; cb[32 + c] = g; } }
            __syncthreads();
            if (tid == 0) { float m = 0.f; for (int c = 0; c < 32; ++c) { const float gL = fmaxf(m, cb[32 + c]); cb[64 + c] = m; cb[96 + c] = gL; m = cb[c] + gL; } }
            __syncthreads();
#pragma unroll
            for (int i = 0; i < 4; ++i) { const int c = wave + 8 * i; const float m = cb[64 + c], gL = cb[96 + c], g = fmaxf(m, cm[i]); float* o = scg + c * 384;
                o[lane] = uu[i]; o[64 + lane] = g; o[128 + lane] = expf(m - g); o[192 + lane] = expf(-bs[i] - g); o[256 + lane] = expf(uu[i] - gL) * 0.0625f;
                if (lane == 0) o[320] = expf(m - gL); }
            asm volatile("s_waitcnt vmcnt(0)" ::: "memory");
            __syncthreads();
        }
        for (int i = tid; i < 80 * QP * 2 / 16; i += NTHR) ((LAS u32x4*)(lds + CT_OFF))[i] = (u32x4){0u, 0u, 0u, 0u};
        if (tid < 128) { LAS bf16_t* r = (LAS bf16_t*)(lds + VS_OFF + (tid >> 6) * VSB) + (tid & 63) * VP + 64; r[0] = 0x3F80;
#pragma unroll
            for (int i = 1; i < 24; ++i) r[i] = 0; }
        f32x4 cacc[2][5];
#pragma unroll
        for (int a = 0; a < 2; ++a)
#pragma unroll
            for (int e = 0; e < 5; ++e) cacc[a][e] = (f32x4){0.f, 0.f, 0.f, 0.f};
        u32x4 pq[4], pk[4], pv; float psc[6];
        const bf16_t* qb = Q + (size_t)b * SEQ * DM + h * 256; const bf16_t* kb = K + (size_t)b * SEQ * DM + h * 256; bf16_t* vb = V + (size_t)b * SEQ * DM + h * 256 + j * 64;
#define ML_LOAD(c_) do { const size_t r0_ = (size_t)(c_) * 64; \
            _Pragma("unroll") for (int i = 0; i < 4; ++i) { const int p = tid + i * NTHR, r = p >> 5, cc = p & 31; pq[i] = *(const u32x4*)(qb + (r0_ + r) * DM + cc * 8); pk[i] = *(const u32x4*)(kb + (r0_ + r) * DM + cc * 8); } \
            pv = *(const u32x4*)(vb + (r0_ + (tid >> 3)) * DM + (tid & 7) * 8); \
            if (wave == 0) { const float* s_ = scg + (c_) * 384; _Pragma("unroll") for (int i = 0; i < 5; ++i) psc[i] = __builtin_nontemporal_load(s_ + 64 * i + lane); psc[5] = __builtin_nontemporal_load(s_ + 320); } } while (0)
#define ML_STORE(c_) do { \
            _Pragma("unroll") for (int i = 0; i < 4; ++i) { const int p = tid + i * NTHR, r = p >> 5, cc = p & 31; *(LAS u32x4*)(lds + QS_OFF + r * QP * 2 + cc * 16) = pq[i]; *(LAS u32x4*)(lds + KS_OFF + r * QP * 2 + cc * 16) = pk[i]; } \
            *(LAS u32x4*)(lds + VS_OFF + ((c_) & 1) * VSB + (tid >> 3) * VP * 2 + (tid & 7) * 16) = pv; \
            if (wave == 0) { LAS float* s_ = (LAS float*)(lds + SC_OFF) + ((c_) & 1) * 512; _Pragma("unroll") for (int i = 0; i < 5; ++i) s_[64 * i + lane] = psc[i]; if (lane == 0) s_[320] = psc[5]; } } while (0)
        ML_LOAD(0);
        __syncthreads();
        ML_STORE(0);
        __syncthreads();
        for (int c = 0; c < 32; ++c) {
            LAS float* sc = (LAS float*)(lds + SC_OFF) + (c & 1) * 512;
            if (c + 1 < 32) ML_LOAD(c + 1);
            bf16x8 qf[8];
#pragma unroll
            for (int kap = 0; kap < 8; ++kap) qf[kap] = *(const LAS bf16x8*)(lds + QS_OFF + ((16 * tau + fr) * QP + 32 * kap + 8 * fq) * 2);
            const float gt = sc[64 + 16 * tau + fr];
#pragma unroll
            for (int si = 0; si < 2; ++si) {
                const int sig = 2 * par + si; f32x4 acc = (f32x4){0.f, 0.f, 0.f, 0.f};
                if (sig <= tau) {
#pragma unroll
                    for (int kap = 0; kap < 8; ++kap) acc = __builtin_amdgcn_mfma_f32_16x16x32_bf16(*(const LAS bf16x8*)(lds + KS_OFF + ((16 * sig + fr) * QP + 32 * kap + 8 * fq) * 2), qf[kap], acc, 0, 0, 0);
                }
                const f32x4 us = *(const LAS f32x4*)(sc + 16 * sig + 4 * fq);
                const int t = 16 * tau + fr, s0 = 16 * sig + 4 * fq;
                const float w0 = (s0 + 0 <= t) ? acc.x * 0.0625f * __expf(us.x - gt) : 0.f, w1 = (s0 + 1 <= t) ? acc.y * 0.0625f * __expf(us.y - gt) : 0.f;
                const float w2 = (s0 + 2 <= t) ? acc.z * 0.0625f * __expf(us.z - gt) : 0.f, w3 = (s0 + 3 <= t) ? acc.w * 0.0625f * __expf(us.w - gt) : 0.f;
                u32x2 o; o.x = cvtpk(w0, w1); o.y = cvtpk(w2, w3);
                *(LAS u32x2*)(lds + PS_OFF + (t * PP + s0) * 2) = o;
            }
            f32x4 nacc[3];
#pragma unroll
            for (int ei = 0; ei < 3; ++ei) {
                const int eps = (ei == 2) ? 4 : 2 * par + ei; f32x4 acc = (f32x4){0.f, 0.f, 0.f, 0.f};
#pragma unroll
                for (int kap = 0; kap < 8; ++kap) acc = __builtin_amdgcn_mfma_f32_16x16x32_bf16(*(const LAS bf16x8*)(lds + CT_OFF + ((16 * eps + fr) * QP + 32 * kap + 8 * fq) * 2), qf[kap], acc, 0, 0, 0);
                nacc[ei] = acc * sc[128 + 16 * tau + fr];
            }
            bf16x8 kw[2][2];
#pragma unroll
            for (int dl = 0; dl < 2; ++dl)
#pragma unroll
                for (int kp = 0; kp < 2; ++kp) {
                    const bf16x8 f = frag_tr(lds + KS_OFF + ((32 * kp + 8 * fq + q_) * QP + 16 * (2 * wave + dl) + 4 * p_) * 2, QP * 2);
                    const u32x4 fw = __builtin_bit_cast(u32x4, f);
                    const f32x4 wa = *(const LAS f32x4*)(sc + 256 + 32 * kp + 8 * fq), wb = *(const LAS f32x4*)(sc + 256 + 32 * kp + 8 * fq + 4);
                    u32x4 o; o.x = cvtpk(bflo(fw.x) * wa.x, bfhi(fw.x) * wa.y); o.y = cvtpk(bflo(fw.y) * wa.z, bfhi(fw.y) * wa.w); o.z = cvtpk(bflo(fw.z) * wb.x, bfhi(fw.z) * wb.y); o.w = cvtpk(bflo(fw.w) * wb.z, bfhi(fw.w) * wb.w);
                    kw[dl][kp] = __builtin_bit_cast(bf16x8, o);
                }
            LAS unsigned char* vsc = lds + VS_OFF + (c & 1) * VSB;
            const float lowb = sc[192 + 16 * tau + fr], decay = sc[320];
            __syncthreads();
            {
                bf16x8 pf[2];
#pragma unroll
                for (int kp = 0; kp < 2; ++kp) pf[kp] = *(const LAS bf16x8*)(lds + PS_OFF + ((16 * tau + fr) * PP + 32 * kp + 8 * fq) * 2);
#pragma unroll
                for (int ei = 0; ei < 3; ++ei) {
#pragma unroll
                    for (int kp = 0; kp < 2; ++kp) {
                        const int eps = (ei == 2) ? 4 : 2 * par + ei;
                        nacc[ei] = __builtin_amdgcn_mfma_f32_16x16x32_bf16(frag_tr(vsc + ((32 * kp + 8 * fq + q_) * VP + 16 * eps + 4 * p_) * 2, VP * 2), pf[kp], nacc[ei], 0, 0, 0);
                    }
                }
                const float den = __shfl(nacc[2].x, fr);
                const float rinv = 1.0f / fmaxf(fabsf(den), lowb);
                bf16_t* hrow = vb + ((size_t)c * 64 + 16 * tau + fr) * DM;
#pragma unroll
                for (int ei = 0; ei < 2; ++ei) { const int eps = 2 * par + ei; u32x2 o; o.x = cvtpk(nacc[ei].x * rinv, nacc[ei].y * rinv); o.y = cvtpk(nacc[ei].z * rinv, nacc[ei].w * rinv);
                    *(u32x2*)(hrow + 16 * eps + 4 * fq) = o; }
            }
#pragma unroll
            for (int eps = 0; eps < 5; ++eps) {
                bf16x8 vf[2];
#pragma unroll
                for (int kp = 0; kp < 2; ++kp) vf[kp] = frag_tr(vsc + ((32 * kp + 8 * fq + q_) * VP + 16 * eps + 4 * p_) * 2, VP * 2);
#pragma unroll
                for (int dl = 0; dl < 2; ++dl) {
                    f32x4 a = cacc[dl][eps] * decay;
                    a = __builtin_amdgcn_mfma_f32_16x16x32_bf16(kw[dl][0], vf[0], a, 0, 0, 0);
                    a = __builtin_amdgcn_mfma_f32_16x16x32_bf16(kw[dl][1], vf[1], a, 0, 0, 0);
                    cacc[dl][eps] = a;
                    u32x2 o; o.x = cvtpk(a.x, a.y); o.y = cvtpk(a.z, a.w);
                    *(LAS u32x2*)(lds + CT_OFF + ((16 * eps + fr) * QP + 16 * (2 * wave + dl) + 4 * fq) * 2) = o;
                }
            }
            if (c + 1 < 32) ML_STORE(c + 1);
            __syncthreads();
        }
#undef ML_LOAD
#undef ML_STORE
    }
}

namespace gmm { constexpr int VVP = 136, MXP = 132, VV_OFF = 0, WS_OFF = 128 * VVP * 2, MX_OFF = 2 * 128 * VVP * 2, BYTES = MX_OFF + 128 * MXP * 4; }
__device__ void p3_gmlp_mfma(const Params& P, LAS unsigned char* lds) {
    using namespace gmm;
    const int tid = threadIdx.x, lane = tid & 63, wave = __builtin_amdgcn_readfirstlane(tid >> 6), fr = lane & 15, fq = lane >> 4, q_ = fr >> 2, p_ = fr & 3;
    bf16_t* PROJ = (bf16_t*)(P.ws + WS_PROJ); const bf16_t* WSPb = (const bf16_t*)(P.ws + WS_WSP); const float* BSP = P.in[I_B_SP];
    int g_staged = -1;
    u32x4 pre[4], pgu[4];
#define GM_LOAD(it_, dst_, sec_) do { const int g_ = (it_) & 7, c_ = ((it_) >> 3) & 15, b_ = (it_) >> 7; const size_t t0_ = (size_t)b_ * SEQ + c_ * 128; \
        _Pragma("unroll") for (int i = 0; i < 4; ++i) { const int p = tid + i * NTHR, r = p >> 4, cc = p & 15; dst_[i] = *(const u32x4*)(PROJ + (t0_ + r) * PROJW + (sec_) * DM + g_ * 128 + cc * 8); } } while (0)
    if ((int)blockIdx.x < 2048) GM_LOAD(blockIdx.x, pre, 3);
    for (int item = blockIdx.x; item < 2048; item += gridDim.x) {
        const int g = item & 7, c = (item >> 3) & 15, b = item >> 7; const size_t t0 = (size_t)b * SEQ + c * 128;
#pragma unroll
        for (int i = 0; i < 4; ++i) { const int p = tid + i * NTHR, r = p >> 4, cc = p & 15; *(LAS u32x4*)(lds + VV_OFF + (r * VVP + cc * 8) * 2) = pre[i]; }
        if (g != g_staged) {
#pragma unroll
            for (int i = 0; i < 4; ++i) { const int p = tid + i * NTHR, r = p >> 4, cc = p & 15; *(LAS u32x4*)(lds + WS_OFF + (r * VVP + cc * 8) * 2) = *(const u32x4*)(WSPb + ((size_t)g * 128 + r) * 128 + cc * 8); }
            g_staged = g;
        }
        __syncthreads();
        GM_LOAD(item, pgu, 2);
        if (item + (int)gridDim.x < 2048) GM_LOAD(item + gridDim.x, pre, 3);
        bf16x8 af[4];
#pragma unroll
        for (int kap = 0; kap < 4; ++kap) af[kap] = mlm::frag_tr(lds + VV_OFF + ((32 * kap + 8 * fq + q_) * VVP + 16 * wave + 4 * p_) * 2, VVP * 2);
#pragma unroll
        for (int th = 0; th < 8; ++th) {
            f32x4 acc = (f32x4){0.f, 0.f, 0.f, 0.f};
#pragma unroll
            for (int kap = 0; kap <= (th >> 1); ++kap) acc = __builtin_amdgcn_mfma_f32_16x16x32_bf16(af[kap], *(const LAS bf16x8*)(lds + WS_OFF + ((16 * th + fr) * VVP + 32 * kap + 8 * fq) * 2), acc, 0, 0, 0);
            const int t = 16 * th + fr; const float bs = BSP[g * 128 + t];
            *(LAS f32x4*)(lds + MX_OFF + (t * MXP + 16 * wave + 4 * fq) * 4) = acc + bs;
        }
        __syncthreads();
#pragma unroll
        for (int i = 0; i < 4; ++i) { const int p = tid + i * NTHR, r = p >> 4, cc = p & 15;
            const f32x4 m0 = *(const LAS f32x4*)(lds + MX_OFF + (r * MXP + cc * 8) * 4), m1 = *(const LAS f32x4*)(lds + MX_OFF + (r * MXP + cc * 8 + 4) * 4);
            const u32x4 w = pgu[i]; u32x4 o;
            o.x = pk2(gelu_tanh(bflo(w.x)) * m0.x, gelu_tanh(bfhi(w.x)) * m0.y); o.y = pk2(gelu_tanh(bflo(w.y)) * m0.z, gelu_tanh(bfhi(w.y)) * m0.w);
            o.z = pk2(gelu_tanh(bflo(w.z)) * m1.x, gelu_tanh(bfhi(w.z)) * m1.y); o.w = pk2(gelu_tanh(bflo(w.w)) * m1.z, gelu_tanh(bfhi(w.w)) * m1.w);
            *(u32x4*)(PROJ + (t0 + r) * PROJW + 2 * DM + g * 128 + cc * 8) = o; }
    }
#undef GM_LOAD
}

__device__ void p4_ym(const Params& P, LAS unsigned char*) {
    const int tid = threadIdx.x, lane = tid & 63, wave = tid >> 6, h = wave & 3, half = wave >> 2;
    bf16_t* PROJ = (bf16_t*)(P.ws + WS_PROJ); const bf16_t* HM = (const bf16_t*)(P.ws + WS_XN);
    const int ch = h * 256 + lane * 4;
    float cw[4][4], cb[4], ng[4], sk[4];
#pragma unroll
    for (int j = 0; j < 4; ++j)
#pragma unroll
        for (int d = 0; d < 4; ++d) cw[j][d] = P.in[I_CONV_W][j * DM + ch + d];
#pragma unroll
    for (int d = 0; d < 4; ++d) { cb[d] = P.in[I_CONV_B][ch + d]; ng[d] = P.in[I_M_NORM_G][ch + d]; sk[d] = P.in[I_M_SKIP][ch + d]; }
    for (int item = blockIdx.x; item < NTOK / 16; item += gridDim.x) {
        const int tb = item * 16 + half * 8;
        u32x2 raw[11], rh[8], rz[8];
        const bool seq0 = (tb & (SEQ - 1)) == 0;
#pragma unroll
        for (int i = 0; i < 11; ++i) raw[i] = (i < 3 && seq0) ? (u32x2){0u, 0u} : *(const u32x2*)(PROJ + (size_t)(tb - 3 + i) * PROJW + ch);
#pragma unroll
        for (int i = 0; i < 8; ++i) { rh[i] = *(const u32x2*)(HM + (size_t)(tb + i) * DM + ch); rz[i] = *(const u32x2*)(PROJ + (size_t)(tb + i) * PROJW + DM + ch); }
        float x0[4], x1[4], x2[4], x3[4];
        up4(raw[0], x0); up4(raw[1], x1); up4(raw[2], x2);
#pragma unroll
        for (int i = 0; i < 8; ++i) {
            const int t = tb + i;
            up4(raw[3 + i], x3);
            float hm[4], sz[4], y[4];
            up4(rh[i], hm); up4(rz[i], sz);
#pragma unroll
            for (int d = 0; d < 4; ++d) sz[d] = siluf_(sz[d]);
            const float mu = wave_sum(hm[0] + hm[1] + hm[2] + hm[3]) * (1.f / 256.f);
            float s2 = 0.f;
#pragma unroll
            for (int d = 0; d < 4; ++d) { hm[d] -= mu; s2 += hm[d] * hm[d]; }
            const float r = 1.0f / sqrtf(wave_sum(s2) * (1.f / 256.f) + EPS);
#pragma unroll
            for (int d = 0; d < 4; ++d) { const float mc = siluf_(cw[0][d] * x0[d] + cw[1][d] * x1[d] + cw[2][d] * x2[d] + cw[3][d] * x3[d] + cb[d]);
                y[d] = (hm[d] * r * ng[d] + sk[d] * mc) * sz[d]; }
            st4(PROJ + (size_t)t * PROJW + DM + ch, y);
#pragma unroll
            for (int d = 0; d < 4; ++d) { x0[d] = x1[d]; x1[d] = x2[d]; x2[d] = x3[d]; }
        }
    }
}

template <bool XI_BF16, bool XO_BF16>
__device__ void norm_pass(const void* xi_, int ldxi, const bf16_t* y, const float* g1, void* xo_, int ldxo, float* rs, const float* pin, bf16_t* pout, int ldp) {
    const int tid = threadIdx.x, lane = tid & 63, wave = tid >> 6;
    const int gw = blockIdx.x * NWAVES + wave, NGW = gridDim.x * NWAVES;
    f32x4 gv1[4];
#pragma unroll
    for (int j = 0; j < 4; ++j) gv1[j] = ((const f32x4*)g1 + lane)[64 * j];
    for (int m0 = gw; m0 < NTOK; m0 += 2 * NGW) {
        const int m1 = m0 + NGW; const bool has1 = m1 < NTOK; const int mm[2] = {m0, has1 ? m1 : m0};
        f32x4 v[2][4], xv[2][4]; float s[2] = {0.f, 0.f};
#pragma unroll
        for (int r = 0; r < 2; ++r) {
            const u32x2* yr = (const u32x2*)(y + (size_t)mm[r] * DM) + lane;
#pragma unroll
            for (int j = 0; j < 4; ++j) { const u32x2 w = yr[64 * j]; v[r][j] = (f32x4){bflo(w.x), bfhi(w.x), bflo(w.y), bfhi(w.y)};
                if (XI_BF16) { const u32x2 xw = ((const u32x2*)((const bf16_t*)xi_ + (size_t)mm[r] * ldxi) + lane)[64 * j]; xv[r][j] = (f32x4){bflo(xw.x), bfhi(xw.x), bflo(xw.y), bfhi(xw.y)}; }
                else xv[r][j] = ((const f32x4*)((const float*)xi_ + (size_t)mm[r] * ldxi) + lane)[64 * j]; }
        }
#pragma unroll
        for (int r = 0; r < 2; ++r)
#pragma unroll
            for (int j = 0; j < 4; ++j) s[r] += (v[r][j].x * v[r][j].x + v[r][j].y * v[r][j].y) + (v[r][j].z * v[r][j].z + v[r][j].w * v[r][j].w);
#pragma unroll
        for (int o = 1; o < 64; o <<= 1) { s[0] += __shfl_xor(s[0], o); s[1] += __shfl_xor(s[1], o); }
        float s2[2] = {0.f, 0.f};
#pragma unroll
        for (int r = 0; r < 2; ++r) {
            const float rr = 1.0f / sqrtf(s[r] * (1.f / DM) + EPS);
#pragma unroll
            for (int j = 0; j < 4; ++j) { v[r][j] = xv[r][j] + v[r][j] * rr * gv1[j];
                s2[r] += (v[r][j].x * v[r][j].x + v[r][j].y * v[r][j].y) + (v[r][j].z * v[r][j].z + v[r][j].w * v[r][j].w);
                if (r == 0 || has1) {
                    if (XO_BF16) { u32x2 o; o.x = pk2(v[r][j].x, v[r][j].y); o.y = pk2(v[r][j].z, v[r][j].w); ((u32x2*)((bf16_t*)xo_ + (size_t)mm[r] * ldxo) + lane)[64 * j] = o; }
                    else ((f32x4*)((float*)xo_ + (size_t)mm[r] * ldxo) + lane)[64 * j] = v[r][j]; } }
        }
        if (rs) {
#pragma unroll
            for (int o = 1; o < 64; o <<= 1) { s2[0] += __shfl_xor(s2[0], o); s2[1] += __shfl_xor(s2[1], o); }
            if (lane == 0) { rs[mm[0]] = 1.0f / sqrtf(s2[0] * (1.f / DM) + EPS); if (has1) rs[mm[1]] = 1.0f / sqrtf(s2[1] * (1.f / DM) + EPS); }
        }
        if (pin) {
#pragma unroll
            for (int r = 0; r < 2; ++r) { if (r == 1 && !has1) break;
                const f32x4 pv = ((const f32x4*)(pin + (size_t)mm[r] * PLE))[lane]; u32x2 o; o.x = pk2(pv.x, pv.y); o.y = pk2(pv.z, pv.w); ((u32x2*)(pout + (size_t)mm[r] * ldp))[lane] = o; }
        }
    }
}

#define XB_TMO      128
#define XB_XCNT(j)  (256  + 64 * (j))
#define XB_XSUB(j)  (1280 + 64 * (j))
#define XB_XGEN(j)  (2304 + 64 * (j))
#define XB_TOP      3328
#define XB_TOPGEN   3392
#define XCD_BAR_WORDS 3456
#define XB_SPIN_CAP (1u << 20)
__device__ __forceinline__ unsigned xb_ld(unsigned* p)              { return __hip_atomic_load(p, __ATOMIC_RELAXED, __HIP_MEMORY_SCOPE_AGENT); }
__device__ __forceinline__ unsigned xb_add(unsigned* p, unsigned v) { return __hip_atomic_fetch_add(p, v, __ATOMIC_RELAXED, __HIP_MEMORY_SCOPE_AGENT); }
__device__ __forceinline__ unsigned xb_xcc_id() { return (unsigned)__builtin_amdgcn_s_getreg((3 << 11) | 20) & 0xFu; }
#define XB_SPIN(cond, bar) do { unsigned _sp = 0; while (cond) { __builtin_amdgcn_s_sleep(1); \
    if ((++_sp & 255u) == 0u) { if (xb_ld(&(bar)[XB_TMO])) break; if (_sp > XB_SPIN_CAP) { atomicAdd(&(bar)[XB_TMO], 1u); break; } } } } while (0)
struct XcdBarrier { unsigned* bar; unsigned x; volatile LAS unsigned* st; };
__device__ __forceinline__ XcdBarrier xcd_barrier_post(unsigned* bar, volatile LAS unsigned* st) {
    XcdBarrier b; b.bar = bar; b.x = xb_xcc_id(); b.st = st;
    if (threadIdx.x == 0) (void)xb_add(&bar[XB_XCNT(b.x)], 1u);
    return b;
}
__device__ __forceinline__ void xcd_barrier_complete(unsigned* bar, unsigned x, unsigned& nloc, unsigned& nx) {
    const unsigned G = gridDim.x * gridDim.y * gridDim.z;
    unsigned sum, cnt, mine, sp = 0u;
    for (;;) {
        sum = 0u; cnt = 0u; mine = 0u;
#pragma unroll
        for (unsigned j = 0; j < 16; ++j) { const unsigned c = xb_ld(&bar[XB_XCNT(j)]); sum += c; cnt += (c > 0u) ? 1u : 0u; mine = (j == x) ? c : mine; }
        if (sum == G) break;
        __builtin_amdgcn_s_sleep(1);
        if ((++sp & 255u) == 0u) { if (xb_ld(&bar[XB_TMO])) break; if (sp > XB_SPIN_CAP) { atomicAdd(&bar[XB_TMO], 1u); break; } }
    }
    nloc = mine > 0u ? mine : 1u; nx = cnt > 0u ? cnt : 1u;
}
__device__ __forceinline__ void xcd_barrier(const XcdBarrier& b) {
    asm volatile("s_waitcnt vmcnt(0)" ::: "memory");
    __syncthreads();
    if (threadIdx.x == 0) {
        unsigned* bar = b.bar;
        __builtin_amdgcn_s_waitcnt(0);
        unsigned nloc = b.st[0], nx = b.st[1];
        if (nloc == 0u) { xcd_barrier_complete(bar, b.x, nloc, nx); b.st[0] = nloc; b.st[1] = nx; }
        const unsigned old = xb_add(&bar[XB_XSUB(b.x)], 1u);
        const unsigned gen = old / nloc;
        if (old + 1u == (gen + 1u) * nloc) {
            __builtin_amdgcn_fence(__ATOMIC_RELEASE, "agent");
            asm volatile("s_waitcnt vmcnt(0)" ::: "memory");
            const unsigned og = xb_add(&bar[XB_TOP], 1u);
            const unsigned tg = og / nx;
            if (og + 1u == (tg + 1u) * nx) xb_add(&bar[XB_TOPGEN], 1u);
            else XB_SPIN(xb_ld(&bar[XB_TOPGEN]) == tg, bar);
            __builtin_amdgcn_fence(__ATOMIC_ACQUIRE, "agent");
            xb_add(&bar[XB_XGEN(b.x)], 1u);
            asm volatile("s_waitcnt vmcnt(0)" ::: "memory");
        } else {
            XB_SPIN(xb_ld(&bar[XB_XGEN(b.x)]) == gen, bar);
            __builtin_amdgcn_fence(__ATOMIC_ACQUIRE, "agent");
            asm volatile("s_waitcnt vmcnt(0)" ::: "memory");
        }
    }
    __syncthreads();
}

#ifndef MEGA
#define MEGA 1
#endif
namespace cg = cooperative_groups;
constexpr int NPHASE = 13;
constexpr int LDS_BYTES = 160 * 1024 - 1024;
constexpr int MISC_OFF = LDS_BYTES - 256;
constexpr int CW_BAR = 4096;
constexpr size_t CTL_ZERO_BYTES = 64 * 1024;
#ifndef USE_CG_SYNC
#define USE_CG_SYNC 0
#endif
static_assert(pg8::STAGE_BYTES <= LDS_BYTES && mlm::BYTES <= MISC_OFF && gmm::BYTES <= MISC_OFF && (CW_BAR + XCD_BAR_WORDS) * 4 <= (int)CTL_ZERO_BYTES, "lds");

template <int LO, int HI> __global__ void __launch_bounds__(NTHR, 2) fwd_kernel(Params P) {
    extern __shared__ __attribute__((aligned(16))) unsigned char lds_raw[];
    LAS unsigned char* lds = (LAS unsigned char*)lds_raw;
    unsigned char* ws = P.ws;
    bf16_t* PROJ = (bf16_t*)(ws + WS_PROJ); bf16_t* XN = (bf16_t*)(ws + WS_XN); bf16_t* HB = (bf16_t*)(ws + WS_HB); bf16_t* Y = (bf16_t*)(ws + WS_Y); float* RS1 = (float*)(ws + WS_RS); float* RS2 = RS1 + NTOK;
    const int G = gridDim.x, bid = blockIdx.x;
#define IN(k) (LO <= (k) && (k) < HI)
#if USE_CG_SYNC
#define SEAM(k) do { if (IN(k) && IN((k) + 1)) cg::this_grid().sync(); } while (0)
#else
    if (HI - LO > 1) { volatile LAS unsigned* misc = (volatile LAS unsigned*)(lds + MISC_OFF); if (threadIdx.x < 2) misc[threadIdx.x] = 0u; __syncthreads(); (void)xcd_barrier_post((unsigned*)(P.ws + WS_CTL) + CW_BAR, misc); }
#define SEAM(k) do { if (IN(k) && IN((k) + 1)) { XcdBarrier xb_; xb_.bar = (unsigned*)(P.ws + WS_CTL) + CW_BAR; xb_.x = xb_xcc_id(); xb_.st = (volatile LAS unsigned*)((LAS unsigned char*)lds_raw + MISC_OFF); xcd_barrier(xb_); } } while (0)
#endif
    if (IN(0)) p0_prologue(P, lds);
    SEAM(0);
    if (IN(1)) { pg8::Gemm g{XN, (const bf16_t*)(ws + WS_WIN), DM, DM, NTOK, PROJW, DM}; pg8::StaticOrder S; S.init(NTOK, PROJW, G, bid);
        pg8::Epi8<ProjF> E{ProjF{PROJ}}; pg8::gemm_phase<pg8::Epi8<ProjF>, -1, true>(lds, g, S, E); }
    SEAM(1);
    if (IN(2)) p2_qkv(P, lds);
    SEAM(2);
    if (IN(3)) { p3_mlstm_mfma(P, lds); __syncthreads(); p3_gmlp_mfma(P, lds); }
    SEAM(3);
    if (IN(4)) p4_ym(P, lds);
    SEAM(4);
    if (IN(5)) { pg8::Gemm g{PROJ + DM, (const bf16_t*)(ws + WS_WBR), PROJW, 2 * DM, NTOK, DM, 2 * DM}; pg8::StaticOrder S; S.init(NTOK, DM, G, bid);
        pg8::Epi8<MergeF> E{MergeF{PROJ, XN}}; pg8::gemm_phase<pg8::Epi8<MergeF>, 16, true>(lds, g, S, E); }
    SEAM(5);
    if (IN(6)) { pg8::Gemm g{XN, (const bf16_t*)(ws + WS_WOUT), DM, DM, NTOK, DM, DM}; pg8::StaticOrder S; S.init(NTOK, DM, G, bid);
        pg8::Epi8<Bf16F> E{Bf16F{Y, DM}}; pg8::gemm_phase<pg8::Epi8<Bf16F>, -1, true>(lds, g, S, E); }
    SEAM(6);
    if (IN(7)) norm_pass<false, true>(P.in[I_X], DM, Y, P.in[I_MIX_POST_G], XN, DM, RS1, nullptr, nullptr, 0);
    SEAM(7);
    if (IN(8)) { pg8::Gemm g{XN, (const bf16_t*)(ws + WS_WUP), DM, DM, NTOK, DFF, DM}; pg8::StaticOrder S; S.init(NTOK, DFF, G, bid);
        pg8::Epi8<Relu2F> E{Relu2F{HB, DFF, RS1}}; pg8::gemm_phase<pg8::Epi8<Relu2F>, -1, true>(lds, g, S, E); }
    SEAM(8);
    if (IN(9)) { pg8::Gemm g{HB, (const bf16_t*)(ws + WS_WDN), DFF, DFF, NTOK, DM, DFF}; pg8::StaticOrder S; S.init(NTOK, DM, G, bid);
        pg8::Epi8<Bf16F> E{Bf16F{Y, DM}}; pg8::gemm_phase<pg8::Epi8<Bf16F>, -1, true>(lds, g, S, E); }
    SEAM(9);
    if (IN(10)) norm_pass<true, true>(XN, DM, Y, P.in[I_MLP_POST_G], HB + PLE, PLEK, RS2, P.in[I_P], HB, PLEK);
    SEAM(10);
    if (IN(11)) { pg8::Gemm g{HB, (const bf16_t*)(ws + WS_WPLE), PLEK, PLEK, NTOK, DM, PLEK}; pg8::StaticOrder S; S.init(NTOK, DM, G, bid);
        pg8::Epi8<PleF> E{PleF{Y, (f32x4*)(ws + WS_XN), RS2}}; pg8::gemm_phase<pg8::Epi8<PleF>, 4, true>(lds, g, S, E); }
    SEAM(11);
    if (IN(12)) norm_pass<true, false>(HB + PLE, PLEK, Y, P.in[I_PLE_POST_G], P.out, DM, nullptr, nullptr, nullptr, 0);
#undef IN
#undef SEAM
}

template <int LO, int HI> static void launch_range(const Params& P, int grid, hipStream_t stream, bool coop) {
    static bool attr = false;
    if (!attr) { (void)hipFuncSetAttribute((const void*)fwd_kernel<LO, HI>, hipFuncAttributeMaxDynamicSharedMemorySize, LDS_BYTES); attr = true; }
    if (coop) {
        Params p = P; void* args[] = {&p};
        const hipError_t e = hipLaunchCooperativeKernel((const void*)fwd_kernel<LO, HI>, dim3(grid), dim3(NTHR), args, LDS_BYTES, stream);
        if (e != hipSuccess) fprintf(stderr, "cooperative launch failed: %s (grid %d)\n", hipGetErrorString(e), grid);
    } else hipLaunchKernelGGL((fwd_kernel<LO, HI>), dim3(grid), dim3(NTHR), LDS_BYTES, stream, P);
}
template <int I> static void launch_each(const Params& P, int grid, hipStream_t stream) {
    if constexpr (I < NPHASE) { launch_range<I, I + 1>(P, grid, stream, false); launch_each<I + 1>(P, grid, stream); }
}

extern "C" void kernel_launch(void* const* d_in, const int* in_sizes, int n_in, void* d_out, int out_size, void* d_ws, size_t ws_size, hipStream_t stream) {
    if (n_in != 29 || out_size != NTOK * DM || ws_size < WS_END + 16 * MiB) { fprintf(stderr, "kernel_launch: unexpected shapes (n_in %d out %d ws %zu)\n", n_in, out_size, ws_size); return; }
    Params P{};
    for (int i = 0; i < 29; ++i) P.in[i] = (const float*)d_in[i];
    P.out = (float*)d_out; P.ws = (unsigned char*)d_ws;
#if MEGA
    static int grid = 0;
    if (!grid) {
        int dev = 0, cus = 0, per_cu = 0;
        (void)hipGetDevice(&dev); (void)hipDeviceGetAttribute(&cus, hipDeviceAttributeMultiprocessorCount, dev);
        (void)hipFuncSetAttribute((const void*)fwd_kernel<0, NPHASE>, hipFuncAttributeMaxDynamicSharedMemorySize, LDS_BYTES);
        (void)hipOccupancyMaxActiveBlocksPerMultiprocessor(&per_cu, (const void*)fwd_kernel<0, NPHASE>, NTHR, LDS_BYTES);
        if (per_cu < 1) per_cu = 1;
        grid = cus;
        if (grid > cus * per_cu) grid = cus * per_cu;
    }
    (void)hipMemsetAsync((char*)d_ws + WS_CTL, 0, CTL_ZERO_BYTES, stream);
    launch_range<0, NPHASE>(P, grid, stream, true);
#else
    launch_each<0>(P, 256, stream);
#endif
}
```
